# Optimizing an MI355X kernel written in HIP

```python
import jax, jax.numpy as jnp
from jax import lax
import numpy as np

D_MODEL = 2048
BATCH = 2
SEQ = 4096
DEPTH = 1

N_MEM = 256
ATT_HEAD_DIM = 128
ATT_WIDTH = D_MODEL // 2
ATT_HEADS = ATT_WIDTH // ATT_HEAD_DIM
MOBA_BLOCK = 256
MOBA_TOPK = 3
Q_CHUNK = 64
SGU_WIDTH = D_MODEL // 2
SGU_CHUNK = 128
SGU_GROUP_DIM = 128
SGU_GROUPS = SGU_WIDTH // SGU_GROUP_DIM
MEM_HEADS = 4
MEM_WIDTH = D_MODEL // 2
MEM_HEAD_DIM = MEM_WIDTH // MEM_HEADS
N_BRANCH = 3
DN_ALPHA = (2 * DEPTH) ** 0.25
DN_BETA = (8 * DEPTH) ** -0.25
LN_EPS = 1e-5
IN_WIDTHS = (ATT_WIDTH, ATT_WIDTH, ATT_WIDTH, ATT_WIDTH,
             SGU_WIDTH, SGU_WIDTH, SGU_WIDTH,
             MEM_WIDTH, MEM_WIDTH,
             N_BRANCH * D_MODEL)

kernel_name = 'moba_gmlp_memxattn_gated_hybrid'


def _layer_norm(x, g, b):
    xf = x.astype(jnp.float32)
    mu = xf.mean(-1, keepdims=True)
    var = jnp.square(xf - mu).mean(-1, keepdims=True)
    return ((xf - mu) * lax.rsqrt(var + LN_EPS) * g + b).astype(x.dtype)


def _moba_attention(q, k, v):
    b, s, h, dh = q.shape
    nb = -(-s // MOBA_BLOCK)
    n_sel = min(MOBA_TOPK, nb)
    pad = nb * MOBA_BLOCK - s
    q = q.transpose(0, 2, 1, 3)
    k = jnp.pad(k.transpose(0, 2, 1, 3), ((0, 0), (0, 0), (0, pad), (0, 0)))
    v = jnp.pad(v.transpose(0, 2, 1, 3), ((0, 0), (0, 0), (0, pad), (0, 0)))
    k_blocks = k.reshape(b, h, nb, MOBA_BLOCK, dh)
    v_blocks = v.reshape(b, h, nb, MOBA_BLOCK, dh)
    k_mean = k_blocks.mean(axis=3)
    scale = dh ** -0.5
    blk_ids = jnp.arange(nb)
    slot_ids = jnp.arange(n_sel)
    key_off = jnp.arange(MOBA_BLOCK)
    q_off = jnp.arange(Q_CHUNK)
    gather = jax.vmap(jax.vmap(lambda blocks, ids: blocks[ids]))

    def chunk(start):
        qc = lax.dynamic_slice_in_dim(q, start, Q_CHUNK, axis=2)
        blk = start // MOBA_BLOCK
        s_blk = jnp.einsum('bhqd,bhnd->bhqn', qc, k_mean)
        s_blk = jnp.where(blk_ids < blk, s_blk, -jnp.inf)
        _, sel = lax.top_k(s_blk, n_sel)
        k_sel = gather(k_blocks, sel)
        v_sel = gather(v_blocks, sel)
        s_sel = jnp.einsum('bhqd,bhqrkd->bhqrk', qc, k_sel) * scale
        s_sel = jnp.where((slot_ids < blk)[:, None], s_sel, -jnp.inf)
        k_own = lax.dynamic_slice_in_dim(k, blk * MOBA_BLOCK, MOBA_BLOCK, axis=2)
        v_own = lax.dynamic_slice_in_dim(v, blk * MOBA_BLOCK, MOBA_BLOCK, axis=2)
        s_own = jnp.einsum('bhqd,bhkd->bhqk', qc, k_own) * scale
        causal = (blk * MOBA_BLOCK + key_off)[None, :] <= (start + q_off)[:, None]
        s_own = jnp.where(causal, s_own, -jnp.inf)
        logits = jnp.concatenate([s_sel.reshape(b, h, Q_CHUNK, n_sel * MOBA_BLOCK), s_own], axis=-1)
        p = jax.nn.softmax(logits.astype(jnp.float32), axis=-1).astype(v.dtype)
        p_sel = p[..., :n_sel * MOBA_BLOCK].reshape(b, h, Q_CHUNK, n_sel, MOBA_BLOCK)
        p_own = p[..., n_sel * MOBA_BLOCK:]
        return (jnp.einsum('bhqrk,bhqrkd->bhqd', p_sel, v_sel)
                + jnp.einsum('bhqk,bhkd->bhqd', p_own, v_own))

    out = lax.map(chunk, jnp.arange(0, s, Q_CHUNK))
    return out.transpose(1, 0, 3, 2, 4).reshape(b, s, h * dh)


def _spatial_gating(u, v, w_s, b_s, ln_v_g, ln_v_b):
    b, s, _ = u.shape
    u = jax.nn.gelu(u)
    v = _layer_norm(jax.nn.gelu(v), ln_v_g, ln_v_b)
    vc = v.reshape(b, s // SGU_CHUNK, SGU_CHUNK, SGU_GROUPS, SGU_GROUP_DIM)
    tril = jnp.tril(jnp.ones((SGU_CHUNK, SGU_CHUNK), dtype=bool))
    w_causal = jnp.where(tril[None], w_s, 0.0)
    mixed = jnp.einsum('gts,bcsgd->bctgd', w_causal, vc) + b_s.T[None, None, :, :, None]
    return u * mixed.reshape(b, s, SGU_WIDTH)


def _memory_attention(q, mem_k, mem_v):
    b, s, h, dh = q.shape
    logits = jnp.einsum('bshd,bmhd->bhsm', q, mem_k) * (dh ** -0.5)
    p = jax.nn.softmax(logits.astype(jnp.float32), axis=-1).astype(mem_v.dtype)
    return jnp.einsum('bhsm,bmhd->bshd', p, mem_v).reshape(b, s, h * dh)


def setup_inputs(seed: int = 0) -> dict:
    key = jax.random.key(seed)
    ks = jax.random.split(key, 32)

    def nrm(k, shape, fan_in, scale=1.0):
        return jax.random.normal(k, shape, jnp.float32) * (scale * fan_in ** -0.5)

    in_scales = (1.0, 1.0, DN_BETA, 1.0, DN_BETA, DN_BETA, 1.0, 1.0, 1.0, 1.0)
    w_in = jnp.concatenate([nrm(ks[10 + i], (D_MODEL, w), D_MODEL, sc)
                            for i, (w, sc) in enumerate(zip(IN_WIDTHS, in_scales))], axis=1)
    return {
        'x': jax.random.normal(ks[0], (BATCH, SEQ, D_MODEL), jnp.float32),
        'mem': jax.random.normal(ks[1], (BATCH, N_MEM, D_MODEL), jnp.float32),
        'w_in': w_in,
        'w_mem_k': nrm(ks[2], (D_MODEL, MEM_WIDTH), D_MODEL),
        'w_mem_v': nrm(ks[3], (D_MODEL, MEM_WIDTH), D_MODEL, DN_BETA),
        'w_s': nrm(ks[4], (SGU_GROUPS, SGU_CHUNK, SGU_CHUNK), SGU_CHUNK),
        'b_s': 1.0 + 0.1 * jax.random.normal(ks[5], (SGU_GROUPS, SGU_CHUNK), jnp.float32),
        'ln_v_g': 1.0 + 0.02 * jax.random.normal(ks[6], (SGU_WIDTH,), jnp.float32),
        'ln_v_b': 0.02 * jax.random.normal(ks[7], (SGU_WIDTH,), jnp.float32),
        'w_branch_attn': nrm(ks[8], (ATT_WIDTH, D_MODEL), ATT_WIDTH, DN_BETA),
        'w_branch_sgu': nrm(ks[9], (SGU_WIDTH, D_MODEL), SGU_WIDTH, DN_BETA),
        'w_branch_mem': nrm(ks[20], (MEM_WIDTH, D_MODEL), MEM_WIDTH, DN_BETA),
        'w_out': nrm(ks[21], (D_MODEL, D_MODEL), D_MODEL, DN_BETA),
        'ln_g': 1.0 + 0.02 * jax.random.normal(ks[22], (D_MODEL,), jnp.float32),
        'ln_b': 0.02 * jax.random.normal(ks[23], (D_MODEL,), jnp.float32),
    }


def reference(x, mem, w_in, w_mem_k, w_mem_v, w_s, b_s, ln_v_g, ln_v_b,
              w_branch_attn, w_branch_sgu, w_branch_mem, w_out, ln_g, ln_b):
    b, s, d = x.shape
    m = mem.shape[1]
    split_at = np.cumsum(IN_WIDTHS)[:-1].tolist()
    for _ in range(DEPTH):
        proj = x @ w_in
        q_a, k_a, v_a, z_a, u_g, v_g, z_g, q_c, z_c, g_logit = jnp.split(proj, split_at, axis=-1)
        y_a = _moba_attention(q_a.reshape(b, s, ATT_HEADS, ATT_HEAD_DIM),
                              k_a.reshape(b, s, ATT_HEADS, ATT_HEAD_DIM),
                              v_a.reshape(b, s, ATT_HEADS, ATT_HEAD_DIM)) * jax.nn.silu(z_a)
        y_g = _spatial_gating(u_g, v_g, w_s, b_s, ln_v_g, ln_v_b) * jax.nn.silu(z_g)
        mem_k = (mem @ w_mem_k).reshape(b, m, MEM_HEADS, MEM_HEAD_DIM)
        mem_v = (mem @ w_mem_v).reshape(b, m, MEM_HEADS, MEM_HEAD_DIM)
        y_c = _memory_attention(q_c.reshape(b, s, MEM_HEADS, MEM_HEAD_DIM), mem_k, mem_v) * jax.nn.silu(z_c)
        gates = jax.nn.sigmoid(g_logit.astype(jnp.float32)).astype(x.dtype).reshape(b, s, N_BRANCH, d)
        merged = (gates[:, :, 0] * (y_a @ w_branch_attn)
                  + gates[:, :, 1] * (y_g @ w_branch_sgu)
                  + gates[:, :, 2] * (y_c @ w_branch_mem))
        y = merged @ w_out
        x = _layer_norm(DN_ALPHA * x + y, ln_g, ln_b)
    return x
```

```cpp
#include <hip/hip_runtime.h>
#include <cstdio>
#include <cstdint>

constexpr int DM = 2048, NB = 2, SEQ = 4096, M = NB * SEQ;
constexpr int NMEM = 256, MM = NB * NMEM;
constexpr int W = 1024;
constexpr int NPROJ = 15360;
constexpr int AH = 8, AD = 128, MBLK = 256, NBLK = SEQ / MBLK;
constexpr int SG = 8, SC = 128, SGD = 128;
constexpr int MH = 4, MD = 256;
constexpr float DN_ALPHA = 1.189207115002721f;
constexpr float LN_EPS = 1e-5f;

constexpr size_t MiB = 1u << 20;
constexpr size_t WS_CTL = 0;
constexpr size_t WS_KMEAN = 1 * MiB;
constexpr size_t WS_C2 = 1 * MiB + 128 * 1024;
constexpr size_t WS_WSB = 1 * MiB + 256 * 1024;
constexpr size_t WS_LNS = 1 * MiB + 512 * 1024;
constexpr size_t WS_WBR = 2 * MiB;
constexpr size_t WS_WOUT = 14 * MiB;
constexpr size_t WS_VSTATS = 22 * MiB;
constexpr size_t WS_ML = 23 * MiB;
constexpr size_t WS_WIN = 32 * MiB;
constexpr size_t WS_WMKV = 92 * MiB;
constexpr size_t WS_XB = 100 * MiB;
constexpr size_t WS_MEMB = 132 * MiB;
constexpr size_t WS_ACT = 134 * MiB;
constexpr size_t ACT_STRIDE = (size_t)M * W;
constexpr size_t WS_GATES = 278 * MiB;
constexpr size_t WS_MEMK = 374 * MiB;
constexpr size_t WS_MEMV = 375 * MiB;
constexpr size_t WS_Y = 376 * MiB;
constexpr size_t WS_MERGED = 424 * MiB;
constexpr size_t WS_END = 456 * MiB;
constexpr size_t WS_PO = 32 * MiB;
constexpr size_t WS_H = 32 * MiB;
enum { A_QA = 0, A_KA, A_VA, A_ZA, A_UG, A_VG, A_ZG, A_QC, A_ZC };

typedef unsigned short bf16;
__host__ __device__ __forceinline__ unsigned f2bf(float f) { unsigned u = __builtin_bit_cast(unsigned, f); return (u + 0x7fffu + ((u >> 16) & 1u)) >> 16; }
__host__ __device__ __forceinline__ float bf2f(unsigned short h) { return __builtin_bit_cast(float, (unsigned)h << 16); }
__device__ __forceinline__ float sigmoidf_(float x) { return 1.f / (1.f + __expf(-x)); }
__device__ __forceinline__ float siluf_(float x) { return x * sigmoidf_(x); }
__device__ __forceinline__ float geluf_(float x) { return 0.5f * x * (1.f + tanhf(0.7978845608028654f * (x + 0.044715f * x * x * x))); }

struct LoadF32 { const float* p; __device__ float operator()(size_t i) const { return p[i]; } };
struct LoadBf { const bf16* p; __device__ float operator()(size_t i) const { return bf2f(p[i]); } };

template <class LA, class Epi>
__global__ void __launch_bounds__(256) ngemm(LA A, int lda, const float* B, int ldb, int K, Epi epi) {
    __shared__ float As[16][64 + 1], Bs[16][64 + 1];
    const int tx = threadIdx.x & 15, ty = threadIdx.x >> 4, m0 = blockIdx.y * 64, n0 = blockIdx.x * 64;
    float acc[4][4] = {};
    for (int k0 = 0; k0 < K; k0 += 16) {
        for (int i = threadIdx.x; i < 64 * 16; i += 256) { const int r = i >> 4, c = i & 15; As[c][r] = A((size_t)(m0 + r) * lda + k0 + c); }
        for (int i = threadIdx.x; i < 16 * 64; i += 256) { const int r = i >> 6, c = i & 63; Bs[r][c] = B[(size_t)(k0 + r) * ldb + n0 + c]; }
        __syncthreads();
#pragma unroll
        for (int kk = 0; kk < 16; ++kk) {
            float a[4], b[4];
#pragma unroll
            for (int i = 0; i < 4; ++i) { a[i] = As[kk][ty * 4 + i]; b[i] = Bs[kk][tx * 4 + i]; }
#pragma unroll
            for (int i = 0; i < 4; ++i)
#pragma unroll
                for (int j = 0; j < 4; ++j) acc[i][j] += a[i] * b[j];
        }
        __syncthreads();
    }
    for (int i = 0; i < 4; ++i) for (int j = 0; j < 4; ++j) epi(m0 + ty * 4 + i, n0 + tx * 4 + j, acc[i][j]);
}

struct EpiProjN {
    bf16* act; bf16* gates;
    __device__ void operator()(int m, int n, float v) const {
        if (n < 9 * W) { const int seg = n / W, c = n % W; float o = v;
            if (seg == A_ZA || seg == A_ZG || seg == A_ZC) o = siluf_(v); else if (seg == A_UG || seg == A_VG) o = geluf_(v);
            act[(size_t)seg * ACT_STRIDE + (size_t)m * W + c] = (bf16)f2bf(o); }
        else { gates[(size_t)m * (3 * DM) + (n - 9 * W)] = (bf16)f2bf(sigmoidf_(v)); }
    }
};
struct EpiStoreBf { bf16* o; int ldc; __device__ void operator()(int m, int n, float v) const { o[(size_t)m * ldc + n] = (bf16)f2bf(v); } };

__global__ void n_kmean(const bf16* KA, float* kmean) {
    const int pb = blockIdx.x;
    for (int c = threadIdx.x; c < W; c += blockDim.x) { float s = 0.f; for (int r = 0; r < MBLK; ++r) s += bf2f(KA[(size_t)(pb * MBLK + r) * W + c]); kmean[(size_t)pb * W + c] = s * (1.f / MBLK); }
}
__global__ void n_vstats(const bf16* VG, float* vst) {
    const int m = blockIdx.x; float s = 0.f, q = 0.f;
    for (int c = threadIdx.x; c < W; c += 64) { const float v = bf2f(VG[(size_t)m * W + c]); s += v; q += v * v; }
    for (int o = 32; o; o >>= 1) { s += __shfl_xor(s, o); q += __shfl_xor(q, o); }
    if (threadIdx.x < 16) { vst[((size_t)m * 16 + threadIdx.x) * 2] = threadIdx.x == 0 ? s : 0.f; vst[((size_t)m * 16 + threadIdx.x) * 2 + 1] = threadIdx.x == 0 ? q : 0.f; }
}
__global__ void __launch_bounds__(256) n_attn(const bf16* QA, const bf16* KA, const bf16* VA, const bf16* ZA, const float* kmean, bf16* YA) {
    __shared__ float q[AD], sc[NBLK], p[4 * MBLK], red[256]; __shared__ int selblk[4]; __shared__ int nsel;
    const int m = blockIdx.x, h = blockIdx.y, b = m / SEQ, t = m % SEQ, blk = t / MBLK, tid = threadIdx.x;
    if (tid < AD) q[tid] = bf2f(QA[(size_t)m * W + h * AD + tid]);
    __syncthreads();
    if (tid < NBLK) { float s = 0.f; for (int d = 0; d < AD; ++d) s += q[d] * kmean[(size_t)(b * NBLK + tid) * W + h * AD + d]; sc[tid] = s; }
    __syncthreads();
    if (tid == 0) { unsigned used = 0; int ns = 0; const int want = blk < 3 ? blk : 3;
        for (int k = 0; k < want; ++k) { float best = -INFINITY; int bi = -1; for (int n = 0; n < blk; ++n) if (!((used >> n) & 1) && (bi < 0 || sc[n] > best)) { best = sc[n]; bi = n; } used |= 1u << bi; selblk[ns++] = bi; }
        selblk[ns++] = blk; nsel = ns; }
    __syncthreads();
    const int ns = nsel; const float scale = 0.08838834764831845f;
    float lmax = -INFINITY;
    for (int i = tid; i < ns * MBLK; i += 256) { const int kb = selblk[i / MBLK], kpos = kb * MBLK + (i % MBLK); float s = -INFINITY;
        if (kpos <= t) { s = 0.f; const bf16* kr = KA + (size_t)(b * SEQ + kpos) * W + h * AD; for (int d = 0; d < AD; ++d) s += q[d] * bf2f(kr[d]); s *= scale; }
        p[i] = s; lmax = fmaxf(lmax, s); }
    red[tid] = lmax; __syncthreads();
    for (int o = 128; o; o >>= 1) { if (tid < o) red[tid] = fmaxf(red[tid], red[tid + o]); __syncthreads(); }
    const float mx = red[0]; __syncthreads();
    float ls = 0.f;
    for (int i = tid; i < ns * MBLK; i += 256) { const float e = __expf(p[i] - mx); p[i] = e; ls += e; }
    red[tid] = ls; __syncthreads();
    for (int o = 128; o; o >>= 1) { if (tid < o) red[tid] += red[tid + o]; __syncthreads(); }
    const float inv = 1.f / red[0];
    if (tid < AD) { float o = 0.f;
        for (int i = 0; i < ns * MBLK; ++i) { const int kpos = selblk[i / MBLK] * MBLK + (i % MBLK); o += p[i] * bf2f(VA[(size_t)(b * SEQ + kpos) * W + h * AD + tid]); }
        const size_t oi = (size_t)m * W + h * AD + tid; YA[oi] = (bf16)f2bf(o * inv * bf2f(ZA[oi])); }
}
__global__ void __launch_bounds__(1024) n_sgu(const bf16* UG, const bf16* VG, const bf16* ZG, const float* vst, const float* w_s, const float* b_s, const float* lng, const float* lnb, bf16* YG) {
    __shared__ float mu[SC], rs[SC];
    const int m = blockIdx.x, t = m % SC, m0 = m - t, ch = threadIdx.x, g = ch / SGD;
    if (ch <= t) { float s = 0.f, q = 0.f; for (int j = 0; j < 16; ++j) { s += vst[((size_t)(m0 + ch) * 16 + j) * 2]; q += vst[((size_t)(m0 + ch) * 16 + j) * 2 + 1]; }
        const float mean = s / W, var = q / W - mean * mean; mu[ch] = mean; rs[ch] = rsqrtf(var + LN_EPS); }
    __syncthreads();
    float acc = 0.f; const float gm = lng[ch], bt = lnb[ch];
    for (int s = 0; s <= t; ++s) acc += w_s[((size_t)g * SC + t) * SC + s] * ((bf2f(VG[(size_t)(m0 + s) * W + ch]) - mu[s]) * rs[s] * gm + bt);
    acc += b_s[g * SC + t];
    const size_t oi = (size_t)m * W + ch; YG[oi] = (bf16)f2bf(bf2f(UG[oi]) * acc * bf2f(ZG[oi]));
}
__global__ void __launch_bounds__(256) n_mem(const bf16* QC, const bf16* ZC, const bf16* MK, const bf16* MV, bf16* YC) {
    __shared__ float q[MD], p[NMEM], red[256];
    const int m = blockIdx.x, h = blockIdx.y, b = m / SEQ, tid = threadIdx.x;
    q[tid] = bf2f(QC[(size_t)m * W + h * MD + tid]); __syncthreads();
    float s = 0.f; { const bf16* kr = MK + (size_t)(b * NMEM + tid) * W + h * MD; for (int d = 0; d < MD; ++d) s += q[d] * bf2f(kr[d]); s *= 0.0625f; }
    red[tid] = s; __syncthreads();
    for (int o = 128; o; o >>= 1) { if (tid < o) red[tid] = fmaxf(red[tid], red[tid + o]); __syncthreads(); }
    const float mx = red[0]; __syncthreads();
    const float e = __expf(s - mx); p[tid] = e; red[tid] = e; __syncthreads();
    for (int o = 128; o; o >>= 1) { if (tid < o) red[tid] += red[tid + o]; __syncthreads(); }
    const float inv = 1.f / red[0];
    float o = 0.f; for (int k = 0; k < NMEM; ++k) o += p[k] * bf2f(MV[(size_t)(b * NMEM + k) * W + h * MD + tid]);
    const size_t oi = (size_t)m * W + h * MD + tid; YC[oi] = (bf16)f2bf(o * inv * bf2f(ZC[oi]));
}
__global__ void __launch_bounds__(256) n_branch(const bf16* Y, const float* w0, const float* w1, const float* w2, const bf16* gates, bf16* merged) {
    __shared__ float As[16][65], Bs[16][65];
    const int tx = threadIdx.x & 15, ty = threadIdx.x >> 4, m0 = blockIdx.y * 64, n0 = blockIdx.x * 64;
    float tot[4][4] = {};
    for (int br = 0; br < 3; ++br) { const bf16* A = Y + (size_t)br * ACT_STRIDE; const float* B = br == 0 ? w0 : br == 1 ? w1 : w2; float acc[4][4] = {};
        for (int k0 = 0; k0 < W; k0 += 16) {
            for (int i = threadIdx.x; i < 1024; i += 256) { const int r = i >> 4, c = i & 15; As[c][r] = bf2f(A[(size_t)(m0 + r) * W + k0 + c]); }
            for (int i = threadIdx.x; i < 1024; i += 256) { const int r = i >> 6, c = i & 63; Bs[r][c] = B[(size_t)(k0 + r) * DM + n0 + c]; }
            __syncthreads();
            for (int kk = 0; kk < 16; ++kk) for (int i = 0; i < 4; ++i) for (int j = 0; j < 4; ++j) acc[i][j] += As[kk][ty * 4 + i] * Bs[kk][tx * 4 + j];
            __syncthreads(); }
        for (int i = 0; i < 4; ++i) for (int j = 0; j < 4; ++j) tot[i][j] += bf2f(gates[(size_t)(m0 + ty * 4 + i) * (3 * DM) + br * DM + n0 + tx * 4 + j]) * acc[i][j]; }
    for (int i = 0; i < 4; ++i) for (int j = 0; j < 4; ++j) merged[(size_t)(m0 + ty * 4 + i) * DM + n0 + tx * 4 + j] = (bf16)f2bf(tot[i][j]);
}
struct EpiResid { const float* x; float* h; __device__ void operator()(int m, int n, float v) const { const size_t i = (size_t)m * DM + n; h[i] = DN_ALPHA * x[i] + v; } };
__global__ void __launch_bounds__(256) n_ln(const float* h, const float* g, const float* b, float* out) {
    __shared__ float red[256]; const int m = blockIdx.x, tid = threadIdx.x; float s = 0.f;
    for (int c = tid; c < DM; c += 256) s += h[(size_t)m * DM + c];
    red[tid] = s; __syncthreads(); for (int o = 128; o; o >>= 1) { if (tid < o) red[tid] += red[tid + o]; __syncthreads(); }
    const float mean = red[0] / DM; __syncthreads(); float q = 0.f;
    for (int c = tid; c < DM; c += 256) { const float d = h[(size_t)m * DM + c] - mean; q += d * d; }
    red[tid] = q; __syncthreads(); for (int o = 128; o; o >>= 1) { if (tid < o) red[tid] += red[tid + o]; __syncthreads(); }
    const float rstd = rsqrtf(red[0] / DM + LN_EPS);
    for (int c = tid; c < DM; c += 256) out[(size_t)m * DM + c] = (h[(size_t)m * DM + c] - mean) * rstd * g[c] + b[c];
}

extern "C" void kernel_launch(void* const* d_in, const int* in_sizes, int n_in, void* d_out, int out_size, void* d_ws, size_t ws_size, hipStream_t stream) {
    if (n_in != 15 || in_sizes[0] != M * DM || out_size != M * DM || ws_size < WS_END) { fprintf(stderr, "kernel_launch: unexpected shapes (n_in %d, ws %zu)\n", n_in, ws_size); return; }
    const float* x = (const float*)d_in[0]; const float* mem = (const float*)d_in[1]; const float* w_in = (const float*)d_in[2];
    const float* w_mk = (const float*)d_in[3]; const float* w_mv = (const float*)d_in[4]; const float* w_s = (const float*)d_in[5]; const float* b_s = (const float*)d_in[6];
    const float* lnvg = (const float*)d_in[7]; const float* lnvb = (const float*)d_in[8]; const float* wba = (const float*)d_in[9]; const float* wbg = (const float*)d_in[10];
    const float* wbm = (const float*)d_in[11]; const float* w_out = (const float*)d_in[12]; const float* ln_g = (const float*)d_in[13]; const float* ln_b = (const float*)d_in[14];
    unsigned char* ws = (unsigned char*)d_ws; float* out = (float*)d_out;
    bf16* act = (bf16*)(ws + WS_ACT); bf16* gates = (bf16*)(ws + WS_GATES); bf16* memk = (bf16*)(ws + WS_MEMK); bf16* memv = (bf16*)(ws + WS_MEMV);
    bf16* Y = (bf16*)(ws + WS_Y); bf16* merged = (bf16*)(ws + WS_MERGED); float* kmean = (float*)(ws + WS_KMEAN); float* vst = (float*)(ws + WS_VSTATS); float* hbuf = (float*)(ws + WS_H);
    ngemm<LoadF32, EpiProjN><<<dim3(NPROJ / 64, M / 64), 256, 0, stream>>>(LoadF32{x}, DM, w_in, NPROJ, DM, EpiProjN{act, gates});
    ngemm<LoadF32, EpiStoreBf><<<dim3(W / 64, MM / 64), 256, 0, stream>>>(LoadF32{mem}, DM, w_mk, W, DM, EpiStoreBf{memk, W});
    ngemm<LoadF32, EpiStoreBf><<<dim3(W / 64, MM / 64), 256, 0, stream>>>(LoadF32{mem}, DM, w_mv, W, DM, EpiStoreBf{memv, W});
    n_kmean<<<NB * NBLK, 256, 0, stream>>>(act + A_KA * ACT_STRIDE, kmean);
    n_vstats<<<M, 64, 0, stream>>>(act + A_VG * ACT_STRIDE, vst);
    n_attn<<<dim3(M, AH), 256, 0, stream>>>(act + A_QA * ACT_STRIDE, act + A_KA * ACT_STRIDE, act + A_VA * ACT_STRIDE, act + A_ZA * ACT_STRIDE, kmean, Y);
    n_sgu<<<M, 1024, 0, stream>>>(act + A_UG * ACT_STRIDE, act + A_VG * ACT_STRIDE, act + A_ZG * ACT_STRIDE, vst, w_s, b_s, lnvg, lnvb, Y + ACT_STRIDE);
    n_mem<<<dim3(M, MH), 256, 0, stream>>>(act + A_QC * ACT_STRIDE, act + A_ZC * ACT_STRIDE, memk, memv, Y + 2 * ACT_STRIDE);
    n_branch<<<dim3(DM / 64, M / 64), 256, 0, stream>>>(Y, wba, wbg, wbm, gates, merged);
    ngemm<LoadBf, EpiResid><<<dim3(DM / 64, M / 64), 256, 0, stream>>>(LoadBf{merged}, DM, w_out, DM, DM, EpiResid{x, hbuf});
    n_ln<<<M, 256, 0, stream>>>(hbuf, ln_g, ln_b, out);
}
```

```cpp
#include <hip/hip_runtime.h>
#include <cstdio>
#include <cstdint>

#ifndef HYBRID
#define HYBRID 1
#endif

constexpr int DM = 2048, NB = 2, SEQ = 4096, M = NB * SEQ;
constexpr int NMEM = 256, MM = NB * NMEM;
constexpr int W = 1024;
constexpr int NPROJ = 15360;
constexpr int AH = 8, AD = 128, MBLK = 256, NBLK = SEQ / MBLK;
constexpr int SG = 8, SC = 128, SGD = 128;
constexpr int MH = 4, MD = 256;
constexpr float DN_ALPHA = 1.189207115002721f;
constexpr float LN_EPS = 1e-5f;

constexpr size_t MiB = 1u << 20;
constexpr size_t WS_CTL = 0, CTL_ZERO_BYTES = 1 * MiB;
constexpr size_t WS_KMEAN = 1 * MiB;
constexpr size_t WS_C2 = 1 * MiB + 256 * 1024;
constexpr size_t WS_WSB = 1 * MiB + 512 * 1024;
constexpr size_t WS_LNS = 24 * MiB;
constexpr size_t WS_WBR = 2 * MiB;
constexpr size_t WS_WOUT = 14 * MiB;
constexpr size_t WS_VSTATS = 22 * MiB;
constexpr size_t WS_ML = 23 * MiB;
constexpr size_t WS_WIN = 32 * MiB;
constexpr size_t WS_WMKV = 92 * MiB;
constexpr size_t WS_XB = 100 * MiB;
constexpr size_t WS_MEMB = 132 * MiB;
constexpr size_t WS_ACT = 134 * MiB;
constexpr size_t ACT_STRIDE = (size_t)M * W;
constexpr size_t KM_SLOT = (size_t)NB * NBLK * W;
constexpr size_t WS_GATES = 278 * MiB;
constexpr size_t WS_MEMK = 374 * MiB;
constexpr size_t WS_MEMV = 375 * MiB;
constexpr size_t WS_Y = 376 * MiB;
constexpr size_t WS_MERGED = 424 * MiB;
constexpr size_t WS_END = 456 * MiB;
constexpr size_t WS_PO = 32 * MiB;
constexpr size_t WS_H = 32 * MiB;
enum { A_QA = 0, A_KA, A_VA, A_ZA, A_UG, A_VG, A_ZG, A_QC, A_ZC };
static_assert(WS_WIN + (size_t)NPROJ * DM * 2 == WS_WMKV && WS_XB + (size_t)M * DM * 2 == WS_MEMB && WS_MEMB + (size_t)MM * DM * 2 == WS_ACT, "virtual concatenations");
static_assert(WS_ACT + 9 * ACT_STRIDE * 2 == WS_GATES && WS_GATES + (size_t)M * 3 * DM * 2 == WS_MEMK && WS_Y + 3 * ACT_STRIDE * 2 == WS_MERGED, "d_ws map");

typedef unsigned short bf16;
__host__ __device__ __forceinline__ unsigned f2bf(float f) { unsigned u = __builtin_bit_cast(unsigned, f); return (u + 0x7fffu + ((u >> 16) & 1u)) >> 16; }
__host__ __device__ __forceinline__ float bf2f(unsigned short h) { return __builtin_bit_cast(float, (unsigned)h << 16); }


#define GAS __attribute__((address_space(1)))
#define LAS __attribute__((address_space(3)))
typedef unsigned v4u __attribute__((ext_vector_type(4)));
typedef float f32x4 __attribute__((ext_vector_type(4)));
typedef float f32x2v __attribute__((ext_vector_type(2)));
typedef short bf16x8 __attribute__((ext_vector_type(8)));
typedef GAS unsigned gu32;
#define RLX_AGENT __ATOMIC_RELAXED, __HIP_MEMORY_SCOPE_AGENT
#define LDS_WAIT() asm volatile("s_waitcnt lgkmcnt(0)" ::: "memory")
#define VM_WAIT() asm volatile("s_waitcnt vmcnt(0)" ::: "memory")
__device__ __forceinline__ unsigned pk2(float lo, float hi) { return f2bf(lo) | (f2bf(hi) << 16); }
typedef float f32x2_t __attribute__((ext_vector_type(2))); typedef __bf16 bf16x2_t __attribute__((ext_vector_type(2)));
__device__ __forceinline__ unsigned cvt_pk_bf16(float lo, float hi) { f32x2_t v = {lo, hi}; bf16x2_t b = __builtin_convertvector(v, bf16x2_t); return __builtin_bit_cast(unsigned, b); }
__device__ __forceinline__ float bflo(unsigned w) { return __builtin_bit_cast(float, w << 16); }
__device__ __forceinline__ float bfhi(unsigned w) { return __builtin_bit_cast(float, w & 0xffff0000u); }


#define XB_TMO      128
#define XB_XCNT(j)  (256  + 64 * (j))
#define XB_XSUB(j)  (1280 + 64 * (j))
#define XB_XGEN(j)  (2304 + 64 * (j))
#define XB_TOP      3328
#define XB_TOPGEN   3392
#define XCD_BAR_WORDS 3456
#define XB_SPIN_CAP (1u << 18)

__device__ __forceinline__ unsigned xb_ld(unsigned* p)              { return __hip_atomic_load(p, __ATOMIC_RELAXED, __HIP_MEMORY_SCOPE_AGENT); }
__device__ __forceinline__ unsigned xb_add(unsigned* p, unsigned v) { return __hip_atomic_fetch_add(p, v, __ATOMIC_RELAXED, __HIP_MEMORY_SCOPE_AGENT); }
__device__ __forceinline__ unsigned xb_xcc_id() { return (unsigned)__builtin_amdgcn_s_getreg((3 << 11) | 20) & 0xFu; }
#define XB_SPIN(cond, bar) do { unsigned _sp = 0; while (cond) { __builtin_amdgcn_s_sleep(1); \
    if ((++_sp & 255u) == 0u) { if (xb_ld(&(bar)[XB_TMO])) break; if (_sp > XB_SPIN_CAP) { atomicAdd(&(bar)[XB_TMO], 1u); break; } } } } while (0)

struct XcdBarrier {
    unsigned* bar; unsigned x;
    volatile LAS unsigned* st;
};

__device__ __forceinline__ XcdBarrier xcd_barrier_post(unsigned* bar, volatile LAS unsigned* st) {
    XcdBarrier b; b.bar = bar; b.x = xb_xcc_id(); b.st = st;
    if (threadIdx.x == 0) (void)xb_add(&bar[XB_XCNT(b.x)], 1u);
    return b;
}
__device__ __forceinline__ void xcd_barrier_complete(unsigned* bar, unsigned x, unsigned& nloc, unsigned& nx) {
    const unsigned G = gridDim.x * gridDim.y * gridDim.z;
    unsigned sum, cnt, mine, sp = 0u;
    for (;;) {
        sum = 0u; cnt = 0u; mine = 0u;
#pragma unroll
        for (unsigned j = 0; j < 16; ++j) { const unsigned c = xb_ld(&bar[XB_XCNT(j)]); sum += c; cnt += (c > 0u) ? 1u : 0u; mine = (j == x) ? c : mine; }
        if (sum == G) break;
        __builtin_amdgcn_s_sleep(1);
        if ((++sp & 255u) == 0u) { if (xb_ld(&bar[XB_TMO])) break; if (sp > XB_SPIN_CAP) { atomicAdd(&bar[XB_TMO], 1u); break; } }
    }
    nloc = mine > 0u ? mine : 1u; nx = cnt > 0u ? cnt : 1u;
}

__device__ __forceinline__ void xcd_barrier(const XcdBarrier& b) {
    asm volatile("s_waitcnt vmcnt(0)" ::: "memory");
    __syncthreads();
    if (threadIdx.x == 0) {
        unsigned* bar = b.bar;
        __builtin_amdgcn_s_waitcnt(0);
        unsigned nloc = b.st[0], nx = b.st[1];
        if (nloc == 0u) { xcd_barrier_complete(bar, b.x, nloc, nx); b.st[0] = nloc; b.st[1] = nx; }
        const unsigned old = xb_add(&bar[XB_XSUB(b.x)], 1u);
        const unsigned gen = old / nloc;
        if (old + 1u == (gen + 1u) * nloc) {
            __builtin_amdgcn_fence(__ATOMIC_RELEASE, "agent");
            asm volatile("s_waitcnt vmcnt(0)" ::: "memory");
            const unsigned og = xb_add(&bar[XB_TOP], 1u);
            const unsigned tg = og / nx;
            if (og + 1u == (tg + 1u) * nx) xb_add(&bar[XB_TOPGEN], 1u);
            else XB_SPIN(xb_ld(&bar[XB_TOPGEN]) == tg, bar);
            __builtin_amdgcn_fence(__ATOMIC_ACQUIRE, "agent");
            xb_add(&bar[XB_XGEN(b.x)], 1u);
            asm volatile("s_waitcnt vmcnt(0)" ::: "memory");
        } else {
            XB_SPIN(xb_ld(&bar[XB_XGEN(b.x)]) == gen, bar);
            __builtin_amdgcn_fence(__ATOMIC_ACQUIRE, "agent");
            asm volatile("s_waitcnt vmcnt(0)" ::: "memory");
        }
    }
    __syncthreads();
}

namespace pg8 {
#define PG8_LAS __attribute__((address_space(3)))
typedef unsigned short bf16_t;
typedef unsigned u32x4 __attribute__((ext_vector_type(4)));
constexpr int BM = 256, BK = 64, HALF = 128, HTB = HALF * BK * 2  , STAGE_BYTES = 8 * HTB, NXCD = 8, WGM = 8;

__host__ __device__ __forceinline__ int lds_byte(int r, int c) { const int st = (r >> 4) * 2 + (c >> 5), rr = r & 15, cc = c & 31, ob = rr * 64 + cc * 2; return st * 1024 + (ob ^ (((ob >> 9) & 1) << 5)); }
__host__ __device__ __forceinline__ void stage_rc(int b, int& R, int& C) { const int st = b / 1024, sb = b % 1024, swz = sb ^ (((sb >> 9) & 1) << 5); R = (st >> 1) * 16 + swz / 64; C = (st & 1) * 32 + (swz % 64) / 2; }
__host__ __device__ __forceinline__ int perm32(int rho) { const int n = rho >> 4, i = rho & 15; return 8 * (i >> 2) + 4 * n + (i & 3); }

struct Unit { int pm, pn; };
struct Gemm { const bf16_t* A; const bf16_t* Bt; int K; };

struct P1Order {
    int G, c;
    __device__ __forceinline__ bool next(int i, Unit& u) const {
        const int L = i * G + c; if (L >= 1936) return false;
        if (L >= 1920) { const int j = L - 1920; u.pm = 32 + (j >> 3); u.pn = 60 + (j & 7); return true; }
        const int wgid = (L % NXCD) * 240 + L / NXCD;
        const int w = wgid % 480; u.pm = (wgid / 480) * WGM + (w % WGM); u.pn = w / WGM; return true;
    }
    __device__ __forceinline__ void a_ready(const Unit&) const {}
    __device__ __forceinline__ void done(const Unit&) const {}
};
struct BranchOrder {
    int pm, pn;
    __device__ __forceinline__ bool next(int i, Unit& u) const { if (i >= 3) return false; u.pm = i * 32 + pm; u.pn = i * 8 + pn; return true; }
    __device__ __forceinline__ void a_ready(const Unit&) const {}
    __device__ __forceinline__ void done(const Unit&) const {}
};
struct OneOrder {
    int pm, pn;
    __device__ __forceinline__ bool next(int i, Unit& u) const { if (i >= 1) return false; u.pm = pm; u.pn = pn; return true; }
    __device__ __forceinline__ void a_ready(const Unit&) const {}
    __device__ __forceinline__ void done(const Unit&) const {}
};


template <class Epi, class Sched, bool ALIGN_EPI = false, bool SP2 = false>
__device__ __forceinline__ void gemm_phase(PG8_LAS unsigned char* lds, const Gemm g, const Sched& S, const Epi& E) {
    const int tid = threadIdx.x, wid = __builtin_amdgcn_readfirstlane(tid >> 6), lane = tid & 63, wr = wid >> 2, wc = wid & 3, fr = lane & 15, fq = lane >> 4;
    const int K = g.K, nt = K / BK;
    unsigned voffA[2], voffB[2];
#pragma unroll
    for (int i = 0; i < 2; ++i) { int R, C; stage_rc(tid * 16 + i * 8192, R, C); const int Rb = Epi::PERM ? ((R & ~31) + perm32(R & 31)) : R;
        voffA[i] = (unsigned)(R * K + C) * 2u; voffB[i] = (unsigned)(Rb * K + C) * 2u; }
    const size_t kstep = (size_t)(BK * 2);
    const size_t hstep = (size_t)HALF * K * 2;
    const size_t tstep = 2 * hstep;
    const unsigned ldsw = (unsigned)wid * 1024u;
    const int aoff = lds_byte(wr * 64 + fr, fq * 8), boff = lds_byte(wc * 32 + fr, fq * 8);
#define PG8_SA(b, h) (((b) * 2 + (h)) * HTB)
#define PG8_SB(b, h) ((4 + (b) * 2 + (h)) * HTB)
#define PG8_STAGE(bufoff, gbase, voff) do { _Pragma("unroll") for (int _i = 0; _i < 2; ++_i) \
        __builtin_amdgcn_global_load_lds((const unsigned*)((const char*)(gbase) + (voff)[_i]), (PG8_LAS unsigned*)(lds + (bufoff) + ldsw + _i * 8192), 16, 0, 0); } while (0)
#define PG8_LDA(dst, b, h) do { _Pragma("unroll") for (int m = 0; m < 4; ++m) _Pragma("unroll") for (int k = 0; k < 2; ++k) dst[m][k] = *(const PG8_LAS bf16x8*)(lds + PG8_SA(b, h) + aoff + m * 2048 + k * 1024); } while (0)
#define PG8_LDB(dst, b, h) do { _Pragma("unroll") for (int n = 0; n < 2; ++n) _Pragma("unroll") for (int k = 0; k < 2; ++k) dst[n][k] = *(const PG8_LAS bf16x8*)(lds + PG8_SB(b, h) + boff + n * 2048 + k * 1024); } while (0)
#define PG8_MMA(ai, bj, At, Bt) do { __builtin_amdgcn_s_setprio(1); _Pragma("unroll") for (int m = 0; m < 4; ++m) _Pragma("unroll") for (int n = 0; n < 2; ++n) _Pragma("unroll") for (int k = 0; k < 2; ++k) \
        acc[ai][bj][m][n] = __builtin_amdgcn_mfma_f32_16x16x32_bf16(Bt[n][k], At[m][k], acc[ai][bj][m][n], 0, 0, 0); __builtin_amdgcn_s_setprio(0); } while (0)
#define PG8_WAIT_V(n) asm volatile("s_waitcnt vmcnt(" #n ")" ::: "memory")
#define PG8_WAIT_L(n) asm volatile("s_waitcnt lgkmcnt(" #n ")" ::: "memory")
#define PG8_BAR __builtin_amdgcn_s_barrier()
#define PG8_SCHED __builtin_amdgcn_sched_barrier(0)
    Unit cur, nxt; int ui = 0;
    if (!S.next(0, cur)) return;
    f32x4 acc[2][2][4][2];
#pragma unroll
    for (int a = 0; a < 2; ++a)
#pragma unroll
        for (int b = 0; b < 2; ++b)
#pragma unroll
            for (int m = 0; m < 4; ++m)
#pragma unroll
                for (int n = 0; n < 2; ++n) acc[a][b][m][n] = (f32x4){0.f, 0.f, 0.f, 0.f};
    bf16x8 At[4][2], B0[2][2], B1[2][2];
    const char* cA = (const char*)g.A + (size_t)cur.pm * tstep; const char* cB = (const char*)g.Bt + (size_t)cur.pn * tstep;
    S.a_ready(cur);
    if constexpr (SP2) {
        PG8_STAGE(PG8_SB(0, 0), cB, voffB); PG8_STAGE(PG8_SB(0, 1), cB + hstep, voffB); PG8_STAGE(PG8_SA(0, 0), cA, voffA); PG8_STAGE(PG8_SA(0, 1), cA + hstep, voffA);
        if (wr == 1) PG8_BAR;
        PG8_WAIT_V(2); PG8_BAR;
        PG8_STAGE(PG8_SB(1, 0), cB + kstep, voffB); PG8_STAGE(PG8_SA(1, 0), cA + kstep, voffA); PG8_STAGE(PG8_SB(1, 1), cB + hstep + kstep, voffB);
        PG8_WAIT_V(6); PG8_BAR;
    } else {
        PG8_STAGE(PG8_SB(0, 0), cB, voffB); PG8_STAGE(PG8_SA(0, 0), cA, voffA); PG8_STAGE(PG8_SB(0, 1), cB + hstep, voffB); PG8_STAGE(PG8_SA(0, 1), cA + hstep, voffA);
        if (wr == 1) PG8_BAR;
        PG8_WAIT_V(4); PG8_BAR;
        PG8_STAGE(PG8_SB(1, 0), cB + kstep, voffB); PG8_STAGE(PG8_SA(1, 0), cA + kstep, voffA); PG8_STAGE(PG8_SB(1, 1), cB + hstep + kstep, voffB);
        PG8_WAIT_V(6); PG8_BAR;
    }
    for (;;) {
        const bool has_next = S.next(ui + 1, nxt);
        const char* nA = has_next ? (const char*)g.A + (size_t)nxt.pm * tstep : cA; const char* nB = has_next ? (const char*)g.Bt + (size_t)nxt.pn * tstep : cB;
        for (int t = 0; t < nt; t += 2) {
            const bool last = (t == nt - 2);
            const char* a1 = cA + (size_t)(t + 1) * kstep;
            const char* a2 = last ? nA : cA + (size_t)(t + 2) * kstep; const char* b2 = last ? nB : cB + (size_t)(t + 2) * kstep;
            const char* a3 = a2 + kstep; const char* b3 = b2 + kstep;
            if (last && has_next) S.a_ready(nxt);
            if constexpr (SP2) {
            PG8_LDB(B0, 0, 0); PG8_LDB(B1, 0, 1); PG8_SCHED; PG8_LDA(At, 0, 0); PG8_STAGE(PG8_SA(1, 1), a1 + hstep, voffA);
            PG8_WAIT_V(8); PG8_WAIT_L(0); PG8_BAR; PG8_MMA(0, 0, At, B0); PG8_MMA(0, 1, At, B1); PG8_BAR; PG8_SCHED;
            PG8_LDA(At, 0, 1); PG8_STAGE(PG8_SB(0, 0), b2, voffB); PG8_STAGE(PG8_SB(0, 1), b2 + hstep, voffB); PG8_STAGE(PG8_SA(0, 0), a2, voffA);
            PG8_WAIT_V(8); PG8_WAIT_L(0); PG8_BAR; PG8_MMA(1, 0, At, B0); PG8_MMA(1, 1, At, B1); PG8_BAR; PG8_SCHED;
            PG8_LDB(B0, 1, 0); PG8_LDB(B1, 1, 1); PG8_SCHED; PG8_LDA(At, 1, 0); PG8_STAGE(PG8_SA(0, 1), a2 + hstep, voffA);
            PG8_WAIT_V(8); PG8_WAIT_L(0); PG8_BAR; PG8_MMA(0, 0, At, B0); PG8_MMA(0, 1, At, B1); PG8_BAR; PG8_SCHED;
            PG8_LDA(At, 1, 1); PG8_STAGE(PG8_SB(1, 0), b3, voffB); PG8_STAGE(PG8_SB(1, 1), b3 + hstep, voffB); PG8_STAGE(PG8_SA(1, 0), a3, voffA);
            PG8_WAIT_V(8); PG8_WAIT_L(0); PG8_BAR; PG8_MMA(1, 0, At, B0); PG8_MMA(1, 1, At, B1); PG8_BAR; PG8_SCHED;
            } else {
            PG8_LDB(B0, 0, 0); PG8_SCHED; PG8_LDA(At, 0, 0); PG8_STAGE(PG8_SA(1, 1), a1 + hstep, voffA);
            PG8_WAIT_L(8); PG8_BAR; PG8_WAIT_L(0); PG8_MMA(0, 0, At, B0); PG8_BAR; PG8_SCHED;
            PG8_LDB(B1, 0, 1); PG8_STAGE(PG8_SB(0, 0), b2, voffB);
            PG8_BAR; PG8_WAIT_L(0); PG8_MMA(0, 1, At, B1); PG8_BAR;
            PG8_LDA(At, 0, 1); PG8_STAGE(PG8_SA(0, 0), a2, voffA);
            PG8_BAR; PG8_WAIT_L(0); PG8_MMA(1, 0, At, B0); PG8_BAR; PG8_SCHED;
            PG8_STAGE(PG8_SB(0, 1), b2 + hstep, voffB);
            PG8_WAIT_V(6); PG8_BAR; PG8_MMA(1, 1, At, B1); PG8_BAR;
            PG8_LDB(B0, 1, 0); PG8_SCHED; PG8_LDA(At, 1, 0); PG8_STAGE(PG8_SA(0, 1), a2 + hstep, voffA);
            PG8_WAIT_L(8); PG8_BAR; PG8_WAIT_L(0); PG8_MMA(0, 0, At, B0); PG8_BAR; PG8_SCHED;
            PG8_LDB(B1, 1, 1); PG8_STAGE(PG8_SB(1, 0), b3, voffB);
            PG8_BAR; PG8_WAIT_L(0); PG8_MMA(0, 1, At, B1); PG8_BAR;
            PG8_LDA(At, 1, 1); PG8_STAGE(PG8_SA(1, 0), a3, voffA);
            PG8_BAR; PG8_WAIT_L(0); PG8_MMA(1, 0, At, B0); PG8_BAR; PG8_SCHED;
            PG8_STAGE(PG8_SB(1, 1), b3 + hstep, voffB);
            PG8_WAIT_V(6); PG8_BAR; PG8_MMA(1, 1, At, B1); PG8_BAR;
            }
        }
        if constexpr (ALIGN_EPI) { if (wr == 0) PG8_BAR; }
        bool zacc = true;
        if constexpr (!Epi::AFTER_DRAIN) { zacc = E(acc, cur, wr, wc, fr, fq); S.done(cur); }
        if (!has_next) break;
        if (zacc) {
#pragma unroll
        for (int a = 0; a < 2; ++a)
#pragma unroll
            for (int b = 0; b < 2; ++b)
#pragma unroll
                for (int m = 0; m < 4; ++m)
#pragma unroll
                    for (int n = 0; n < 2; ++n) acc[a][b][m][n] = (f32x4){0.f, 0.f, 0.f, 0.f};
        }
        cur = nxt; cA = nA; cB = nB; ++ui;
        if constexpr (ALIGN_EPI) { if (wr == 1) PG8_BAR; }
    }
    PG8_WAIT_V(0);
    if constexpr (!ALIGN_EPI) { if (wr == 0) PG8_BAR; }
    PG8_BAR;
    if constexpr (Epi::AFTER_DRAIN) { E.fused(acc, cur, wr, wc, fr, fq, lds, wid, lane); S.done(cur); }
#undef PG8_SA
#undef PG8_SB
#undef PG8_STAGE
#undef PG8_LDA
#undef PG8_LDB
#undef PG8_MMA
#undef PG8_WAIT_V
#undef PG8_WAIT_L
#undef PG8_BAR
#undef PG8_SCHED
}

constexpr float LOG2E = 1.4426950408889634f;
__device__ __forceinline__ float act_gate(float x, float ka, float kb, bool one) {
    const float t = x * (ka + kb * (x * x));
    const float r = __builtin_amdgcn_rcpf(1.0f + __builtin_amdgcn_exp2f(t));
    return (one ? 1.0f : x) * r;
}
struct EpiProj {
    static constexpr bool PERM = true, AFTER_DRAIN = false;
    bf16_t* act; bf16_t* gates; bf16_t* memk; float* kmean; float* vst;
    __device__ __forceinline__ void plain_store(const f32x4 (&acc)[2][2][4][2], bf16_t* base, int ldc, int row0, int col0) const {
#pragma unroll
        for (int ai = 0; ai < 2; ++ai)
#pragma unroll
            for (int m = 0; m < 4; ++m) { bf16_t* rowp = base + (size_t)(row0 + ai * HALF + m * 16) * ldc + col0;
#pragma unroll
                for (int bj = 0; bj < 2; ++bj) { const f32x4 v0 = acc[ai][bj][m][0], v1 = acc[ai][bj][m][1];
                    u32x4 w; w.x = cvt_pk_bf16(v0[0], v0[1]); w.y = cvt_pk_bf16(v0[2], v0[3]); w.z = cvt_pk_bf16(v1[0], v1[1]); w.w = cvt_pk_bf16(v1[2], v1[3]);
                    *(u32x4*)(rowp + bj * HALF) = w; } }
    }
    template <bool STATS> __device__ __forceinline__ void act_store(const f32x4 (&acc)[2][2][4][2], bf16_t* base, int ldc, int row0, int col0, float ka, float kb, bool one, float* vsl, int fq) const {
#pragma unroll
        for (int ai = 0; ai < 2; ++ai)
#pragma unroll
            for (int m = 0; m < 4; ++m) { bf16_t* rowp = base + (size_t)(row0 + ai * HALF + m * 16) * ldc + col0; float rs = 0.f, rq = 0.f;
#pragma unroll
                for (int bj = 0; bj < 2; ++bj) { f32x4 v0 = acc[ai][bj][m][0], v1 = acc[ai][bj][m][1];
#pragma unroll
                    for (int j = 0; j < 4; ++j) { v0[j] = act_gate(v0[j], ka, kb, one); v1[j] = act_gate(v1[j], ka, kb, one); }
                    if (STATS) {
#pragma unroll
                        for (int j = 0; j < 4; ++j) { rs += v0[j] + v1[j]; rq += v0[j] * v0[j] + v1[j] * v1[j]; } }
                    u32x4 w; w.x = cvt_pk_bf16(v0[0], v0[1]); w.y = cvt_pk_bf16(v0[2], v0[3]); w.z = cvt_pk_bf16(v1[0], v1[1]); w.w = cvt_pk_bf16(v1[2], v1[3]);
                    *(u32x4*)(rowp + bj * HALF) = w; }
                if (STATS) { rs += __shfl_xor(rs, 16); rs += __shfl_xor(rs, 32); rq += __shfl_xor(rq, 16); rq += __shfl_xor(rq, 32);
                    if (fq == 0) *(f32x2v*)(vsl + (size_t)(ai * HALF + m * 16) * 32) = (f32x2v){rs, rq}; } }
    }
    __device__ __forceinline__ bool operator()(f32x4 (&acc)[2][2][4][2], const Unit& u, int wr, int wc, int fr, int fq) const {
        const int pn = u.pn, row0 = u.pm * BM + wr * 64 + fr, cw = wc * 32 + 8 * fq;
        constexpr float KG = -2.0f * 0.7978845608028654f * LOG2E;
        if (pn >= 60) { const int j = pn - 60; plain_store(acc, memk + (size_t)(j >> 2) * ((size_t)MM * W), W, row0 - M, (j & 3) * 256 + cw); return true; }
        if (pn >= 36) { act_store<false>(acc, gates, 3 * DM, row0, (pn - 36) * 256 + cw, -LOG2E, 0.f, true, nullptr, fq); return true; }
        const int seg = pn >> 2, col0 = (pn & 3) * 256 + cw; bf16_t* base = act + (size_t)seg * ACT_STRIDE;
        if (seg == A_VG) { act_store<true>(acc, base, W, row0, col0, KG, KG * 0.044715f, false, vst + ((size_t)row0 * 16 + (pn & 3) * 4 + wc) * 2, fq); return true; }
        if (seg == A_ZA || seg == A_ZG || seg == A_ZC || seg == A_UG) { const bool gl = seg == A_UG; act_store<false>(acc, base, W, row0, col0, gl ? KG : -LOG2E, gl ? KG * 0.044715f : 0.f, false, nullptr, fq); return true; }
        plain_store(acc, base, W, row0, col0);
        if (seg == A_KA) {
            float* kp = kmean + (size_t)wr * KM_SLOT + (size_t)u.pm * W + col0;
#pragma unroll
            for (int bj = 0; bj < 2; ++bj)
#pragma unroll
                for (int n = 0; n < 2; ++n) { f32x4 sv;
#pragma unroll
                    for (int j = 0; j < 4; ++j) { float s = 0.f;
#pragma unroll
                        for (int ai = 0; ai < 2; ++ai)
#pragma unroll
                            for (int m = 0; m < 4; ++m) s += acc[ai][bj][m][n][j];
                        s += __shfl_xor(s, 1); s += __shfl_xor(s, 2); s += __shfl_xor(s, 4); s += __shfl_xor(s, 8); sv[j] = s * (1.0f / 256.0f); }
                    if (fr == 0) *(f32x4*)(kp + bj * HALF + 4 * n) = sv; }
        }
        return true;
    }
};
struct EpiBranch {
    static constexpr bool PERM = true, AFTER_DRAIN = false;
    const bf16_t* gates; bf16_t* merged;
    __device__ __forceinline__ bool operator()(f32x4 (&acc)[2][2][4][2], const Unit& u, int wr, int wc, int fr, int fq) const {
        const int br = u.pm >> 5, pm = u.pm & 31, pn = u.pn & 7;
        const int row0 = pm * BM + wr * 64 + fr, col0 = pn * BM + wc * 32 + 8 * fq;
#pragma unroll
        for (int ai = 0; ai < 2; ++ai)
#pragma unroll
            for (int m = 0; m < 4; ++m) { const int row = row0 + ai * HALF + m * 16; const bf16_t* gp = gates + (size_t)row * (3 * DM) + br * DM + col0;
#pragma unroll
                for (int bj = 0; bj < 2; ++bj) { const u32x4 ga = *(const u32x4*)(gp + bj * HALF);
                    float g[8] = {bflo(ga.x), bfhi(ga.x), bflo(ga.y), bfhi(ga.y), bflo(ga.z), bfhi(ga.z), bflo(ga.w), bfhi(ga.w)};
                    if (br < 2) { const u32x4 gb = *(const u32x4*)(gp + DM + bj * HALF);
                        const float h[8] = {bflo(gb.x), bfhi(gb.x), bflo(gb.y), bfhi(gb.y), bflo(gb.z), bfhi(gb.z), bflo(gb.w), bfhi(gb.w)};
#pragma unroll
                        for (int e = 0; e < 8; ++e) g[e] = fmaxf(g[e], 1e-18f) * __builtin_amdgcn_rcpf(fmaxf(h[e], 1e-18f));
                    } else {
#pragma unroll
                        for (int e = 0; e < 8; ++e) g[e] = fmaxf(g[e], 1e-18f); }
#pragma unroll
                    for (int j = 0; j < 4; ++j) { acc[ai][bj][m][0][j] *= g[j]; acc[ai][bj][m][1][j] *= g[4 + j]; }
                    if (br == 2) { const f32x4 v0 = acc[ai][bj][m][0], v1 = acc[ai][bj][m][1];
                        u32x4 w; w.x = cvt_pk_bf16(v0[0], v0[1]); w.y = cvt_pk_bf16(v0[2], v0[3]); w.z = cvt_pk_bf16(v1[0], v1[1]); w.w = cvt_pk_bf16(v1[2], v1[3]);
                        *(u32x4*)(merged + (size_t)row * DM + col0 + bj * HALF) = w; } }
                if (m & 1) asm volatile("" ::: "memory"); }
        return br == 2;
    }
};
struct EpiOutLN {
    static constexpr bool PERM = false, AFTER_DRAIN = true;
    const float* x; float* out; const float* lng; const float* lnb; float* lns; XcdBarrier bar;
    __device__ __forceinline__ void fused(f32x4 (&acc)[2][2][4][2], const Unit& u, int wr, int wc, int fr, int fq, PG8_LAS unsigned char* lds, int wid, int lane) const {
        PG8_LAS f32x2v* P = (PG8_LAS f32x2v*)lds;
        PG8_LAS f32x2v* S = (PG8_LAS f32x2v*)(lds + 8192);
        const int col0 = u.pn * BM + wc * 32 + 4 * fq;
#pragma unroll
        for (int ai = 0; ai < 2; ++ai)
#pragma unroll
            for (int m = 0; m < 4; ++m) { const size_t off = (size_t)(u.pm * BM + ai * HALF + wr * 64 + m * 16 + fr) * DM + col0;
#pragma unroll
                for (int bj = 0; bj < 2; ++bj)
#pragma unroll
                    for (int n = 0; n < 2; ++n) { const f32x4 xv = *(const f32x4*)(x + off + bj * HALF + n * 16); acc[ai][bj][m][n] = acc[ai][bj][m][n] + xv * DN_ALPHA; }
                asm volatile("" : "+v"(acc[ai][0][m][0]), "+v"(acc[ai][0][m][1]), "+v"(acc[ai][1][m][0]), "+v"(acc[ai][1][m][1]));
                if (m & 1) asm volatile("" ::: "memory"); }
#pragma unroll
        for (int ai = 0; ai < 2; ++ai)
#pragma unroll
            for (int m = 0; m < 4; ++m) {
                float s = 0.f;
#pragma unroll
                for (int bj = 0; bj < 2; ++bj)
#pragma unroll
                    for (int n = 0; n < 2; ++n) { const f32x4 v = acc[ai][bj][m][n]; s += (v[0] + v[1]) + (v[2] + v[3]); }
                s += __shfl_xor(s, 16); s += __shfl_xor(s, 32);
                const float mw = s * (1.0f / 64.0f); float q = 0.f;
#pragma unroll
                for (int bj = 0; bj < 2; ++bj)
#pragma unroll
                    for (int n = 0; n < 2; ++n) { const f32x4 d = acc[ai][bj][m][n] - mw; q += (d[0] * d[0] + d[1] * d[1]) + (d[2] * d[2] + d[3] * d[3]); }
                q += __shfl_xor(q, 16); q += __shfl_xor(q, 32);
                if (fq == 0) P[(ai * HALF + wr * 64 + m * 16 + fr) * 4 + wc] = (f32x2v){mw, q};
            }
        asm volatile("s_waitcnt lgkmcnt(0)" ::: "memory"); __builtin_amdgcn_s_barrier(); asm volatile("" ::: "memory");
        const int row = wid * 32 + (lane & 31);
        if (lane < 32) {
            const f32x2v a = P[row * 4 + 0], b = P[row * 4 + 1], c = P[row * 4 + 2], d = P[row * 4 + 3];
            const float mt = (a.x + b.x + c.x + d.x) * 0.25f;
            const float da = a.x - mt, db = b.x - mt, dc = c.x - mt, dd = d.x - mt;
            const float m2 = (a.y + b.y) + (c.y + d.y) + 64.0f * ((da * da + db * db) + (dc * dc + dd * dd));
            *(f32x2v*)(lns + ((size_t)(u.pm * BM + row) * 8 + u.pn) * 2) = (f32x2v){mt, m2};
        }
        xcd_barrier(bar);
        if (lane < 32) {
            const f32x4* sp = (const f32x4*)(lns + (size_t)(u.pm * BM + row) * 16); float mt[8], m2[8];
#pragma unroll
            for (int t = 0; t < 4; ++t) { const f32x4 w = sp[t]; mt[2 * t] = w[0]; m2[2 * t] = w[1]; mt[2 * t + 1] = w[2]; m2[2 * t + 1] = w[3]; }
            float ms = 0.f;
#pragma unroll
            for (int t = 0; t < 8; ++t) ms += mt[t];
            const float mean = ms * 0.125f; float q = 0.f;
#pragma unroll
            for (int t = 0; t < 8; ++t) { const float dm = mt[t] - mean; q += m2[t] + 256.0f * dm * dm; }
            S[row] = (f32x2v){mean, 1.0f / sqrtf(q * (1.0f / DM) + LN_EPS)};
        }
        asm volatile("s_waitcnt lgkmcnt(0)" ::: "memory"); __builtin_amdgcn_s_barrier(); asm volatile("" ::: "memory");
        f32x4 gv[2][2], bv[2][2];
#pragma unroll
        for (int bj = 0; bj < 2; ++bj)
#pragma unroll
            for (int n = 0; n < 2; ++n) { gv[bj][n] = *(const f32x4*)(lng + col0 + bj * HALF + n * 16); bv[bj][n] = *(const f32x4*)(lnb + col0 + bj * HALF + n * 16); }
#pragma unroll
        for (int ai = 0; ai < 2; ++ai)
#pragma unroll
            for (int m = 0; m < 4; ++m) { const int r = ai * HALF + wr * 64 + m * 16 + fr; const f32x2v sr = S[r]; const size_t off = (size_t)(u.pm * BM + r) * DM + col0;
#pragma unroll
                for (int bj = 0; bj < 2; ++bj)
#pragma unroll
                    for (int n = 0; n < 2; ++n) { const f32x4 o = (acc[ai][bj][m][n] - sr.x) * sr.y * gv[bj][n] + bv[bj][n]; *(f32x4*)(out + off + bj * HALF + n * 16) = o; } }
    }
};
}


constexpr int NWAVES = 8;
constexpr int RING_BYTES = 131072;
constexpr int LDSCTL_OFF = RING_BYTES, MISC_OFF = LDSCTL_OFF + 320;
constexpr int LDS_BYTES = 147456;
constexpr int CW_TMO = 0, CW_CODE = 1, CW_BAR = 4096;
constexpr int N_PHASES = 6;

struct Frame {
    LAS unsigned char* lds;
    volatile LAS unsigned* MISC;
    gu32* ctl;
    int tid, lane, wave, vcu, G;
    const float *x, *mem, *w_in, *w_mk, *w_mv, *w_s, *b_s, *lnvg, *lnvb, *wba, *wbg, *wbm, *w_out, *ln_g, *ln_b; float* out;
    unsigned char* ws;
};

__device__ __forceinline__ float wave_sum(float v) {
#pragma unroll
    for (int o = 1; o < 64; o <<= 1) v += __shfl_xor(v, o);
    return v;
}
__device__ __forceinline__ void p0_transpose_item(const float* Wm, int K, int N, bf16* WT, int row_off, LAS float* scr, int item, int lane) {
    const int nblk = N / 32, kb = item / nblk, nb = item % nblk, k0 = 64 * kb, n0 = 32 * nb;
#pragma unroll 8
    for (int i = 0; i < 32; ++i) { const int kk = 2 * i + (lane >> 5); scr[kk * 33 + (lane & 31)] = Wm[(size_t)(k0 + kk) * N + n0 + (lane & 31)]; }
    LDS_WAIT(); asm volatile("" ::: "memory");
    const int c = lane & 7;
#pragma unroll
    for (int j = 0; j < 4; ++j) { const int n = (lane >> 3) + 8 * j; const LAS float* s = scr + (8 * c) * 33 + n;
        v4u o; o.x = pk2(s[0 * 33], s[1 * 33]); o.y = pk2(s[2 * 33], s[3 * 33]); o.z = pk2(s[4 * 33], s[5 * 33]); o.w = pk2(s[6 * 33], s[7 * 33]);
        *(GAS v4u*)(WT + (size_t)(row_off + n0 + n) * K + k0 + 8 * c) = o; }
    LDS_WAIT(); asm volatile("" ::: "memory");
}
__device__ __forceinline__ void p0_prologue(Frame& F) {
    LAS float* scr = (LAS float*)(F.lds + F.wave * 16384);
    const int gw = F.vcu * NWAVES + F.wave, NGW = F.G * NWAVES, lane = F.lane;
    bf16* WIN = (bf16*)(F.ws + WS_WIN); bf16* WMKV = (bf16*)(F.ws + WS_WMKV); bf16* WBR = (bf16*)(F.ws + WS_WBR); bf16* WOUT = (bf16*)(F.ws + WS_WOUT);
    constexpr int I_IN = (DM / 64) * (NPROJ / 32), I_MK = (DM / 64) * (W / 32), I_BR = (W / 64) * (DM / 32), I_OUT = (DM / 64) * (DM / 32);
    constexpr int NITEMS = I_IN + 2 * I_MK + 3 * I_BR + I_OUT;
    for (int it = gw; it < NITEMS; it += NGW) {
        int r = it;
        if (r < I_IN) { p0_transpose_item(F.w_in, DM, NPROJ, WIN, 0, scr, r, lane); continue; } r -= I_IN;
        if (r < I_MK) { p0_transpose_item(F.w_mk, DM, W, WMKV, 0, scr, r, lane); continue; } r -= I_MK;
        if (r < I_MK) { p0_transpose_item(F.w_mv, DM, W, WMKV, W, scr, r, lane); continue; } r -= I_MK;
        if (r < I_BR) { p0_transpose_item(F.wba, W, DM, WBR, 0, scr, r, lane); continue; } r -= I_BR;
        if (r < I_BR) { p0_transpose_item(F.wbg, W, DM, WBR, DM, scr, r, lane); continue; } r -= I_BR;
        if (r < I_BR) { p0_transpose_item(F.wbm, W, DM, WBR, 2 * DM, scr, r, lane); continue; } r -= I_BR;
        p0_transpose_item(F.w_out, DM, DM, WOUT, 0, scr, r, lane);
    }
    { GAS v4u* xb = (GAS v4u*)(F.ws + WS_XB); const GAS f32x4* xs = (const GAS f32x4*)F.x;
      for (int i = gw; i < (M * DM) / 512; i += NGW) { const size_t ch = (size_t)i * 64 + lane; const f32x4 a = xs[2 * ch], b = xs[2 * ch + 1];
          v4u o; o.x = pk2(a[0], a[1]); o.y = pk2(a[2], a[3]); o.z = pk2(b[0], b[1]); o.w = pk2(b[2], b[3]); xb[ch] = o; }
      GAS v4u* mb = (GAS v4u*)(F.ws + WS_MEMB); const GAS f32x4* ms = (const GAS f32x4*)F.mem;
      for (int i = gw; i < (MM * DM) / 512; i += NGW) { const size_t ch = (size_t)i * 64 + lane; const f32x4 a = ms[2 * ch], b = ms[2 * ch + 1];
          v4u o; o.x = pk2(a[0], a[1]); o.y = pk2(a[2], a[3]); o.z = pk2(b[0], b[1]); o.w = pk2(b[2], b[3]); mb[ch] = o; } }
    { bf16* wsb = (bf16*)(F.ws + WS_WSB); float* c2 = (float*)(F.ws + WS_C2);
      for (int row = gw; row < SG * SC; row += NGW) { const int t = row % SC; float s = 0.f;
#pragma unroll
          for (int h = 0; h < 2; ++h) { const int sidx = lane + 64 * h; const float w = sidx <= t ? F.w_s[(size_t)row * SC + sidx] : 0.f; const unsigned short wb = (unsigned short)f2bf(w); wsb[(size_t)row * SC + sidx] = wb; s += bf2f(wb); }
          s = wave_sum(s); if (lane == 0) c2[row] = s; } }
}

struct Args { const float* in[15]; float* out; unsigned char* ws; int ph_lo, ph_hi, li, pad; };
__global__ void __launch_bounds__(NWAVES * 64, 2) mk_fwd(Args args) {
    extern __shared__ __attribute__((aligned(16))) unsigned char lds[];
    Frame F;
    F.lds = (LAS unsigned char*)lds;
    F.MISC = (volatile LAS unsigned*)(F.lds + MISC_OFF);
    F.tid = threadIdx.x; F.lane = F.tid & 63; F.wave = __builtin_amdgcn_readfirstlane(F.tid >> 6);
    F.G = gridDim.x; { const int bx = blockIdx.x; F.vcu = (F.G % 8 == 0) ? (bx % 8) * (F.G / 8) + bx / 8 : bx; }
    F.ws = args.ws; F.ctl = (gu32*)(args.ws + WS_CTL);
    F.x = args.in[0]; F.mem = args.in[1]; F.w_in = args.in[2]; F.w_mk = args.in[3]; F.w_mv = args.in[4]; F.w_s = args.in[5]; F.b_s = args.in[6]; F.lnvg = args.in[7]; F.lnvb = args.in[8];
    F.wba = args.in[9]; F.wbg = args.in[10]; F.wbm = args.in[11]; F.w_out = args.in[12]; F.ln_g = args.in[13]; F.ln_b = args.in[14]; F.out = args.out;
    for (int u = F.tid; u < (LDS_BYTES - LDSCTL_OFF) / 4; u += NWAVES * 64) ((LAS unsigned*)(F.lds + LDSCTL_OFF))[u] = 0u;
    __syncthreads();
    XcdBarrier bar = xcd_barrier_post((unsigned*)(F.ctl + CW_BAR) + args.li * XCD_BAR_WORDS, F.MISC + 8);
    const int lo = args.ph_lo, hi = args.ph_hi;
#define IN(k) (lo <= (k) && (k) < hi)
#define BOTH(k) (IN(k) && IN((k) + 1))
    unsigned char* ws = args.ws;
    if (IN(0)) { p0_prologue(F); if (BOTH(0)) xcd_barrier(bar); }
    if (IN(1)) {
        pg8::Gemm g{(const bf16*)(ws + WS_XB), (const bf16*)(ws + WS_WIN), DM}; pg8::P1Order S{F.G, (int)blockIdx.x};
        pg8::EpiProj E{(bf16*)(ws + WS_ACT), (bf16*)(ws + WS_GATES), (bf16*)(ws + WS_MEMK), (float*)(ws + WS_KMEAN), (float*)(ws + WS_VSTATS)};
        pg8::gemm_phase<pg8::EpiProj, pg8::P1Order, true, true>(F.lds, g, S, E);
        if (BOTH(1)) xcd_barrier(bar);
    }
    const int tile = F.vcu;
    if (IN(4)) {
        pg8::Gemm g{(const bf16*)(ws + WS_Y), (const bf16*)(ws + WS_WBR), W}; pg8::BranchOrder S{tile >> 3, tile & 7};
        pg8::EpiBranch E{(const bf16*)(ws + WS_GATES), (bf16*)(ws + WS_MERGED)};
        if (F.G == 256) pg8::gemm_phase<pg8::EpiBranch, pg8::BranchOrder, false, true>(F.lds, g, S, E);
        if (BOTH(4)) xcd_barrier(bar);
    }
    if (IN(5)) {
        pg8::Gemm g{(const bf16*)(ws + WS_MERGED), (const bf16*)(ws + WS_WOUT), DM}; pg8::OneOrder S{tile >> 3, tile & 7};
        pg8::EpiOutLN E{F.x, F.out, F.ln_g, F.ln_b, (float*)(ws + WS_LNS), bar};
        if (F.G == 256) pg8::gemm_phase<pg8::EpiOutLN, pg8::OneOrder, false, true>(F.lds, g, S, E);
    }
#undef IN
#undef BOTH
}


#if HYBRID
__device__ __forceinline__ float sigmoidf_(float x) { return 1.f / (1.f + __expf(-x)); }
__device__ __forceinline__ float siluf_(float x) { return x * sigmoidf_(x); }
__device__ __forceinline__ float geluf_(float x) { return 0.5f * x * (1.f + tanhf(0.7978845608028654f * (x + 0.044715f * x * x * x))); }

struct LoadF32 { const float* p; __device__ float operator()(size_t i) const { return p[i]; } };
struct LoadBf { const bf16* p; __device__ float operator()(size_t i) const { return bf2f(p[i]); } };

template <class LA, class Epi>
__global__ void __launch_bounds__(256) ngemm(LA A, int lda, const float* B, int ldb, int K, Epi epi) {
    __shared__ float As[16][64 + 1], Bs[16][64 + 1];
    const int tx = threadIdx.x & 15, ty = threadIdx.x >> 4, m0 = blockIdx.y * 64, n0 = blockIdx.x * 64;
    float acc[4][4] = {};
    for (int k0 = 0; k0 < K; k0 += 16) {
        for (int i = threadIdx.x; i < 64 * 16; i += 256) { const int r = i >> 4, c = i & 15; As[c][r] = A((size_t)(m0 + r) * lda + k0 + c); }
        for (int i = threadIdx.x; i < 16 * 64; i += 256) { const int r = i >> 6, c = i & 63; Bs[r][c] = B[(size_t)(k0 + r) * ldb + n0 + c]; }
        __syncthreads();
#pragma unroll
        for (int kk = 0; kk < 16; ++kk) {
            float a[4], b[4];
#pragma unroll
            for (int i = 0; i < 4; ++i) { a[i] = As[kk][ty * 4 + i]; b[i] = Bs[kk][tx * 4 + i]; }
#pragma unroll
            for (int i = 0; i < 4; ++i)
#pragma unroll
                for (int j = 0; j < 4; ++j) acc[i][j] += a[i] * b[j];
        }
        __syncthreads();
    }
    for (int i = 0; i < 4; ++i) for (int j = 0; j < 4; ++j) epi(m0 + ty * 4 + i, n0 + tx * 4 + j, acc[i][j]);
}

struct EpiProjN {
    bf16* act; bf16* gates;
    __device__ void operator()(int m, int n, float v) const {
        if (n < 9 * W) { const int seg = n / W, c = n % W; float o = v;
            if (seg == A_ZA || seg == A_ZG || seg == A_ZC) o = siluf_(v); else if (seg == A_UG || seg == A_VG) o = geluf_(v);
            act[(size_t)seg * ACT_STRIDE + (size_t)m * W + c] = (bf16)f2bf(o); }
        else { gates[(size_t)m * (3 * DM) + (n - 9 * W)] = (bf16)f2bf(sigmoidf_(v)); }
    }
};
struct EpiStoreBf { bf16* o; int ldc; __device__ void operator()(int m, int n, float v) const { o[(size_t)m * ldc + n] = (bf16)f2bf(v); } };

__global__ void n_kmean(const bf16* KA, float* kmean) {
    const int pb = blockIdx.x;
    for (int c = threadIdx.x; c < W; c += blockDim.x) { float s = 0.f; for (int r = 0; r < MBLK; ++r) s += bf2f(KA[(size_t)(pb * MBLK + r) * W + c]); kmean[(size_t)pb * W + c] = s * (1.f / MBLK); kmean[KM_SLOT + (size_t)pb * W + c] = 0.f; }
}
__global__ void n_vstats(const bf16* VG, float* vst) {
    const int m = blockIdx.x; float s = 0.f, q = 0.f;
    for (int c = threadIdx.x; c < W; c += 64) { const float v = bf2f(VG[(size_t)m * W + c]); s += v; q += v * v; }
    for (int o = 32; o; o >>= 1) { s += __shfl_xor(s, o); q += __shfl_xor(q, o); }
    if (threadIdx.x < 16) { vst[((size_t)m * 16 + threadIdx.x) * 2] = threadIdx.x == 0 ? s : 0.f; vst[((size_t)m * 16 + threadIdx.x) * 2 + 1] = threadIdx.x == 0 ? q : 0.f; }
}
__global__ void __launch_bounds__(256) n_attn(const bf16* QA, const bf16* KA, const bf16* VA, const bf16* ZA, const float* kmean, bf16* YA) {
    __shared__ float q[AD], sc[NBLK], p[4 * MBLK], red[256]; __shared__ int selblk[4]; __shared__ int nsel;
    const int m = blockIdx.x, h = blockIdx.y, b = m / SEQ, t = m % SEQ, blk = t / MBLK, tid = threadIdx.x;
    if (tid < AD) q[tid] = bf2f(QA[(size_t)m * W + h * AD + tid]);
    __syncthreads();
    if (tid < NBLK) { float s = 0.f; for (int d = 0; d < AD; ++d) { const size_t ki = (size_t)(b * NBLK + tid) * W + h * AD + d; s += q[d] * (kmean[ki] + kmean[KM_SLOT + ki]); } sc[tid] = s; }
    __syncthreads();
    if (tid == 0) { unsigned used = 0; int ns = 0; const int want = blk < 3 ? blk : 3;
        for (int k = 0; k < want; ++k) { float best = -INFINITY; int bi = -1; for (int n = 0; n < blk; ++n) if (!((used >> n) & 1) && (bi < 0 || sc[n] > best)) { best = sc[n]; bi = n; } used |= 1u << bi; selblk[ns++] = bi; }
        selblk[ns++] = blk; nsel = ns; }
    __syncthreads();
    const int ns = nsel; const float scale = 0.08838834764831845f;
    float lmax = -INFINITY;
    for (int i = tid; i < ns * MBLK; i += 256) { const int kb = selblk[i / MBLK], kpos = kb * MBLK + (i % MBLK); float s = -INFINITY;
        if (kpos <= t) { s = 0.f; const bf16* kr = KA + (size_t)(b * SEQ + kpos) * W + h * AD; for (int d = 0; d < AD; ++d) s += q[d] * bf2f(kr[d]); s *= scale; }
        p[i] = s; lmax = fmaxf(lmax, s); }
    red[tid] = lmax; __syncthreads();
    for (int o = 128; o; o >>= 1) { if (tid < o) red[tid] = fmaxf(red[tid], red[tid + o]); __syncthreads(); }
    const float mx = red[0]; __syncthreads();
    float ls = 0.f;
    for (int i = tid; i < ns * MBLK; i += 256) { const float e = __expf(p[i] - mx); p[i] = e; ls += e; }
    red[tid] = ls; __syncthreads();
    for (int o = 128; o; o >>= 1) { if (tid < o) red[tid] += red[tid + o]; __syncthreads(); }
    const float inv = 1.f / red[0];
    if (tid < AD) { float o = 0.f;
        for (int i = 0; i < ns * MBLK; ++i) { const int kpos = selblk[i / MBLK] * MBLK + (i % MBLK); o += p[i] * bf2f(VA[(size_t)(b * SEQ + kpos) * W + h * AD + tid]); }
        const size_t oi = (size_t)m * W + h * AD + tid; YA[oi] = (bf16)f2bf(o * inv * bf2f(ZA[oi])); }
}
__global__ void __launch_bounds__(1024) n_sgu(const bf16* UG, const bf16* VG, const bf16* ZG, const float* vst, const float* w_s, const float* b_s, const float* lng, const float* lnb, bf16* YG) {
    __shared__ float mu[SC], rs[SC];
    const int m = blockIdx.x, t = m % SC, m0 = m - t, ch = threadIdx.x, g = ch / SGD;
    if (ch <= t) { float s = 0.f, q = 0.f; for (int j = 0; j < 16; ++j) { s += vst[((size_t)(m0 + ch) * 16 + j) * 2]; q += vst[((size_t)(m0 + ch) * 16 + j) * 2 + 1]; }
        const float mean = s / W, var = q / W - mean * mean; mu[ch] = mean; rs[ch] = rsqrtf(var + LN_EPS); }
    __syncthreads();
    float acc = 0.f; const float gm = lng[ch], bt = lnb[ch];
    for (int s = 0; s <= t; ++s) acc += w_s[((size_t)g * SC + t) * SC + s] * ((bf2f(VG[(size_t)(m0 + s) * W + ch]) - mu[s]) * rs[s] * gm + bt);
    acc += b_s[g * SC + t];
    const size_t oi = (size_t)m * W + ch; YG[oi] = (bf16)f2bf(bf2f(UG[oi]) * acc * bf2f(ZG[oi]));
}
__global__ void __launch_bounds__(256) n_mem(const bf16* QC, const bf16* ZC, const bf16* MK, const bf16* MV, bf16* YC) {
    __shared__ float q[MD], p[NMEM], red[256];
    const int m = blockIdx.x, h = blockIdx.y, b = m / SEQ, tid = threadIdx.x;
    q[tid] = bf2f(QC[(size_t)m * W + h * MD + tid]); __syncthreads();
    float s = 0.f; { const bf16* kr = MK + (size_t)(b * NMEM + tid) * W + h * MD; for (int d = 0; d < MD; ++d) s += q[d] * bf2f(kr[d]); s *= 0.0625f; }
    red[tid] = s; __syncthreads();
    for (int o = 128; o; o >>= 1) { if (tid < o) red[tid] = fmaxf(red[tid], red[tid + o]); __syncthreads(); }
    const float mx = red[0]; __syncthreads();
    const float e = __expf(s - mx); p[tid] = e; red[tid] = e; __syncthreads();
    for (int o = 128; o; o >>= 1) { if (tid < o) red[tid] += red[tid + o]; __syncthreads(); }
    const float inv = 1.f / red[0];
    float o = 0.f; for (int k = 0; k < NMEM; ++k) o += p[k] * bf2f(MV[(size_t)(b * NMEM + k) * W + h * MD + tid]);
    const size_t oi = (size_t)m * W + h * MD + tid; YC[oi] = (bf16)f2bf(o * inv * bf2f(ZC[oi]));
}
__global__ void __launch_bounds__(256) n_branch(const bf16* Y, const float* w0, const float* w1, const float* w2, const bf16* gates, bf16* merged) {
    __shared__ float As[16][65], Bs[16][65];
    const int tx = threadIdx.x & 15, ty = threadIdx.x >> 4, m0 = blockIdx.y * 64, n0 = blockIdx.x * 64;
    float tot[4][4] = {};
    for (int br = 0; br < 3; ++br) { const bf16* A = Y + (size_t)br * ACT_STRIDE; const float* B = br == 0 ? w0 : br == 1 ? w1 : w2; float acc[4][4] = {};
        for (int k0 = 0; k0 < W; k0 += 16) {
            for (int i = threadIdx.x; i < 1024; i += 256) { const int r = i >> 4, c = i & 15; As[c][r] = bf2f(A[(size_t)(m0 + r) * W + k0 + c]); }
            for (int i = threadIdx.x; i < 1024; i += 256) { const int r = i >> 6, c = i & 63; Bs[r][c] = B[(size_t)(k0 + r) * DM + n0 + c]; }
            __syncthreads();
            for (int kk = 0; kk < 16; ++kk) for (int i = 0; i < 4; ++i) for (int j = 0; j < 4; ++j) acc[i][j] += As[kk][ty * 4 + i] * Bs[kk][tx * 4 + j];
            __syncthreads(); }
        for (int i = 0; i < 4; ++i) for (int j = 0; j < 4; ++j) tot[i][j] += bf2f(gates[(size_t)(m0 + ty * 4 + i) * (3 * DM) + br * DM + n0 + tx * 4 + j]) * acc[i][j]; }
    for (int i = 0; i < 4; ++i) for (int j = 0; j < 4; ++j) merged[(size_t)(m0 + ty * 4 + i) * DM + n0 + tx * 4 + j] = (bf16)f2bf(tot[i][j]);
}
struct EpiResid { const float* x; float* h; __device__ void operator()(int m, int n, float v) const { const size_t i = (size_t)m * DM + n; h[i] = DN_ALPHA * x[i] + v; } };
__global__ void __launch_bounds__(256) n_ln(const float* h, const float* g, const float* b, float* out) {
    __shared__ float red[256]; const int m = blockIdx.x, tid = threadIdx.x; float s = 0.f;
    for (int c = tid; c < DM; c += 256) s += h[(size_t)m * DM + c];
    red[tid] = s; __syncthreads(); for (int o = 128; o; o >>= 1) { if (tid < o) red[tid] += red[tid + o]; __syncthreads(); }
    const float mean = red[0] / DM; __syncthreads(); float q = 0.f;
    for (int c = tid; c < DM; c += 256) { const float d = h[(size_t)m * DM + c] - mean; q += d * d; }
    red[tid] = q; __syncthreads(); for (int o = 128; o; o >>= 1) { if (tid < o) red[tid] += red[tid + o]; __syncthreads(); }
    const float rstd = rsqrtf(red[0] / DM + LN_EPS);
    for (int c = tid; c < DM; c += 256) out[(size_t)m * DM + c] = (h[(size_t)m * DM + c] - mean) * rstd * g[c] + b[c];
}

#endif


extern "C" void kernel_launch(void* const* d_in, const int* in_sizes, int n_in, void* d_out, int out_size, void* d_ws, size_t ws_size, hipStream_t stream) {
    static int grid = 0;
    if (grid == 0) {
        if (n_in != 15 || in_sizes[0] != M * DM || in_sizes[2] != DM * NPROJ || out_size != M * DM || ws_size < WS_END) { fprintf(stderr, "kernel_launch: unexpected shapes (n_in %d, ws %zu); nothing launched\n", n_in, ws_size); grid = -1; return; }
        int dev = 0, cus = 0, per_cu = 0;
        if (hipGetDevice(&dev) != hipSuccess || hipDeviceGetAttribute(&cus, hipDeviceAttributeMultiprocessorCount, dev) != hipSuccess) { grid = -1; return; }
        if (hipFuncSetAttribute((const void*)mk_fwd, hipFuncAttributeMaxDynamicSharedMemorySize, LDS_BYTES) != hipSuccess) { fprintf(stderr, "kernel_launch: hipFuncSetAttribute failed\n"); grid = -1; return; }
        if (hipOccupancyMaxActiveBlocksPerMultiprocessor(&per_cu, (const void*)mk_fwd, NWAVES * 64, LDS_BYTES) != hipSuccess || per_cu < 1) fprintf(stderr, "kernel_launch: occupancy query reports %d workgroups per CU\n", per_cu);
        (void)hipGetLastError();
        grid = cus;
        if (grid != 256) fprintf(stderr, "kernel_launch: %d CUs; the one-tile-per-workgroup phases need 256\n", grid);
    }
    if (grid < 0) return;
    (void)hipMemsetAsync((char*)d_ws + WS_CTL, 0, CTL_ZERO_BYTES, stream);
    Args a{};
    for (int i = 0; i < 15; ++i) a.in[i] = (const float*)d_in[i];
    a.out = (float*)d_out; a.ws = (unsigned char*)d_ws;
#if HYBRID
    unsigned char* ws = (unsigned char*)d_ws;
    bf16* act = (bf16*)(ws + WS_ACT); bf16* memk = (bf16*)(ws + WS_MEMK); bf16* memv = (bf16*)(ws + WS_MEMV); bf16* Y = (bf16*)(ws + WS_Y); float* kmean = (float*)(ws + WS_KMEAN); float* vst = (float*)(ws + WS_VSTATS);
    a.ph_lo = 0; a.ph_hi = 2; a.li = 0;
    hipLaunchKernelGGL(mk_fwd, dim3(grid), dim3(NWAVES * 64), LDS_BYTES, stream, a);
    n_attn<<<dim3(M, AH), 256, 0, stream>>>(act + A_QA * ACT_STRIDE, act + A_KA * ACT_STRIDE, act + A_VA * ACT_STRIDE, act + A_ZA * ACT_STRIDE, kmean, Y);
    n_sgu<<<M, 1024, 0, stream>>>(act + A_UG * ACT_STRIDE, act + A_VG * ACT_STRIDE, act + A_ZG * ACT_STRIDE, vst, (const float*)d_in[5], (const float*)d_in[6], (const float*)d_in[7], (const float*)d_in[8], Y + ACT_STRIDE);
    n_mem<<<dim3(M, MH), 256, 0, stream>>>(act + A_QC * ACT_STRIDE, act + A_ZC * ACT_STRIDE, memk, memv, Y + 2 * ACT_STRIDE);
#if HYBRID == 2
    { bf16* gates = (bf16*)(ws + WS_GATES); bf16* merged = (bf16*)(ws + WS_MERGED); float* hbuf = (float*)(ws + WS_H);
      n_branch<<<dim3(DM / 64, M / 64), 256, 0, stream>>>(Y, (const float*)d_in[9], (const float*)d_in[10], (const float*)d_in[11], gates, merged);
      ngemm<LoadBf, EpiResid><<<dim3(DM / 64, M / 64), 256, 0, stream>>>(LoadBf{merged}, DM, (const float*)d_in[12], DM, DM, EpiResid{(const float*)d_in[0], hbuf});
      n_ln<<<M, 256, 0, stream>>>(hbuf, (const float*)d_in[13], (const float*)d_in[14], (float*)d_out); }
#else
    a.ph_lo = 4; a.ph_hi = 6; a.li = 1;
    hipLaunchKernelGGL(mk_fwd, dim3(grid), dim3(NWAVES * 64), LDS_BYTES, stream, a);
#endif
#else
    a.ph_lo = 0; a.ph_hi = N_PHASES; a.li = 0;
    hipLaunchKernelGGL(mk_fwd, dim3(grid), dim3(NWAVES * 64), LDS_BYTES, stream, a);
#endif
    const hipError_t le = hipPeekAtLastError();
    if (le != hipSuccess) fprintf(stderr, "kernel_launch: launch failed: %s\n", hipGetErrorName(le));
}
```

```cpp
#include <hip/hip_runtime.h>
#include <cstdio>
#include <cstdint>

#ifndef HYBRID
#define HYBRID 0
#endif

constexpr int DM = 2048, NB = 2, SEQ = 4096, M = NB * SEQ;
constexpr int NMEM = 256, MM = NB * NMEM;
constexpr int W = 1024;
constexpr int NPROJ = 15360;
constexpr int AH = 8, AD = 128, MBLK = 256, NBLK = SEQ / MBLK;
constexpr int SG = 8, SC = 128, SGD = 128;
constexpr int MH = 4, MD = 256;
constexpr float DN_ALPHA = 1.189207115002721f;
constexpr float LN_EPS = 1e-5f;

constexpr size_t MiB = 1u << 20;
constexpr size_t WS_CTL = 0, CTL_ZERO_BYTES = 1 * MiB;
constexpr size_t WS_KMEAN = 1 * MiB;
constexpr size_t WS_C2 = 1 * MiB + 256 * 1024;
constexpr size_t WS_WSB = 1 * MiB + 512 * 1024;
constexpr size_t WS_LNS = 24 * MiB;
constexpr size_t WS_WBR = 2 * MiB;
constexpr size_t WS_WOUT = 14 * MiB;
constexpr size_t WS_VSTATS = 22 * MiB;
constexpr size_t WS_ML = 23 * MiB;
constexpr size_t WS_WIN = 32 * MiB;
constexpr size_t WS_WMKV = 92 * MiB;
constexpr size_t WS_XB = 100 * MiB;
constexpr size_t WS_MEMB = 132 * MiB;
constexpr size_t WS_ACT = 134 * MiB;
constexpr size_t ACT_STRIDE = (size_t)M * W;
constexpr size_t KM_SLOT = (size_t)NB * NBLK * W;
constexpr size_t WS_GATES = 278 * MiB;
constexpr size_t WS_MEMK = 374 * MiB;
constexpr size_t WS_MEMV = 375 * MiB;
constexpr size_t WS_Y = 376 * MiB;
constexpr size_t WS_MERGED = 424 * MiB;
constexpr size_t WS_END = 456 * MiB;
constexpr size_t WS_PO = 32 * MiB;
constexpr size_t WS_H = 32 * MiB;
enum { A_QA = 0, A_KA, A_VA, A_ZA, A_UG, A_VG, A_ZG, A_QC, A_ZC };
static_assert(WS_WIN + (size_t)NPROJ * DM * 2 == WS_WMKV && WS_XB + (size_t)M * DM * 2 == WS_MEMB && WS_MEMB + (size_t)MM * DM * 2 == WS_ACT, "virtual concatenations");
static_assert(WS_ACT + 9 * ACT_STRIDE * 2 == WS_GATES && WS_GATES + (size_t)M * 3 * DM * 2 == WS_MEMK && WS_Y + 3 * ACT_STRIDE * 2 == WS_MERGED, "d_ws map");

typedef unsigned short bf16;
__host__ __device__ __forceinline__ unsigned f2bf(float f) { unsigned u = __builtin_bit_cast(unsigned, f); return (u + 0x7fffu + ((u >> 16) & 1u)) >> 16; }
__host__ __device__ __forceinline__ float bf2f(unsigned short h) { return __builtin_bit_cast(float, (unsigned)h << 16); }


#define GAS __attribute__((address_space(1)))
#define LAS __attribute__((address_space(3)))
typedef unsigned v4u __attribute__((ext_vector_type(4)));
typedef float f32x4 __attribute__((ext_vector_type(4)));
typedef float f32x2v __attribute__((ext_vector_type(2)));
typedef short bf16x8 __attribute__((ext_vector_type(8)));
typedef GAS unsigned gu32;
#define RLX_AGENT __ATOMIC_RELAXED, __HIP_MEMORY_SCOPE_AGENT
#define LDS_WAIT() asm volatile("s_waitcnt lgkmcnt(0)" ::: "memory")
#define VM_WAIT() asm volatile("s_waitcnt vmcnt(0)" ::: "memory")
__device__ __forceinline__ unsigned pk2(float lo, float hi) { return f2bf(lo) | (f2bf(hi) << 16); }
typedef float f32x2_t __attribute__((ext_vector_type(2))); typedef __bf16 bf16x2_t __attribute__((ext_vector_type(2)));
__device__ __forceinline__ unsigned cvt_pk_bf16(float lo, float hi) { f32x2_t v = {lo, hi}; bf16x2_t b = __builtin_convertvector(v, bf16x2_t); return __builtin_bit_cast(unsigned, b); }
__device__ __forceinline__ float bflo(unsigned w) { return __builtin_bit_cast(float, w << 16); }
__device__ __forceinline__ float bfhi(unsigned w) { return __builtin_bit_cast(float, w & 0xffff0000u); }


#define XB_TMO      128
#define XB_XCNT(j)  (256  + 64 * (j))
#define XB_XSUB(j)  (1280 + 64 * (j))
#define XB_XGEN(j)  (2304 + 64 * (j))
#define XB_TOP      3328
#define XB_TOPGEN   3392
#define XCD_BAR_WORDS 3456
#define XB_SPIN_CAP (1u << 18)

__device__ __forceinline__ unsigned xb_ld(unsigned* p)              { return __hip_atomic_load(p, __ATOMIC_RELAXED, __HIP_MEMORY_SCOPE_AGENT); }
__device__ __forceinline__ unsigned xb_add(unsigned* p, unsigned v) { return __hip_atomic_fetch_add(p, v, __ATOMIC_RELAXED, __HIP_MEMORY_SCOPE_AGENT); }
__device__ __forceinline__ unsigned xb_xcc_id() { return (unsigned)__builtin_amdgcn_s_getreg((3 << 11) | 20) & 0xFu; }
#define XB_SPIN(cond, bar) do { unsigned _sp = 0; while (cond) { __builtin_amdgcn_s_sleep(1); \
    if ((++_sp & 255u) == 0u) { if (xb_ld(&(bar)[XB_TMO])) break; if (_sp > XB_SPIN_CAP) { atomicAdd(&(bar)[XB_TMO], 1u); break; } } } } while (0)

struct XcdBarrier {
    unsigned* bar; unsigned x;
    volatile LAS unsigned* st;
};

__device__ __forceinline__ XcdBarrier xcd_barrier_post(unsigned* bar, volatile LAS unsigned* st) {
    XcdBarrier b; b.bar = bar; b.x = xb_xcc_id(); b.st = st;
    if (threadIdx.x == 0) (void)xb_add(&bar[XB_XCNT(b.x)], 1u);
    return b;
}
__device__ __forceinline__ void xcd_barrier_complete(unsigned* bar, unsigned x, unsigned& nloc, unsigned& nx) {
    const unsigned G = gridDim.x * gridDim.y * gridDim.z;
    unsigned sum, cnt, mine, sp = 0u;
    for (;;) {
        sum = 0u; cnt = 0u; mine = 0u;
#pragma unroll
        for (unsigned j = 0; j < 16; ++j) { const unsigned c = xb_ld(&bar[XB_XCNT(j)]); sum += c; cnt += (c > 0u) ? 1u : 0u; mine = (j == x) ? c : mine; }
        if (sum == G) break;
        __builtin_amdgcn_s_sleep(1);
        if ((++sp & 255u) == 0u) { if (xb_ld(&bar[XB_TMO])) break; if (sp > XB_SPIN_CAP) { atomicAdd(&bar[XB_TMO], 1u); break; } }
    }
    nloc = mine > 0u ? mine : 1u; nx = cnt > 0u ? cnt : 1u;
}

__device__ __forceinline__ void xcd_barrier(const XcdBarrier& b) {
    asm volatile("s_waitcnt vmcnt(0)" ::: "memory");
    __syncthreads();
    if (threadIdx.x == 0) {
        unsigned* bar = b.bar;
        __builtin_amdgcn_s_waitcnt(0);
        unsigned nloc = b.st[0], nx = b.st[1];
        if (nloc == 0u) { xcd_barrier_complete(bar, b.x, nloc, nx); b.st[0] = nloc; b.st[1] = nx; }
        const unsigned old = xb_add(&bar[XB_XSUB(b.x)], 1u);
        const unsigned gen = old / nloc;
        if (old + 1u == (gen + 1u) * nloc) {
            __builtin_amdgcn_fence(__ATOMIC_RELEASE, "agent");
            asm volatile("s_waitcnt vmcnt(0)" ::: "memory");
            const unsigned og = xb_add(&bar[XB_TOP], 1u);
            const unsigned tg = og / nx;
            if (og + 1u == (tg + 1u) * nx) xb_add(&bar[XB_TOPGEN], 1u);
            else XB_SPIN(xb_ld(&bar[XB_TOPGEN]) == tg, bar);
            __builtin_amdgcn_fence(__ATOMIC_ACQUIRE, "agent");
            xb_add(&bar[XB_XGEN(b.x)], 1u);
            asm volatile("s_waitcnt vmcnt(0)" ::: "memory");
        } else {
            XB_SPIN(xb_ld(&bar[XB_XGEN(b.x)]) == gen, bar);
            __builtin_amdgcn_fence(__ATOMIC_ACQUIRE, "agent");
            asm volatile("s_waitcnt vmcnt(0)" ::: "memory");
        }
    }
    __syncthreads();
}

namespace pg8 {
#define PG8_LAS __attribute__((address_space(3)))
typedef unsigned short bf16_t;
typedef unsigned u32x4 __attribute__((ext_vector_type(4)));
constexpr int BM = 256, BK = 64, HALF = 128, HTB = HALF * BK * 2  , STAGE_BYTES = 8 * HTB, NXCD = 8, WGM = 8;

__host__ __device__ __forceinline__ int lds_byte(int r, int c) { const int st = (r >> 4) * 2 + (c >> 5), rr = r & 15, cc = c & 31, ob = rr * 64 + cc * 2; return st * 1024 + (ob ^ (((ob >> 9) & 1) << 5)); }
__host__ __device__ __forceinline__ void stage_rc(int b, int& R, int& C) { const int st = b / 1024, sb = b % 1024, swz = sb ^ (((sb >> 9) & 1) << 5); R = (st >> 1) * 16 + swz / 64; C = (st & 1) * 32 + (swz % 64) / 2; }
__host__ __device__ __forceinline__ int perm32(int rho) { const int n = rho >> 4, i = rho & 15; return 8 * (i >> 2) + 4 * n + (i & 3); }

struct Unit { int pm, pn; };
struct Gemm { const bf16_t* A; const bf16_t* Bt; int K; };

struct P1Order {
    int G, c;
    __device__ __forceinline__ bool next(int i, Unit& u) const {
        const int L = i * G + c; if (L >= 1936) return false;
        if (L >= 1920) { const int j = L - 1920; u.pm = 32 + (j >> 3); u.pn = 60 + (j & 7); return true; }
        const int wgid = (L % NXCD) * 240 + L / NXCD;
        const int w = wgid % 480; u.pm = (wgid / 480) * WGM + (w % WGM); u.pn = w / WGM; return true;
    }
    __device__ __forceinline__ void a_ready(const Unit&) const {}
    __device__ __forceinline__ void done(const Unit&) const {}
};
struct BranchOrder {
    int pm, pn;
    __device__ __forceinline__ bool next(int i, Unit& u) const { if (i >= 3) return false; u.pm = i * 32 + pm; u.pn = i * 8 + pn; return true; }
    __device__ __forceinline__ void a_ready(const Unit&) const {}
    __device__ __forceinline__ void done(const Unit&) const {}
};
struct OneOrder {
    int pm, pn;
    __device__ __forceinline__ bool next(int i, Unit& u) const { if (i >= 1) return false; u.pm = pm; u.pn = pn; return true; }
    __device__ __forceinline__ void a_ready(const Unit&) const {}
    __device__ __forceinline__ void done(const Unit&) const {}
};


template <class Epi, class Sched, bool ALIGN_EPI = false, bool SP2 = false>
__device__ __forceinline__ void gemm_phase(PG8_LAS unsigned char* lds, const Gemm g, const Sched& S, const Epi& E) {
    const int tid = threadIdx.x, wid = __builtin_amdgcn_readfirstlane(tid >> 6), lane = tid & 63, wr = wid >> 2, wc = wid & 3, fr = lane & 15, fq = lane >> 4;
    const int K = g.K, nt = K / BK;
    unsigned voffA[2], voffB[2];
#pragma unroll
    for (int i = 0; i < 2; ++i) { int R, C; stage_rc(tid * 16 + i * 8192, R, C); const int Rb = Epi::PERM ? ((R & ~31) + perm32(R & 31)) : R;
        voffA[i] = (unsigned)(R * K + C) * 2u; voffB[i] = (unsigned)(Rb * K + C) * 2u; }
    const size_t kstep = (size_t)(BK * 2);
    const size_t hstep = (size_t)HALF * K * 2;
    const size_t tstep = 2 * hstep;
    const unsigned ldsw = (unsigned)wid * 1024u;
    const int aoff = lds_byte(wr * 64 + fr, fq * 8), boff = lds_byte(wc * 32 + fr, fq * 8);
#define PG8_SA(b, h) (((b) * 2 + (h)) * HTB)
#define PG8_SB(b, h) ((4 + (b) * 2 + (h)) * HTB)
#define PG8_STAGE(bufoff, gbase, voff) do { _Pragma("unroll") for (int _i = 0; _i < 2; ++_i) \
        __builtin_amdgcn_global_load_lds((const unsigned*)((const char*)(gbase) + (voff)[_i]), (PG8_LAS unsigned*)(lds + (bufoff) + ldsw + _i * 8192), 16, 0, 0); } while (0)
#define PG8_LDA(dst, b, h) do { _Pragma("unroll") for (int m = 0; m < 4; ++m) _Pragma("unroll") for (int k = 0; k < 2; ++k) dst[m][k] = *(const PG8_LAS bf16x8*)(lds + PG8_SA(b, h) + aoff + m * 2048 + k * 1024); } while (0)
#define PG8_LDB(dst, b, h) do { _Pragma("unroll") for (int n = 0; n < 2; ++n) _Pragma("unroll") for (int k = 0; k < 2; ++k) dst[n][k] = *(const PG8_LAS bf16x8*)(lds + PG8_SB(b, h) + boff + n * 2048 + k * 1024); } while (0)
#define PG8_MMA(ai, bj, At, Bt) do { __builtin_amdgcn_s_setprio(1); _Pragma("unroll") for (int m = 0; m < 4; ++m) _Pragma("unroll") for (int n = 0; n < 2; ++n) _Pragma("unroll") for (int k = 0; k < 2; ++k) \
        acc[ai][bj][m][n] = __builtin_amdgcn_mfma_f32_16x16x32_bf16(Bt[n][k], At[m][k], acc[ai][bj][m][n], 0, 0, 0); __builtin_amdgcn_s_setprio(0); } while (0)
#define PG8_WAIT_V(n) asm volatile("s_waitcnt vmcnt(" #n ")" ::: "memory")
#define PG8_WAIT_L(n) asm volatile("s_waitcnt lgkmcnt(" #n ")" ::: "memory")
#define PG8_BAR __builtin_amdgcn_s_barrier()
#define PG8_SCHED __builtin_amdgcn_sched_barrier(0)
    Unit cur, nxt; int ui = 0;
    if (!S.next(0, cur)) return;
    f32x4 acc[2][2][4][2];
#pragma unroll
    for (int a = 0; a < 2; ++a)
#pragma unroll
        for (int b = 0; b < 2; ++b)
#pragma unroll
            for (int m = 0; m < 4; ++m)
#pragma unroll
                for (int n = 0; n < 2; ++n) acc[a][b][m][n] = (f32x4){0.f, 0.f, 0.f, 0.f};
    bf16x8 At[4][2], B0[2][2], B1[2][2];
    const char* cA = (const char*)g.A + (size_t)cur.pm * tstep; const char* cB = (const char*)g.Bt + (size_t)cur.pn * tstep;
    S.a_ready(cur);
    if constexpr (SP2) {
        PG8_STAGE(PG8_SB(0, 0), cB, voffB); PG8_STAGE(PG8_SB(0, 1), cB + hstep, voffB); PG8_STAGE(PG8_SA(0, 0), cA, voffA); PG8_STAGE(PG8_SA(0, 1), cA + hstep, voffA);
        if (wr == 1) PG8_BAR;
        PG8_WAIT_V(2); PG8_BAR;
        PG8_STAGE(PG8_SB(1, 0), cB + kstep, voffB); PG8_STAGE(PG8_SA(1, 0), cA + kstep, voffA); PG8_STAGE(PG8_SB(1, 1), cB + hstep + kstep, voffB);
        PG8_WAIT_V(6); PG8_BAR;
    } else {
        PG8_STAGE(PG8_SB(0, 0), cB, voffB); PG8_STAGE(PG8_SA(0, 0), cA, voffA); PG8_STAGE(PG8_SB(0, 1), cB + hstep, voffB); PG8_STAGE(PG8_SA(0, 1), cA + hstep, voffA);
        if (wr == 1) PG8_BAR;
        PG8_WAIT_V(4); PG8_BAR;
        PG8_STAGE(PG8_SB(1, 0), cB + kstep, voffB); PG8_STAGE(PG8_SA(1, 0), cA + kstep, voffA); PG8_STAGE(PG8_SB(1, 1), cB + hstep + kstep, voffB);
        PG8_WAIT_V(6); PG8_BAR;
    }
    for (;;) {
        const bool has_next = S.next(ui + 1, nxt);
        const char* nA = has_next ? (const char*)g.A + (size_t)nxt.pm * tstep : cA; const char* nB = has_next ? (const char*)g.Bt + (size_t)nxt.pn * tstep : cB;
        for (int t = 0; t < nt; t += 2) {
            const bool last = (t == nt - 2);
            const char* a1 = cA + (size_t)(t + 1) * kstep;
            const char* a2 = last ? nA : cA + (size_t)(t + 2) * kstep; const char* b2 = last ? nB : cB + (size_t)(t + 2) * kstep;
            const char* a3 = a2 + kstep; const char* b3 = b2 + kstep;
            if (last && has_next) S.a_ready(nxt);
            if constexpr (SP2) {
            PG8_LDB(B0, 0, 0); PG8_LDB(B1, 0, 1); PG8_SCHED; PG8_LDA(At, 0, 0); PG8_STAGE(PG8_SA(1, 1), a1 + hstep, voffA);
            PG8_WAIT_V(8); PG8_WAIT_L(0); PG8_BAR; PG8_MMA(0, 0, At, B0); PG8_MMA(0, 1, At, B1); PG8_BAR; PG8_SCHED;
            PG8_LDA(At, 0, 1); PG8_STAGE(PG8_SB(0, 0), b2, voffB); PG8_STAGE(PG8_SB(0, 1), b2 + hstep, voffB); PG8_STAGE(PG8_SA(0, 0), a2, voffA);
            PG8_WAIT_V(8); PG8_WAIT_L(0); PG8_BAR; PG8_MMA(1, 0, At, B0); PG8_MMA(1, 1, At, B1); PG8_BAR; PG8_SCHED;
            PG8_LDB(B0, 1, 0); PG8_LDB(B1, 1, 1); PG8_SCHED; PG8_LDA(At, 1, 0); PG8_STAGE(PG8_SA(0, 1), a2 + hstep, voffA);
            PG8_WAIT_V(8); PG8_WAIT_L(0); PG8_BAR; PG8_MMA(0, 0, At, B0); PG8_MMA(0, 1, At, B1); PG8_BAR; PG8_SCHED;
            PG8_LDA(At, 1, 1); PG8_STAGE(PG8_SB(1, 0), b3, voffB); PG8_STAGE(PG8_SB(1, 1), b3 + hstep, voffB); PG8_STAGE(PG8_SA(1, 0), a3, voffA);
            PG8_WAIT_V(8); PG8_WAIT_L(0); PG8_BAR; PG8_MMA(1, 0, At, B0); PG8_MMA(1, 1, At, B1); PG8_BAR; PG8_SCHED;
            } else {
            PG8_LDB(B0, 0, 0); PG8_SCHED; PG8_LDA(At, 0, 0); PG8_STAGE(PG8_SA(1, 1), a1 + hstep, voffA);
            PG8_WAIT_L(8); PG8_BAR; PG8_WAIT_L(0); PG8_MMA(0, 0, At, B0); PG8_BAR; PG8_SCHED;
            PG8_LDB(B1, 0, 1); PG8_STAGE(PG8_SB(0, 0), b2, voffB);
            PG8_BAR; PG8_WAIT_L(0); PG8_MMA(0, 1, At, B1); PG8_BAR;
            PG8_LDA(At, 0, 1); PG8_STAGE(PG8_SA(0, 0), a2, voffA);
            PG8_BAR; PG8_WAIT_L(0); PG8_MMA(1, 0, At, B0); PG8_BAR; PG8_SCHED;
            PG8_STAGE(PG8_SB(0, 1), b2 + hstep, voffB);
            PG8_WAIT_V(6); PG8_BAR; PG8_MMA(1, 1, At, B1); PG8_BAR;
            PG8_LDB(B0, 1, 0); PG8_SCHED; PG8_LDA(At, 1, 0); PG8_STAGE(PG8_SA(0, 1), a2 + hstep, voffA);
            PG8_WAIT_L(8); PG8_BAR; PG8_WAIT_L(0); PG8_MMA(0, 0, At, B0); PG8_BAR; PG8_SCHED;
            PG8_LDB(B1, 1, 1); PG8_STAGE(PG8_SB(1, 0), b3, voffB);
            PG8_BAR; PG8_WAIT_L(0); PG8_MMA(0, 1, At, B1); PG8_BAR;
            PG8_LDA(At, 1, 1); PG8_STAGE(PG8_SA(1, 0), a3, voffA);
            PG8_BAR; PG8_WAIT_L(0); PG8_MMA(1, 0, At, B0); PG8_BAR; PG8_SCHED;
            PG8_STAGE(PG8_SB(1, 1), b3 + hstep, voffB);
            PG8_WAIT_V(6); PG8_BAR; PG8_MMA(1, 1, At, B1); PG8_BAR;
            }
        }
        if constexpr (ALIGN_EPI) { if (wr == 0) PG8_BAR; }
        bool zacc = true;
        if constexpr (!Epi::AFTER_DRAIN) { zacc = E(acc, cur, wr, wc, fr, fq); S.done(cur); }
        if (!has_next) break;
        if (zacc) {
#pragma unroll
        for (int a = 0; a < 2; ++a)
#pragma unroll
            for (int b = 0; b < 2; ++b)
#pragma unroll
                for (int m = 0; m < 4; ++m)
#pragma unroll
                    for (int n = 0; n < 2; ++n) acc[a][b][m][n] = (f32x4){0.f, 0.f, 0.f, 0.f};
        }
        cur = nxt; cA = nA; cB = nB; ++ui;
        if constexpr (ALIGN_EPI) { if (wr == 1) PG8_BAR; }
    }
    PG8_WAIT_V(0);
    if constexpr (!ALIGN_EPI) { if (wr == 0) PG8_BAR; }
    PG8_BAR;
    if constexpr (Epi::AFTER_DRAIN) { E.fused(acc, cur, wr, wc, fr, fq, lds, wid, lane); S.done(cur); }
#undef PG8_SA
#undef PG8_SB
#undef PG8_STAGE
#undef PG8_LDA
#undef PG8_LDB
#undef PG8_MMA
#undef PG8_WAIT_V
#undef PG8_WAIT_L
#undef PG8_BAR
#undef PG8_SCHED
}

constexpr float LOG2E = 1.4426950408889634f;
__device__ __forceinline__ float act_gate(float x, float ka, float kb, bool one) {
    const float t = x * (ka + kb * (x * x));
    const float r = __builtin_amdgcn_rcpf(1.0f + __builtin_amdgcn_exp2f(t));
    return (one ? 1.0f : x) * r;
}
struct EpiProj {
    static constexpr bool PERM = true, AFTER_DRAIN = false;
    bf16_t* act; bf16_t* gates; bf16_t* memk; float* kmean; float* vst;
    __device__ __forceinline__ void plain_store(const f32x4 (&acc)[2][2][4][2], bf16_t* base, int ldc, int row0, int col0) const {
#pragma unroll
        for (int ai = 0; ai < 2; ++ai)
#pragma unroll
            for (int m = 0; m < 4; ++m) { bf16_t* rowp = base + (size_t)(row0 + ai * HALF + m * 16) * ldc + col0;
#pragma unroll
                for (int bj = 0; bj < 2; ++bj) { const f32x4 v0 = acc[ai][bj][m][0], v1 = acc[ai][bj][m][1];
                    u32x4 w; w.x = cvt_pk_bf16(v0[0], v0[1]); w.y = cvt_pk_bf16(v0[2], v0[3]); w.z = cvt_pk_bf16(v1[0], v1[1]); w.w = cvt_pk_bf16(v1[2], v1[3]);
                    *(u32x4*)(rowp + bj * HALF) = w; } }
    }
    template <bool STATS> __device__ __forceinline__ void act_store(const f32x4 (&acc)[2][2][4][2], bf16_t* base, int ldc, int row0, int col0, float ka, float kb, bool one, float* vsl, int fq) const {
#pragma unroll
        for (int ai = 0; ai < 2; ++ai)
#pragma unroll
            for (int m = 0; m < 4; ++m) { bf16_t* rowp = base + (size_t)(row0 + ai * HALF + m * 16) * ldc + col0; float rs = 0.f, rq = 0.f;
#pragma unroll
                for (int bj = 0; bj < 2; ++bj) { f32x4 v0 = acc[ai][bj][m][0], v1 = acc[ai][bj][m][1];
#pragma unroll
                    for (int j = 0; j < 4; ++j) { v0[j] = act_gate(v0[j], ka, kb, one); v1[j] = act_gate(v1[j], ka, kb, one); }
                    if (STATS) {
#pragma unroll
                        for (int j = 0; j < 4; ++j) { rs += v0[j] + v1[j]; rq += v0[j] * v0[j] + v1[j] * v1[j]; } }
                    u32x4 w; w.x = cvt_pk_bf16(v0[0], v0[1]); w.y = cvt_pk_bf16(v0[2], v0[3]); w.z = cvt_pk_bf16(v1[0], v1[1]); w.w = cvt_pk_bf16(v1[2], v1[3]);
                    *(u32x4*)(rowp + bj * HALF) = w; }
                if (STATS) { rs += __shfl_xor(rs, 16); rs += __shfl_xor(rs, 32); rq += __shfl_xor(rq, 16); rq += __shfl_xor(rq, 32);
                    if (fq == 0) *(f32x2v*)(vsl + (size_t)(ai * HALF + m * 16) * 32) = (f32x2v){rs, rq}; } }
    }
    __device__ __forceinline__ bool operator()(f32x4 (&acc)[2][2][4][2], const Unit& u, int wr, int wc, int fr, int fq) const {
        const int pn = u.pn, row0 = u.pm * BM + wr * 64 + fr, cw = wc * 32 + 8 * fq;
        constexpr float KG = -2.0f * 0.7978845608028654f * LOG2E;
        if (pn >= 60) { const int j = pn - 60; plain_store(acc, memk + (size_t)(j >> 2) * ((size_t)MM * W), W, row0 - M, (j & 3) * 256 + cw); return true; }
        if (pn >= 36) { act_store<false>(acc, gates, 3 * DM, row0, (pn - 36) * 256 + cw, -LOG2E, 0.f, true, nullptr, fq); return true; }
        const int seg = pn >> 2, col0 = (pn & 3) * 256 + cw; bf16_t* base = act + (size_t)seg * ACT_STRIDE;
        if (seg == A_VG) { act_store<true>(acc, base, W, row0, col0, KG, KG * 0.044715f, false, vst + ((size_t)row0 * 16 + (pn & 3) * 4 + wc) * 2, fq); return true; }
        if (seg == A_ZA || seg == A_ZG || seg == A_ZC || seg == A_UG) { const bool gl = seg == A_UG; act_store<false>(acc, base, W, row0, col0, gl ? KG : -LOG2E, gl ? KG * 0.044715f : 0.f, false, nullptr, fq); return true; }
        plain_store(acc, base, W, row0, col0);
        if (seg == A_KA) {
            float* kp = kmean + (size_t)wr * KM_SLOT + (size_t)u.pm * W + col0;
#pragma unroll
            for (int bj = 0; bj < 2; ++bj)
#pragma unroll
                for (int n = 0; n < 2; ++n) { f32x4 sv;
#pragma unroll
                    for (int j = 0; j < 4; ++j) { float s = 0.f;
#pragma unroll
                        for (int ai = 0; ai < 2; ++ai)
#pragma unroll
                            for (int m = 0; m < 4; ++m) s += acc[ai][bj][m][n][j];
                        s += __shfl_xor(s, 1); s += __shfl_xor(s, 2); s += __shfl_xor(s, 4); s += __shfl_xor(s, 8); sv[j] = s * (1.0f / 256.0f); }
                    if (fr == 0) *(f32x4*)(kp + bj * HALF + 4 * n) = sv; }
        }
        return true;
    }
};
struct EpiBranch {
    static constexpr bool PERM = true, AFTER_DRAIN = false;
    const bf16_t* gates; bf16_t* merged;
    __device__ __forceinline__ bool operator()(f32x4 (&acc)[2][2][4][2], const Unit& u, int wr, int wc, int fr, int fq) const {
        const int br = u.pm >> 5, pm = u.pm & 31, pn = u.pn & 7;
        const int row0 = pm * BM + wr * 64 + fr, col0 = pn * BM + wc * 32 + 8 * fq;
#pragma unroll
        for (int ai = 0; ai < 2; ++ai)
#pragma unroll
            for (int m = 0; m < 4; ++m) { const int row = row0 + ai * HALF + m * 16; const bf16_t* gp = gates + (size_t)row * (3 * DM) + br * DM + col0;
#pragma unroll
                for (int bj = 0; bj < 2; ++bj) { const u32x4 ga = *(const u32x4*)(gp + bj * HALF);
                    float g[8] = {bflo(ga.x), bfhi(ga.x), bflo(ga.y), bfhi(ga.y), bflo(ga.z), bfhi(ga.z), bflo(ga.w), bfhi(ga.w)};
                    if (br < 2) { const u32x4 gb = *(const u32x4*)(gp + DM + bj * HALF);
                        const float h[8] = {bflo(gb.x), bfhi(gb.x), bflo(gb.y), bfhi(gb.y), bflo(gb.z), bfhi(gb.z), bflo(gb.w), bfhi(gb.w)};
#pragma unroll
                        for (int e = 0; e < 8; ++e) g[e] = fmaxf(g[e], 1e-18f) * __builtin_amdgcn_rcpf(fmaxf(h[e], 1e-18f));
                    } else {
#pragma unroll
                        for (int e = 0; e < 8; ++e) g[e] = fmaxf(g[e], 1e-18f); }
#pragma unroll
                    for (int j = 0; j < 4; ++j) { acc[ai][bj][m][0][j] *= g[j]; acc[ai][bj][m][1][j] *= g[4 + j]; }
                    if (br == 2) { const f32x4 v0 = acc[ai][bj][m][0], v1 = acc[ai][bj][m][1];
                        u32x4 w; w.x = cvt_pk_bf16(v0[0], v0[1]); w.y = cvt_pk_bf16(v0[2], v0[3]); w.z = cvt_pk_bf16(v1[0], v1[1]); w.w = cvt_pk_bf16(v1[2], v1[3]);
                        *(u32x4*)(merged + (size_t)row * DM + col0 + bj * HALF) = w; } }
                if (m & 1) asm volatile("" ::: "memory"); }
        return br == 2;
    }
};
struct EpiOutLN {
    static constexpr bool PERM = false, AFTER_DRAIN = true;
    const float* x; float* out; const float* lng; const float* lnb; float* lns; XcdBarrier bar;
    __device__ __forceinline__ void fused(f32x4 (&acc)[2][2][4][2], const Unit& u, int wr, int wc, int fr, int fq, PG8_LAS unsigned char* lds, int wid, int lane) const {
        PG8_LAS f32x2v* P = (PG8_LAS f32x2v*)lds;
        PG8_LAS f32x2v* S = (PG8_LAS f32x2v*)(lds + 8192);
        const int col0 = u.pn * BM + wc * 32 + 4 * fq;
#pragma unroll
        for (int ai = 0; ai < 2; ++ai)
#pragma unroll
            for (int m = 0; m < 4; ++m) { const size_t off = (size_t)(u.pm * BM + ai * HALF + wr * 64 + m * 16 + fr) * DM + col0;
#pragma unroll
                for (int bj = 0; bj < 2; ++bj)
#pragma unroll
                    for (int n = 0; n < 2; ++n) { const f32x4 xv = *(const f32x4*)(x + off + bj * HALF + n * 16); acc[ai][bj][m][n] = acc[ai][bj][m][n] + xv * DN_ALPHA; }
                asm volatile("" : "+v"(acc[ai][0][m][0]), "+v"(acc[ai][0][m][1]), "+v"(acc[ai][1][m][0]), "+v"(acc[ai][1][m][1]));
                if (m & 1) asm volatile("" ::: "memory"); }
#pragma unroll
        for (int ai = 0; ai < 2; ++ai)
#pragma unroll
            for (int m = 0; m < 4; ++m) {
                float s = 0.f;
#pragma unroll
                for (int bj = 0; bj < 2; ++bj)
#pragma unroll
                    for (int n = 0; n < 2; ++n) { const f32x4 v = acc[ai][bj][m][n]; s += (v[0] + v[1]) + (v[2] + v[3]); }
                s += __shfl_xor(s, 16); s += __shfl_xor(s, 32);
                const float mw = s * (1.0f / 64.0f); float q = 0.f;
#pragma unroll
                for (int bj = 0; bj < 2; ++bj)
#pragma unroll
                    for (int n = 0; n < 2; ++n) { const f32x4 d = acc[ai][bj][m][n] - mw; q += (d[0] * d[0] + d[1] * d[1]) + (d[2] * d[2] + d[3] * d[3]); }
                q += __shfl_xor(q, 16); q += __shfl_xor(q, 32);
                if (fq == 0) P[(ai * HALF + wr * 64 + m * 16 + fr) * 4 + wc] = (f32x2v){mw, q};
            }
        asm volatile("s_waitcnt lgkmcnt(0)" ::: "memory"); __builtin_amdgcn_s_barrier(); asm volatile("" ::: "memory");
        const int row = wid * 32 + (lane & 31);
        if (lane < 32) {
            const f32x2v a = P[row * 4 + 0], b = P[row * 4 + 1], c = P[row * 4 + 2], d = P[row * 4 + 3];
            const float mt = (a.x + b.x + c.x + d.x) * 0.25f;
            const float da = a.x - mt, db = b.x - mt, dc = c.x - mt, dd = d.x - mt;
            const float m2 = (a.y + b.y) + (c.y + d.y) + 64.0f * ((da * da + db * db) + (dc * dc + dd * dd));
            *(f32x2v*)(lns + ((size_t)(u.pm * BM + row) * 8 + u.pn) * 2) = (f32x2v){mt, m2};
        }
        xcd_barrier(bar);
        if (lane < 32) {
            const f32x4* sp = (const f32x4*)(lns + (size_t)(u.pm * BM + row) * 16); float mt[8], m2[8];
#pragma unroll
            for (int t = 0; t < 4; ++t) { const f32x4 w = sp[t]; mt[2 * t] = w[0]; m2[2 * t] = w[1]; mt[2 * t + 1] = w[2]; m2[2 * t + 1] = w[3]; }
            float ms = 0.f;
#pragma unroll
            for (int t = 0; t < 8; ++t) ms += mt[t];
            const float mean = ms * 0.125f; float q = 0.f;
#pragma unroll
            for (int t = 0; t < 8; ++t) { const float dm = mt[t] - mean; q += m2[t] + 256.0f * dm * dm; }
            S[row] = (f32x2v){mean, 1.0f / sqrtf(q * (1.0f / DM) + LN_EPS)};
        }
        asm volatile("s_waitcnt lgkmcnt(0)" ::: "memory"); __builtin_amdgcn_s_barrier(); asm volatile("" ::: "memory");
        f32x4 gv[2][2], bv[2][2];
#pragma unroll
        for (int bj = 0; bj < 2; ++bj)
#pragma unroll
            for (int n = 0; n < 2; ++n) { gv[bj][n] = *(const f32x4*)(lng + col0 + bj * HALF + n * 16); bv[bj][n] = *(const f32x4*)(lnb + col0 + bj * HALF + n * 16); }
#pragma unroll
        for (int ai = 0; ai < 2; ++ai)
#pragma unroll
            for (int m = 0; m < 4; ++m) { const int r = ai * HALF + wr * 64 + m * 16 + fr; const f32x2v sr = S[r]; const size_t off = (size_t)(u.pm * BM + r) * DM + col0;
#pragma unroll
                for (int bj = 0; bj < 2; ++bj)
#pragma unroll
                    for (int n = 0; n < 2; ++n) { const f32x4 o = (acc[ai][bj][m][n] - sr.x) * sr.y * gv[bj][n] + bv[bj][n]; *(f32x4*)(out + off + bj * HALF + n * 16) = o; } }
    }
};
}


namespace moba {
constexpr int D = 128, PITCH = W, NW = 8, QBLK = 32, KVBLK = 64, QB = NW * QBLK;
constexpr int SHM_V = KVBLK * D * 2, SHM_K = KVBLK * D * 2;
constexpr int LDS_NEED = 2 * SHM_V + 2 * SHM_K + NW * 64 * 4;
constexpr float SCALE = 0.08838834764831845f, THR = 8.f;
typedef short s16x4 __attribute__((ext_vector_type(4)));
typedef float f32x16 __attribute__((ext_vector_type(16)));
typedef unsigned u32x4 __attribute__((ext_vector_type(4)));
#define KSWZ(row, colB) ((row) * 256 + ((colB) ^ (((row) & 7) << 4)))
#define SBAR() __builtin_amdgcn_sched_barrier(0)
__device__ __forceinline__ int v_st(int k, int c) { const int kk = (k & ~0xC) | ((k & 4) << 1) | ((k & 8) >> 1); return ((kk >> 3) * 4 + (c >> 5)) * 512 + ((kk & 7) * 32 + (c & 31)) * 2; }
__device__ __forceinline__ int v_rd_base(int lane) { return ((lane & 3) << 3) | (((lane >> 2) & 3) << 6) | (((lane >> 4) & 1) << 5) | (((lane >> 5) & 1) << 8); }
constexpr int v_rd_off(int d0, int ks, int half) { return d0 * 512 + ks * 4096 + half * 2048; }
__device__ __forceinline__ int crow(int r, int hi) { return (r & 3) + 8 * (r >> 2) + 4 * hi; }
__device__ __forceinline__ bf16x8 pack8(f32x4 a, f32x4 b) { u32x4 w = {cvt_pk_bf16(a[0], a[1]), cvt_pk_bf16(a[2], a[3]), cvt_pk_bf16(b[0], b[1]), cvt_pk_bf16(b[2], b[3])}; return *reinterpret_cast<bf16x8*>(&w); }
__device__ __forceinline__ bf16x8 load8(const bf16* p) { return *reinterpret_cast<const bf16x8*>(p); }
__device__ __forceinline__ void mask_causal(f32x16& p0, f32x16& p1, int dq) {
    const float NEG = -__builtin_inff();
#pragma unroll
    for (int r = 0; r < 16; ++r) { const int c = (r & 3) + 8 * (r >> 2); if (dq - c < 0) p0[r] = NEG; if (dq - c - 32 < 0) p1[r] = NEG; }
}
__device__ __forceinline__ void mask_row(f32x16& p0, f32x16& p1, bool keep) {
    const float NEG = -__builtin_inff();
#pragma unroll
    for (int r = 0; r < 16; ++r) { p0[r] = keep ? p0[r] : NEG; p1[r] = keep ? p1[r] : NEG; }
}
__device__ __forceinline__ void partialSM(f32x16& p0, f32x16& p1, float& m_reg, float& mn, float& alpha) {
    float pmax = p0[0]; for (int r = 1; r < 16; ++r) pmax = fmaxf(pmax, p0[r]); for (int r = 0; r < 16; ++r) pmax = fmaxf(pmax, p1[r]);
    { auto rr = __builtin_amdgcn_permlane32_swap(__float_as_uint(pmax), __float_as_uint(pmax), false, false);
      pmax = fmaxf(__uint_as_float(rr[0]), __uint_as_float(rr[1])); }
    constexpr float C2 = 1.4426950408889634f * SCALE;
    if (__builtin_expect(__all((pmax - m_reg) * SCALE <= THR), 1)) { mn = m_reg; alpha = 1.f; }
    else { mn = fmaxf(m_reg, pmax); alpha = __builtin_amdgcn_exp2f((m_reg - mn) * C2); m_reg = mn; }
    const float mnL = -mn * C2;
    for (int r = 0; r < 16; ++r) p0[r] = fmaf(p0[r], C2, mnL); for (int r = 0; r < 16; ++r) p1[r] = fmaf(p1[r], C2, mnL);
    for (int r = 0; r < 16; ++r) p0[r] = __builtin_amdgcn_exp2f(p0[r]);
}
__device__ __forceinline__ void finishSM(f32x16& p0, f32x16& p1, float alpha, float& l_reg, bf16x8& pa0, bf16x8& pa1, bf16x8& pa2, bf16x8& pa3) {
    for (int r = 0; r < 16; ++r) p1[r] = __builtin_amdgcn_exp2f(p1[r]);
    float ps = 0; for (int r = 0; r < 16; ++r) ps += p0[r]; for (int r = 0; r < 16; ++r) ps += p1[r];
    { auto rr = __builtin_amdgcn_permlane32_swap(__float_as_uint(ps), __float_as_uint(ps), false, false);
      ps = __uint_as_float(rr[0]) + __uint_as_float(rr[1]); }
    l_reg = l_reg * alpha + ps;
#define PK4(P, B_, OUT) do { unsigned a0 = cvt_pk_bf16(P[B_+0], P[B_+1]), a1 = cvt_pk_bf16(P[B_+2], P[B_+3]);                          \
        unsigned b0 = cvt_pk_bf16(P[B_+4], P[B_+5]), b1 = cvt_pk_bf16(P[B_+6], P[B_+7]);                                             \
        auto r0 = __builtin_amdgcn_permlane32_swap(a0, b0, false, false); auto r1 = __builtin_amdgcn_permlane32_swap(a1, b1, false, false); \
        u32x4 w = {r0[0], r1[0], r0[1], r1[1]}; OUT = *reinterpret_cast<bf16x8*>(&w); } while (0)
    PK4(p0, 0, pa0); PK4(p0, 8, pa1); PK4(p1, 0, pa2); PK4(p1, 8, pa3);
#undef PK4
}
template <int KB>
__device__ __forceinline__ void qkt(f32x16& p0, f32x16& p1, const char* K_lds, int r32, int hi, const bf16x8* qr) {
    p0 = f32x16{}; p1 = f32x16{};
    const char* kb[4];
#pragma unroll
    for (int dd = 0; dd < 4; ++dd) kb[dd] = K_lds + KB * SHM_K + KSWZ(r32, (dd * 16 + hi * 8) * 2);
#pragma unroll
    for (int d0 = 0; d0 < 8; ++d0) { const char* a = kb[d0 & 3] + (d0 >> 2) * 128;
        bf16x8 b0 = *reinterpret_cast<const bf16x8*>(a);
        bf16x8 b1 = *reinterpret_cast<const bf16x8*>(a + 32 * 256);
        p0 = __builtin_amdgcn_mfma_f32_32x32x16_bf16(b0, qr[d0], p0, 0, 0, 0);
        p1 = __builtin_amdgcn_mfma_f32_32x32x16_bf16(b1, qr[d0], p1, 0, 0, 0); }
}
#define MOBA_TRRD(dst, off) asm volatile("ds_read_b64_tr_b16 %0, %1 offset:%2" : "=&v"(dst) : "v"(vb0), "i"(off) : "memory")
#define MOBA_PV_D0(d0) do { s16x4 l0, l1, l2, l3, h0, h1, h2, h3; constexpr int b_ = VB * SHM_V + v_rd_off(d0, 0, 0);     \
        MOBA_TRRD(l0, b_); MOBA_TRRD(h0, b_ + 2048); MOBA_TRRD(l1, b_ + 4096); MOBA_TRRD(h1, b_ + 6144); MOBA_TRRD(l2, b_ + 8192); MOBA_TRRD(h2, b_ + 10240); MOBA_TRRD(l3, b_ + 12288); MOBA_TRRD(h3, b_ + 14336); \
        asm volatile("s_waitcnt lgkmcnt(0)" ::: "memory"); SBAR();                 \
        o[d0] = __builtin_amdgcn_mfma_f32_32x32x16_bf16(pa0, (bf16x8){l0[0], l0[1], l0[2], l0[3], h0[0], h0[1], h0[2], h0[3]}, o[d0], 0, 0, 0);   \
        o[d0] = __builtin_amdgcn_mfma_f32_32x32x16_bf16(pa1, (bf16x8){l1[0], l1[1], l1[2], l1[3], h1[0], h1[1], h1[2], h1[3]}, o[d0], 0, 0, 0);   \
        o[d0] = __builtin_amdgcn_mfma_f32_32x32x16_bf16(pa2, (bf16x8){l2[0], l2[1], l2[2], l2[3], h2[0], h2[1], h2[2], h2[3]}, o[d0], 0, 0, 0);   \
        o[d0] = __builtin_amdgcn_mfma_f32_32x32x16_bf16(pa3, (bf16x8){l3[0], l3[1], l3[2], l3[3], h3[0], h3[1], h3[2], h3[3]}, o[d0], 0, 0, 0); } while (0)
template <int VB>
__device__ __forceinline__ void pv_tile(f32x16* o, int vb0, bf16x8 pa0, bf16x8 pa1, bf16x8 pa2, bf16x8 pa3) {
    MOBA_PV_D0(0); MOBA_PV_D0(1); MOBA_PV_D0(2); MOBA_PV_D0(3);
}

struct BlockRef { const bf16* Q; const bf16* K; const bf16* V; bf16* PO; float* ML; const float* KM; int P0, blk, j_lo, j_hi; };
struct Seam { bf16x8 qr[8]; bf16x8 st_v0, st_v1, st_k0, st_k1; };
#define ROW(p, k0, rr) ((p) + (size_t)((k0) + (rr)) * PITCH + sc)
#define VMW() asm volatile("s_waitcnt vmcnt(0)" ::: "memory")
#define VMWN(n) asm volatile("s_waitcnt vmcnt(%0)" :: "i"(n) : "memory")
#define SLOAD_H(Kp, Vp, k0) do { S.st_v0 = load8(ROW(Vp, k0, sr)); S.st_v1 = load8(ROW(Vp, k0, 32 + sr));              \
                         S.st_k0 = load8(ROW(Kp, k0, sr)); S.st_k1 = load8(ROW(Kp, k0, 32 + sr)); } while (0)
#define SWRITE_HK(bf) do { *(bf16x8*)(K_lds + (bf) * SHM_K + kws) = S.st_k0; *(bf16x8*)(K_lds + (bf) * SHM_K + kws + 32 * 256) = S.st_k1; } while (0)
#define SWRITE_HV(bf) do { *(bf16x8*)(V_lds + (bf) * SHM_V + vst0) = S.st_v0; *(bf16x8*)(V_lds + (bf) * SHM_V + vst1) = S.st_v1; } while (0)
#define SWRITE_H(bf) do { SWRITE_HV(bf); SWRITE_HK(bf); } while (0)
__device__ __forceinline__ void prime(const BlockRef& cur, char* lds, Seam& S) {
    const int tid = threadIdx.x, wid = __builtin_amdgcn_readfirstlane(tid >> 6), lane = tid & 63, r32 = lane & 31, hi = lane >> 5;
    const int sr = tid >> 4, sc = (tid & 15) * 8, kws = KSWZ(sr, sc * 2); char* K_lds = lds + 2 * SHM_V;
    const int kb0 = cur.j_lo * KVBLK;
    for (int d0 = 0; d0 < 8; ++d0) S.qr[d0] = load8(cur.Q + (size_t)(wid * QBLK + r32) * PITCH + d0 * 16 + hi * 8);
    SLOAD_H(cur.K, cur.V, kb0); VMW(); SWRITE_HK(0);
    __syncthreads();
}
__device__ __forceinline__ void block(const BlockRef& cur, const BlockRef& nxt, char* lds, Seam& S) {
    const int tid = threadIdx.x, wid = __builtin_amdgcn_readfirstlane(tid >> 6), lane = tid & 63, r32 = lane & 31, hi = lane >> 5;
    const int j_lo = cur.j_lo, NT = cur.j_hi - cur.j_lo, blk = cur.blk;
    const int kbn = nxt.j_lo * KVBLK;
    const int qlo = cur.P0 + wid * QBLK, qm = qlo + r32 - 4 * hi;
    char* V_lds = lds; char* K_lds = lds + 2 * SHM_V;
    float* ws = (float*)(lds + 2 * SHM_V + 2 * SHM_K) + wid * 64; float* li_l = ws, * al_l = ws + 32;
    unsigned sel = 0u;
    if (blk > 0) {
        f32x16 sc_ = f32x16{};
        const float* kmp = cur.KM + (size_t)(r32 & 15) * W + hi * 8;
#pragma unroll
        for (int d0 = 0; d0 < 8; ++d0) { const f32x4 a0 = *(const f32x4*)(kmp + d0 * 16) + *(const f32x4*)(kmp + KM_SLOT + d0 * 16), a1 = *(const f32x4*)(kmp + d0 * 16 + 4) + *(const f32x4*)(kmp + KM_SLOT + d0 * 16 + 4);
            const bf16x8 ah = pack8(a0, a1); f32x4 r0, r1;
#pragma unroll
            for (int j = 0; j < 4; ++j) { r0[j] = a0[j] - bf2f((unsigned short)ah[j]); r1[j] = a1[j] - bf2f((unsigned short)ah[4 + j]); }
            const bf16x8 al = pack8(r0, r1);
            sc_ = __builtin_amdgcn_mfma_f32_32x32x16_bf16(ah, S.qr[d0], sc_, 0, 0, 0); sc_ = __builtin_amdgcn_mfma_f32_32x32x16_bf16(al, S.qr[d0], sc_, 0, 0, 0); }
        float v[16];
#pragma unroll
        for (int n = 0; n < 16; ++n) { const int idx = (n & 3) + 4 * (n >> 3); const float own = sc_[idx], oth = __shfl_xor(own, 32); v[n] = (hi == ((n >> 2) & 1)) ? own : oth; }
#pragma unroll
        for (int k = 0; k < 3; ++k) { float best = -__builtin_inff(); int bi = -1;
#pragma unroll
            for (int n = 0; n < 15; ++n) { const bool ok = n < blk && !((sel >> n) & 1u) && (bi < 0 || v[n] > best); if (ok) { best = v[n]; bi = n; } }
            if (bi >= 0) sel |= 1u << bi; }
    }
    float m_reg = -1e30f, l_reg = 0; f32x16 o[4] = {};
    const int sr = tid >> 4, sc = (tid & 15) * 8, vst0 = v_st(sr, sc), vst1 = v_st(32 + sr, sc), kws = KSWZ(sr, sc * 2);
    const int vb0 = (int)(uintptr_t)V_lds + v_rd_base(lane);
    const bf16* Kh = cur.K; const bf16* Vh = cur.V;
#define RESC(a) do { if (__any((a) < 1.f)) { if (hi == 0) al_l[r32] = (a); asm volatile("s_waitcnt lgkmcnt(0)" ::: "memory");              \
                     for (int d_ = 0; d_ < 4; ++d_) for (int r = 0; r < 16; ++r) o[d_][r] *= al_l[crow(r, hi)]; } } while (0)
#define KBASE(t) ((j_lo + (t)) * KVBLK)
#define MASKT(P0_, P1_, t) do { const int jt_ = j_lo + (t), nb_ = jt_ >> 2; \
        if (nb_ < blk) { mask_row(P0_, P1_, ((sel >> nb_) & 1u) != 0u); } \
        else { const int kb_ = jt_ * KVBLK; if (kb_ + KVBLK - 1 > qlo) mask_causal(P0_, P1_, qm - kb_); } } while (0)
    constexpr int NQL = 8;
#define SEAM_K0() do { VMWN(NQL); SWRITE_HK(0); SBAR(); } while (0)
    f32x16 pA0, pA1, pB0, pB1; float mnA, mnB, alA, alB; bf16x8 pa0, pa1, pa2, pa3;
    SWRITE_HV(0); SBAR();
    if (NT > 1) SLOAD_H(Kh, Vh, KBASE(1));
    SBAR(); qkt<0>(pA0, pA1, K_lds, r32, hi, S.qr);
    MASKT(pA0, pA1, 0); partialSM(pA0, pA1, m_reg, mnA, alA);
    if (NT > 1) { VMW(); SWRITE_H(1); }
    __syncthreads();
#define HALF_STEP(PX0, PX1, mnX, alX, PY0, PY1, alY, t, KB, VB, SB) do {                                                      \
        SBAR(); qkt<KB>(PX0, PX1, K_lds, r32, hi, S.qr);                                             \
        finishSM(PY0, PY1, alY, l_reg, pa0, pa1, pa2, pa3); SBAR();                                                           \
        if ((t) + 1 < NT) { SLOAD_H(Kh, Vh, KBASE((t) + 1)); SBAR(); }                                               \
        pv_tile<VB>(o, vb0, pa0, pa1, pa2, pa3); MASKT(PX0, PX1, (t)); partialSM(PX0, PX1, m_reg, mnX, alX);                                        \
        __syncthreads();                                                                                                      \
        if ((t) + 1 < NT) { VMW(); SWRITE_H(SB); }                                                                          \
        RESC(alX); __syncthreads(); } while (0)
    for (int t = 1; t + 1 < NT; t += 2) {
        HALF_STEP(pB0, pB1, mnB, alB, pA0, pA1, alA, t, 1, 0, 0);
        HALF_STEP(pA0, pA1, mnA, alA, pB0, pB1, alB, t + 1, 0, 1, 1);
    }
    const bool even = (NT & 1) == 0;
    if (even) { SBAR(); qkt<1>(pB0, pB1, K_lds, r32, hi, S.qr); SBAR(); }
    SLOAD_H(nxt.K, nxt.V, kbn); SBAR();
#pragma unroll
    for (int d0 = 0; d0 < 8; ++d0) S.qr[d0] = load8(nxt.Q + (size_t)(wid * QBLK + r32) * PITCH + d0 * 16 + hi * 8);
    SBAR();
    finishSM(pA0, pA1, alA, l_reg, pa0, pa1, pa2, pa3); SBAR();
    pv_tile<0>(o, vb0, pa0, pa1, pa2, pa3);
    if (even) { MASKT(pB0, pB1, NT - 1); partialSM(pB0, pB1, m_reg, mnB, alB); __syncthreads(); RESC(alB);
        finishSM(pB0, pB1, alB, l_reg, pa0, pa1, pa2, pa3); SBAR(); pv_tile<1>(o, vb0, pa0, pa1, pa2, pa3); }
    SBAR(); SEAM_K0();
    if (hi == 0) { li_l[r32] = l_reg; *(f32x2v*)(cur.ML + (size_t)(wid * QBLK + r32) * (2 * AH)) = (f32x2v){m_reg, l_reg}; }
    asm volatile("s_waitcnt lgkmcnt(0)" ::: "memory");
    float rli[16];
#pragma unroll
    for (int r = 0; r < 16; ++r) { const float l = li_l[crow(r, hi)]; rli[r] = l > 0.f ? __builtin_amdgcn_rcpf(l) : 0.f; }
    bf16* Ow = cur.PO + (size_t)(wid * QBLK) * PITCH;
#pragma unroll
    for (int r = 0; r < 16; ++r) { const int orow = crow(r, hi);
#pragma unroll
        for (int d0 = 0; d0 < 4; ++d0) { const float vv = o[d0][r] * rli[r]; const float vn = __shfl_xor(vv, 1);
            if ((r32 & 1) == 0) *(unsigned*)(Ow + (size_t)orow * PITCH + d0 * 32 + r32) = cvt_pk_bf16(vv, vn); } }
    __syncthreads();
#undef RESC
#undef KBASE
#undef MASKT
#undef SEAM_K0
#undef HALF_STEP
}
#undef ROW
#undef VMW
#undef VMWN
#undef SLOAD_H
#undef SWRITE_HK
#undef SWRITE_HV
#undef SWRITE_H
}


namespace mix {
using moba::f32x16; using moba::s16x4; using moba::u32x4; using moba::crow; using moba::v_st; using moba::v_rd_base; using moba::SHM_V;
__device__ __forceinline__ void sgu_unit(char* lds, unsigned char* ws, const float* b_s, const float* lng, const float* lnb, int b, int c, int gp) {
    const int tid = threadIdx.x, wid = __builtin_amdgcn_readfirstlane(tid >> 6), lane = tid & 63, r32 = lane & 31, hi = lane >> 5, hw = wid >> 2, tb = wid & 3, g = 2 * gp + hw;
    const size_t row0 = (size_t)b * SEQ + (size_t)c * SC;
    const bf16* act = (const bf16*)(ws + WS_ACT); const bf16* UG = act + A_UG * ACT_STRIDE; const bf16* VG = act + A_VG * ACT_STRIDE; const bf16* ZG = act + A_ZG * ACT_STRIDE; bf16* YG = (bf16*)(ws + WS_Y) + ACT_STRIDE;
    const float* vst = (const float*)(ws + WS_VSTATS); const bf16* wsb = (const bf16*)(ws + WS_WSB); const float* c2 = (const float*)(ws + WS_C2);
    char* V_lds = lds + hw * 2 * SHM_V; f32x2v* stab = (f32x2v*)(lds + 4 * SHM_V);
    if (tid < SC) { const f32x4* sp = (const f32x4*)(vst + (row0 + tid) * 32); float s = 0.f, q = 0.f;
#pragma unroll
        for (int j = 0; j < 8; ++j) { const f32x4 w = sp[j]; s += w[0] + w[2]; q += w[1] + w[3]; }
        const float mean = s * (1.0f / W), var = q * (1.0f / W) - mean * mean; stab[tid] = (f32x2v){mean, 1.0f / sqrtf(var + LN_EPS)}; }
    __syncthreads();
    { const int ht = tid & 255;
#pragma unroll
      for (int i = 0; i < 8; ++i) { const int idx = ht + 256 * i, s = idx >> 4, col = (idx & 15) * 8; const v4u raw = *(const v4u*)(VG + (row0 + s) * W + g * SGD + col); const f32x2v st = stab[s]; v4u o;
#pragma unroll
          for (int j = 0; j < 4; ++j) o[j] = cvt_pk_bf16((bflo(raw[j]) - st.x) * st.y, (bfhi(raw[j]) - st.x) * st.y);
          *(v4u*)(V_lds + (s >> 6) * SHM_V + v_st(s & 63, col)) = o; } }
    __syncthreads();
    f32x16 o[4] = {};
    const int vb0 = (int)(uintptr_t)V_lds + v_rd_base(lane);
    const bf16* wrow = wsb + ((size_t)g * SC + tb * 32 + r32) * SC + hi * 8;
    { const bf16x8 a0 = *(const bf16x8*)(wrow), a1 = *(const bf16x8*)(wrow + 16), a2 = *(const bf16x8*)(wrow + 32), a3 = *(const bf16x8*)(wrow + 48); moba::pv_tile<0>(o, vb0, a0, a1, a2, a3); }
    if (tb >= 2) { const bf16x8 a0 = *(const bf16x8*)(wrow + 64), a1 = *(const bf16x8*)(wrow + 80), a2 = *(const bf16x8*)(wrow + 96), a3 = *(const bf16x8*)(wrow + 112); moba::pv_tile<1>(o, vb0, a0, a1, a2, a3); }
    float gm[4], bt[4];
#pragma unroll
    for (int d0 = 0; d0 < 4; ++d0) { gm[d0] = lng[g * SGD + d0 * 32 + r32]; bt[d0] = lnb[g * SGD + d0 * 32 + r32]; }
#pragma unroll
    for (int r = 0; r < 16; ++r) { const int t = tb * 32 + crow(r, hi); const float cc = c2[g * SC + t], bb = b_s[g * SC + t]; const size_t e = (row0 + t) * W + g * SGD + r32;
#pragma unroll
        for (int d0 = 0; d0 < 4; ++d0) { const float mixed = gm[d0] * o[d0][r] + bt[d0] * cc + bb; const float y = bf2f(UG[e + d0 * 32]) * mixed * bf2f(ZG[e + d0 * 32]);
            const float yn = __shfl_xor(y, 1); if ((r32 & 1) == 0) *(unsigned*)(YG + e + d0 * 32) = cvt_pk_bf16(y, yn); } }
    __syncthreads();
}
__device__ __forceinline__ void mem_unit(char* lds, unsigned char* ws, int b, int h, int qb, int dh) {
    const int tid = threadIdx.x, wid = __builtin_amdgcn_readfirstlane(tid >> 6), lane = tid & 63, r32 = lane & 31, hi = lane >> 5;
    const bf16* act = (const bf16*)(ws + WS_ACT); const bf16* QC = act + A_QC * ACT_STRIDE; const bf16* ZC = act + A_ZC * ACT_STRIDE; bf16* YC = (bf16*)(ws + WS_Y) + 2 * ACT_STRIDE;
    const bf16* MK = (const bf16*)(ws + WS_MEMK) + (size_t)b * NMEM * W + h * MD; const bf16* MV = (const bf16*)(ws + WS_MEMV) + (size_t)b * NMEM * W + h * MD + dh * 128;
    const size_t qrow = (size_t)b * SEQ + (size_t)qb * 256 + wid * 32 + r32;
    bf16x8 qr[16];
#pragma unroll
    for (int d0 = 0; d0 < 16; ++d0) qr[d0] = *(const bf16x8*)(QC + qrow * W + h * MD + d0 * 16 + hi * 8);
#pragma unroll
    for (int i = 0; i < 16; ++i) { const int idx = tid + 512 * i, key = idx >> 5, ch = idx & 31; const v4u kv = *(const v4u*)(MK + (size_t)key * W + ch * 8);
        *(v4u*)(lds + key * 512 + ((ch ^ (key & 7)) << 4)) = kv; }
    __syncthreads();
    f32x16 p[8];
#pragma unroll
    for (int kg = 0; kg < 8; ++kg) { p[kg] = f32x16{};
        const char* kb = lds + (kg * 32 + r32) * 512;
#pragma unroll
        for (int d0 = 0; d0 < 16; ++d0) { const bf16x8 kf = *(const bf16x8*)(kb + (((2 * d0 + hi) ^ (r32 & 7)) << 4)); p[kg] = __builtin_amdgcn_mfma_f32_32x32x16_bf16(kf, qr[d0], p[kg], 0, 0, 0); } }
    constexpr float C2 = 1.4426950408889634f * 0.0625f;
    float mx = p[0][0];
#pragma unroll
    for (int kg = 0; kg < 8; ++kg)
#pragma unroll
        for (int r = 0; r < 16; ++r) mx = fmaxf(mx, p[kg][r]);
    { auto rr = __builtin_amdgcn_permlane32_swap(__float_as_uint(mx), __float_as_uint(mx), false, false); mx = fmaxf(__uint_as_float(rr[0]), __uint_as_float(rr[1])); }
    const float mnl = -mx * C2; float ls = 0.f;
#pragma unroll
    for (int kg = 0; kg < 8; ++kg)
#pragma unroll
        for (int r = 0; r < 16; ++r) { p[kg][r] = __builtin_amdgcn_exp2f(fmaf(p[kg][r], C2, mnl)); ls += p[kg][r]; }
    { auto rr = __builtin_amdgcn_permlane32_swap(__float_as_uint(ls), __float_as_uint(ls), false, false); ls = __uint_as_float(rr[0]) + __uint_as_float(rr[1]); }
    bf16x8 pa[4][4];
#define MIX_PK4(P, B_, OUT) do { unsigned a0 = cvt_pk_bf16(P[B_+0], P[B_+1]), a1 = cvt_pk_bf16(P[B_+2], P[B_+3]);                          \
        unsigned b0 = cvt_pk_bf16(P[B_+4], P[B_+5]), b1 = cvt_pk_bf16(P[B_+6], P[B_+7]);                                             \
        auto r0 = __builtin_amdgcn_permlane32_swap(a0, b0, false, false); auto r1 = __builtin_amdgcn_permlane32_swap(a1, b1, false, false); \
        u32x4 w = {r0[0], r1[0], r0[1], r1[1]}; OUT = *reinterpret_cast<bf16x8*>(&w); } while (0)
#pragma unroll
    for (int t = 0; t < 4; ++t) { MIX_PK4(p[2 * t], 0, pa[t][0]); MIX_PK4(p[2 * t], 8, pa[t][1]); MIX_PK4(p[2 * t + 1], 0, pa[t][2]); MIX_PK4(p[2 * t + 1], 8, pa[t][3]); }
#undef MIX_PK4
    __syncthreads();
#pragma unroll
    for (int i = 0; i < 8; ++i) { const int idx = tid + 512 * i, key = idx >> 4, col = (idx & 15) * 8; const v4u vv = *(const v4u*)(MV + (size_t)key * W + col);
        *(v4u*)(lds + (key >> 6) * SHM_V + v_st(key & 63, col)) = vv; }
    __syncthreads();
    f32x16 o[4] = {};
    const int vb0 = (int)(uintptr_t)lds + v_rd_base(lane);
    moba::pv_tile<0>(o, vb0, pa[0][0], pa[0][1], pa[0][2], pa[0][3]); moba::pv_tile<1>(o, vb0, pa[1][0], pa[1][1], pa[1][2], pa[1][3]);
    moba::pv_tile<2>(o, vb0, pa[2][0], pa[2][1], pa[2][2], pa[2][3]); moba::pv_tile<3>(o, vb0, pa[3][0], pa[3][1], pa[3][2], pa[3][3]);
    const float rl = __builtin_amdgcn_rcpf(ls);
    const size_t obase = ((size_t)b * SEQ + (size_t)qb * 256 + wid * 32) * W + h * MD + dh * 128 + r32;
#pragma unroll
    for (int r = 0; r < 16; ++r) { const int orow = crow(r, hi); const float rli = __shfl(rl, orow); const size_t e = obase + (size_t)orow * W;
#pragma unroll
        for (int d0 = 0; d0 < 4; ++d0) { const float y = o[d0][r] * rli * bf2f(ZC[e + d0 * 32]); const float yn = __shfl_xor(y, 1); if ((r32 & 1) == 0) *(unsigned*)(YC + e + d0 * 32) = cvt_pk_bf16(y, yn); } }
    __syncthreads();
}
}


constexpr int NWAVES = 8;
constexpr int RING_BYTES = 131072;
constexpr int LDSCTL_OFF = RING_BYTES, MISC_OFF = LDSCTL_OFF + 320;
constexpr int LDS_BYTES = 147456;
constexpr int CW_TMO = 0, CW_CODE = 1, CW_BAR = 4096;
constexpr int N_PHASES = 6;

struct Frame {
    LAS unsigned char* lds;
    volatile LAS unsigned* MISC;
    gu32* ctl;
    int tid, lane, wave, vcu, G;
    const float *x, *mem, *w_in, *w_mk, *w_mv, *w_s, *b_s, *lnvg, *lnvb, *wba, *wbg, *wbm, *w_out, *ln_g, *ln_b; float* out;
    unsigned char* ws;
};

__device__ __forceinline__ float wave_sum(float v) {
#pragma unroll
    for (int o = 1; o < 64; o <<= 1) v += __shfl_xor(v, o);
    return v;
}
__device__ __forceinline__ void p0_transpose_item(const float* Wm, int K, int N, bf16* WT, int row_off, LAS float* scr, int item, int lane) {
    const int nblk = N / 32, kb = item / nblk, nb = item % nblk, k0 = 64 * kb, n0 = 32 * nb;
#pragma unroll 8
    for (int i = 0; i < 32; ++i) { const int kk = 2 * i + (lane >> 5); scr[kk * 33 + (lane & 31)] = Wm[(size_t)(k0 + kk) * N + n0 + (lane & 31)]; }
    LDS_WAIT(); asm volatile("" ::: "memory");
    const int c = lane & 7;
#pragma unroll
    for (int j = 0; j < 4; ++j) { const int n = (lane >> 3) + 8 * j; const LAS float* s = scr + (8 * c) * 33 + n;
        v4u o; o.x = pk2(s[0 * 33], s[1 * 33]); o.y = pk2(s[2 * 33], s[3 * 33]); o.z = pk2(s[4 * 33], s[5 * 33]); o.w = pk2(s[6 * 33], s[7 * 33]);
        *(GAS v4u*)(WT + (size_t)(row_off + n0 + n) * K + k0 + 8 * c) = o; }
    LDS_WAIT(); asm volatile("" ::: "memory");
}
__device__ __forceinline__ void p0_prologue(Frame& F) {
    LAS float* scr = (LAS float*)(F.lds + F.wave * 16384);
    const int gw = F.vcu * NWAVES + F.wave, NGW = F.G * NWAVES, lane = F.lane;
    bf16* WIN = (bf16*)(F.ws + WS_WIN); bf16* WMKV = (bf16*)(F.ws + WS_WMKV); bf16* WBR = (bf16*)(F.ws + WS_WBR); bf16* WOUT = (bf16*)(F.ws + WS_WOUT);
    constexpr int I_IN = (DM / 64) * (NPROJ / 32), I_MK = (DM / 64) * (W / 32), I_BR = (W / 64) * (DM / 32), I_OUT = (DM / 64) * (DM / 32);
    constexpr int NITEMS = I_IN + 2 * I_MK + 3 * I_BR + I_OUT;
    for (int it = gw; it < NITEMS; it += NGW) {
        int r = it;
        if (r < I_IN) { p0_transpose_item(F.w_in, DM, NPROJ, WIN, 0, scr, r, lane); continue; } r -= I_IN;
        if (r < I_MK) { p0_transpose_item(F.w_mk, DM, W, WMKV, 0, scr, r, lane); continue; } r -= I_MK;
        if (r < I_MK) { p0_transpose_item(F.w_mv, DM, W, WMKV, W, scr, r, lane); continue; } r -= I_MK;
        if (r < I_BR) { p0_transpose_item(F.wba, W, DM, WBR, 0, scr, r, lane); continue; } r -= I_BR;
        if (r < I_BR) { p0_transpose_item(F.wbg, W, DM, WBR, DM, scr, r, lane); continue; } r -= I_BR;
        if (r < I_BR) { p0_transpose_item(F.wbm, W, DM, WBR, 2 * DM, scr, r, lane); continue; } r -= I_BR;
        p0_transpose_item(F.w_out, DM, DM, WOUT, 0, scr, r, lane);
    }
    { GAS v4u* xb = (GAS v4u*)(F.ws + WS_XB); const GAS f32x4* xs = (const GAS f32x4*)F.x;
      for (int i = gw; i < (M * DM) / 512; i += NGW) { const size_t ch = (size_t)i * 64 + lane; const f32x4 a = xs[2 * ch], b = xs[2 * ch + 1];
          v4u o; o.x = pk2(a[0], a[1]); o.y = pk2(a[2], a[3]); o.z = pk2(b[0], b[1]); o.w = pk2(b[2], b[3]); xb[ch] = o; }
      GAS v4u* mb = (GAS v4u*)(F.ws + WS_MEMB); const GAS f32x4* ms = (const GAS f32x4*)F.mem;
      for (int i = gw; i < (MM * DM) / 512; i += NGW) { const size_t ch = (size_t)i * 64 + lane; const f32x4 a = ms[2 * ch], b = ms[2 * ch + 1];
          v4u o; o.x = pk2(a[0], a[1]); o.y = pk2(a[2], a[3]); o.z = pk2(b[0], b[1]); o.w = pk2(b[2], b[3]); mb[ch] = o; } }
    { bf16* wsb = (bf16*)(F.ws + WS_WSB); float* c2 = (float*)(F.ws + WS_C2);
      for (int row = gw; row < SG * SC; row += NGW) { const int t = row % SC; float s = 0.f;
#pragma unroll
          for (int h = 0; h < 2; ++h) { const int sidx = lane + 64 * h; const float w = sidx <= t ? F.w_s[(size_t)row * SC + sidx] : 0.f; const unsigned short wb = (unsigned short)f2bf(w); wsb[(size_t)row * SC + sidx] = wb; s += bf2f(wb); }
          s = wave_sum(s); if (lane == 0) c2[row] = s; } }
}

__device__ __forceinline__ moba::BlockRef moba_ref(unsigned char* ws, int b, int h, int blk, int half) {
    const size_t row0 = (size_t)b * SEQ + (size_t)blk * MBLK, rb = (size_t)b * SEQ; bf16* act = (bf16*)(ws + WS_ACT); moba::BlockRef r;
    r.Q = act + A_QA * ACT_STRIDE + row0 * W + h * AD; r.K = act + A_KA * ACT_STRIDE + rb * W + h * AD; r.V = act + A_VA * ACT_STRIDE + rb * W + h * AD;
    r.PO = (bf16*)(ws + WS_PO) + (size_t)half * ACT_STRIDE + row0 * W + h * AD;
    r.ML = (float*)(ws + WS_ML) + ((size_t)half * M + row0) * (2 * AH) + h * 2;
    r.KM = (const float*)(ws + WS_KMEAN) + (size_t)(b * NBLK) * W + h * AD;
    r.P0 = blk * MBLK; r.blk = blk; const int nt = 4 * (blk + 1); r.j_lo = half ? nt / 2 : 0; r.j_hi = half ? nt : nt / 2;
    return r;
}
__device__ __forceinline__ void p3_combine(Frame& F) {
    const int gw = F.vcu * NWAVES + F.wave, NGW = F.G * NWAVES, lane = F.lane;
    const bf16* po0 = (const bf16*)(F.ws + WS_PO); const bf16* po1 = po0 + ACT_STRIDE; const float* ml0 = (const float*)(F.ws + WS_ML); const float* ml1 = ml0 + (size_t)M * 2 * AH;
    const bf16* za = (const bf16*)(F.ws + WS_ACT) + A_ZA * ACT_STRIDE; bf16* ya = (bf16*)(F.ws + WS_Y);
    constexpr float C2 = 1.4426950408889634f * moba::SCALE;
    for (int row = gw; row < M; row += NGW) {
#pragma unroll
        for (int c2 = 0; c2 < 2; ++c2) { const int col = c2 * 512 + lane * 8, head = col >> 7; const size_t e = (size_t)row * W + col;
            const f32x2v a = *(const f32x2v*)(ml0 + (size_t)row * 2 * AH + head * 2), b = *(const f32x2v*)(ml1 + (size_t)row * 2 * AH + head * 2);
            const float mx = fmaxf(a.x, b.x), w0 = a.y * __builtin_amdgcn_exp2f((a.x - mx) * C2), w1 = b.y * __builtin_amdgcn_exp2f((b.x - mx) * C2), inv = 1.0f / (w0 + w1), f0 = w0 * inv, f1 = w1 * inv;
            const v4u p0 = *(const v4u*)(po0 + e), p1 = *(const v4u*)(po1 + e), z = *(const v4u*)(za + e); v4u o;
#pragma unroll
            for (int j = 0; j < 4; ++j) { const float lo = (f0 * bflo(p0[j]) + f1 * bflo(p1[j])) * bflo(z[j]), hi = (f0 * bfhi(p0[j]) + f1 * bfhi(p1[j])) * bfhi(z[j]); o[j] = cvt_pk_bf16(lo, hi); }
            *(v4u*)(ya + e) = o; }
    }
}

struct Args { const float* in[15]; float* out; unsigned char* ws; int ph_lo, ph_hi, li, pad; };
__global__ void __launch_bounds__(NWAVES * 64, 2) mk_fwd(Args args) {
    extern __shared__ __attribute__((aligned(16))) unsigned char lds[];
    Frame F;
    F.lds = (LAS unsigned char*)lds;
    F.MISC = (volatile LAS unsigned*)(F.lds + MISC_OFF);
    F.tid = threadIdx.x; F.lane = F.tid & 63; F.wave = __builtin_amdgcn_readfirstlane(F.tid >> 6);
    F.G = gridDim.x; { const int bx = blockIdx.x; F.vcu = (F.G % 8 == 0) ? (bx % 8) * (F.G / 8) + bx / 8 : bx; }
    F.ws = args.ws; F.ctl = (gu32*)(args.ws + WS_CTL);
    F.x = args.in[0]; F.mem = args.in[1]; F.w_in = args.in[2]; F.w_mk = args.in[3]; F.w_mv = args.in[4]; F.w_s = args.in[5]; F.b_s = args.in[6]; F.lnvg = args.in[7]; F.lnvb = args.in[8];
    F.wba = args.in[9]; F.wbg = args.in[10]; F.wbm = args.in[11]; F.w_out = args.in[12]; F.ln_g = args.in[13]; F.ln_b = args.in[14]; F.out = args.out;
    for (int u = F.tid; u < (LDS_BYTES - LDSCTL_OFF) / 4; u += NWAVES * 64) ((LAS unsigned*)(F.lds + LDSCTL_OFF))[u] = 0u;
    __syncthreads();
    XcdBarrier bar = xcd_barrier_post((unsigned*)(F.ctl + CW_BAR) + args.li * XCD_BAR_WORDS, F.MISC + 8);
    const int lo = args.ph_lo, hi = args.ph_hi;
#define IN(k) (lo <= (k) && (k) < hi)
#define BOTH(k) (IN(k) && IN((k) + 1))
    unsigned char* ws = args.ws;
    if (IN(0)) { p0_prologue(F); if (BOTH(0)) xcd_barrier(bar); }
    if (IN(1)) {
        pg8::Gemm g{(const bf16*)(ws + WS_XB), (const bf16*)(ws + WS_WIN), DM}; pg8::P1Order S{F.G, (int)blockIdx.x};
        pg8::EpiProj E{(bf16*)(ws + WS_ACT), (bf16*)(ws + WS_GATES), (bf16*)(ws + WS_MEMK), (float*)(ws + WS_KMEAN), (float*)(ws + WS_VSTATS)};
        pg8::gemm_phase<pg8::EpiProj, pg8::P1Order, true, true>(F.lds, g, S, E);
        if (BOTH(1)) xcd_barrier(bar);
    }
    if (IN(2)) {
        if (F.G == 256) { const int v = F.vcu, bh = v >> 4, wq = v & 15, blkA = wq >> 1, half = wq & 1;
            const moba::BlockRef u0 = moba_ref(ws, bh >> 3, bh & 7, blkA, half), u1 = moba_ref(ws, bh >> 3, bh & 7, 15 - blkA, half);
            moba::Seam S; moba::prime(u0, (char*)lds, S); moba::block(u0, u1, (char*)lds, S); moba::block(u1, u1, (char*)lds, S); }
        if (BOTH(2)) xcd_barrier(bar);
    }
    if (IN(3)) {
        if (F.G == 256) { const int v = F.vcu;
            mix::mem_unit((char*)lds, ws, v >> 7, (v >> 5) & 3, (v >> 1) & 15, v & 1);
            mix::sgu_unit((char*)lds, ws, F.b_s, F.lnvg, F.lnvb, v >> 7, (v >> 2) & 31, v & 3); }
        p3_combine(F);
        if (BOTH(3)) xcd_barrier(bar);
    }
    const int tile = F.vcu;
    if (IN(4)) {
        pg8::Gemm g{(const bf16*)(ws + WS_Y), (const bf16*)(ws + WS_WBR), W}; pg8::BranchOrder S{tile >> 3, tile & 7};
        pg8::EpiBranch E{(const bf16*)(ws + WS_GATES), (bf16*)(ws + WS_MERGED)};
        if (F.G == 256) pg8::gemm_phase<pg8::EpiBranch, pg8::BranchOrder, false, true>(F.lds, g, S, E);
        if (BOTH(4)) xcd_barrier(bar);
    }
    if (IN(5)) {
        pg8::Gemm g{(const bf16*)(ws + WS_MERGED), (const bf16*)(ws + WS_WOUT), DM}; pg8::OneOrder S{tile >> 3, tile & 7};
        pg8::EpiOutLN E{F.x, F.out, F.ln_g, F.ln_b, (float*)(ws + WS_LNS), bar};
        if (F.G == 256) pg8::gemm_phase<pg8::EpiOutLN, pg8::OneOrder, false, true>(F.lds, g, S, E);
    }
#undef IN
#undef BOTH
}


#if HYBRID
__device__ __forceinline__ float sigmoidf_(float x) { return 1.f / (1.f + __expf(-x)); }
__device__ __forceinline__ float siluf_(float x) { return x * sigmoidf_(x); }
__device__ __forceinline__ float geluf_(float x) { return 0.5f * x * (1.f + tanhf(0.7978845608028654f * (x + 0.044715f * x * x * x))); }

struct LoadF32 { const float* p; __device__ float operator()(size_t i) const { return p[i]; } };
struct LoadBf { const bf16* p; __device__ float operator()(size_t i) const { return bf2f(p[i]); } };

template <class LA, class Epi>
__global__ void __launch_bounds__(256) ngemm(LA A, int lda, const float* B, int ldb, int K, Epi epi) {
    __shared__ float As[16][64 + 1], Bs[16][64 + 1];
    const int tx = threadIdx.x & 15, ty = threadIdx.x >> 4, m0 = blockIdx.y * 64, n0 = blockIdx.x * 64;
    float acc[4][4] = {};
    for (int k0 = 0; k0 < K; k0 += 16) {
        for (int i = threadIdx.x; i < 64 * 16; i += 256) { const int r = i >> 4, c = i & 15; As[c][r] = A((size_t)(m0 + r) * lda + k0 + c); }
        for (int i = threadIdx.x; i < 16 * 64; i += 256) { const int r = i >> 6, c = i & 63; Bs[r][c] = B[(size_t)(k0 + r) * ldb + n0 + c]; }
        __syncthreads();
#pragma unroll
        for (int kk = 0; kk < 16; ++kk) {
            float a[4], b[4];
#pragma unroll
            for (int i = 0; i < 4; ++i) { a[i] = As[kk][ty * 4 + i]; b[i] = Bs[kk][tx * 4 + i]; }
#pragma unroll
            for (int i = 0; i < 4; ++i)
#pragma unroll
                for (int j = 0; j < 4; ++j) acc[i][j] += a[i] * b[j];
        }
        __syncthreads();
    }
    for (int i = 0; i < 4; ++i) for (int j = 0; j < 4; ++j) epi(m0 + ty * 4 + i, n0 + tx * 4 + j, acc[i][j]);
}

struct EpiProjN {
    bf16* act; bf16* gates;
    __device__ void operator()(int m, int n, float v) const {
        if (n < 9 * W) { const int seg = n / W, c = n % W; float o = v;
            if (seg == A_ZA || seg == A_ZG || seg == A_ZC) o = siluf_(v); else if (seg == A_UG || seg == A_VG) o = geluf_(v);
            act[(size_t)seg * ACT_STRIDE + (size_t)m * W + c] = (bf16)f2bf(o); }
        else { gates[(size_t)m * (3 * DM) + (n - 9 * W)] = (bf16)f2bf(sigmoidf_(v)); }
    }
};
struct EpiStoreBf { bf16* o; int ldc; __device__ void operator()(int m, int n, float v) const { o[(size_t)m * ldc + n] = (bf16)f2bf(v); } };

__global__ void n_kmean(const bf16* KA, float* kmean) {
    const int pb = blockIdx.x;
    for (int c = threadIdx.x; c < W; c += blockDim.x) { float s = 0.f; for (int r = 0; r < MBLK; ++r) s += bf2f(KA[(size_t)(pb * MBLK + r) * W + c]); kmean[(size_t)pb * W + c] = s * (1.f / MBLK); kmean[KM_SLOT + (size_t)pb * W + c] = 0.f; }
}
__global__ void n_vstats(const bf16* VG, float* vst) {
    const int m = blockIdx.x; float s = 0.f, q = 0.f;
    for (int c = threadIdx.x; c < W; c += 64) { const float v = bf2f(VG[(size_t)m * W + c]); s += v; q += v * v; }
    for (int o = 32; o; o >>= 1) { s += __shfl_xor(s, o); q += __shfl_xor(q, o); }
    if (threadIdx.x < 16) { vst[((size_t)m * 16 + threadIdx.x) * 2] = threadIdx.x == 0 ? s : 0.f; vst[((size_t)m * 16 + threadIdx.x) * 2 + 1] = threadIdx.x == 0 ? q : 0.f; }
}
__global__ void __launch_bounds__(256) n_attn(const bf16* QA, const bf16* KA, const bf16* VA, const bf16* ZA, const float* kmean, bf16* YA) {
    __shared__ float q[AD], sc[NBLK], p[4 * MBLK], red[256]; __shared__ int selblk[4]; __shared__ int nsel;
    const int m = blockIdx.x, h = blockIdx.y, b = m / SEQ, t = m % SEQ, blk = t / MBLK, tid = threadIdx.x;
    if (tid < AD) q[tid] = bf2f(QA[(size_t)m * W + h * AD + tid]);
    __syncthreads();
    if (tid < NBLK) { float s = 0.f; for (int d = 0; d < AD; ++d) { const size_t ki = (size_t)(b * NBLK + tid) * W + h * AD + d; s += q[d] * (kmean[ki] + kmean[KM_SLOT + ki]); } sc[tid] = s; }
    __syncthreads();
    if (tid == 0) { unsigned used = 0; int ns = 0; const int want = blk < 3 ? blk : 3;
        for (int k = 0; k < want; ++k) { float best = -INFINITY; int bi = -1; for (int n = 0; n < blk; ++n) if (!((used >> n) & 1) && (bi < 0 || sc[n] > best)) { best = sc[n]; bi = n; } used |= 1u << bi; selblk[ns++] = bi; }
        selblk[ns++] = blk; nsel = ns; }
    __syncthreads();
    const int ns = nsel; const float scale = 0.08838834764831845f;
    float lmax = -INFINITY;
    for (int i = tid; i < ns * MBLK; i += 256) { const int kb = selblk[i / MBLK], kpos = kb * MBLK + (i % MBLK); float s = -INFINITY;
        if (kpos <= t) { s = 0.f; const bf16* kr = KA + (size_t)(b * SEQ + kpos) * W + h * AD; for (int d = 0; d < AD; ++d) s += q[d] * bf2f(kr[d]); s *= scale; }
        p[i] = s; lmax = fmaxf(lmax, s); }
    red[tid] = lmax; __syncthreads();
    for (int o = 128; o; o >>= 1) { if (tid < o) red[tid] = fmaxf(red[tid], red[tid + o]); __syncthreads(); }
    const float mx = red[0]; __syncthreads();
    float ls = 0.f;
    for (int i = tid; i < ns * MBLK; i += 256) { const float e = __expf(p[i] - mx); p[i] = e; ls += e; }
    red[tid] = ls; __syncthreads();
    for (int o = 128; o; o >>= 1) { if (tid < o) red[tid] += red[tid + o]; __syncthreads(); }
    const float inv = 1.f / red[0];
    if (tid < AD) { float o = 0.f;
        for (int i = 0; i < ns * MBLK; ++i) { const int kpos = selblk[i / MBLK] * MBLK + (i % MBLK); o += p[i] * bf2f(VA[(size_t)(b * SEQ + kpos) * W + h * AD + tid]); }
        const size_t oi = (size_t)m * W + h * AD + tid; YA[oi] = (bf16)f2bf(o * inv * bf2f(ZA[oi])); }
}
__global__ void __launch_bounds__(1024) n_sgu(const bf16* UG, const bf16* VG, const bf16* ZG, const float* vst, const float* w_s, const float* b_s, const float* lng, const float* lnb, bf16* YG) {
    __shared__ float mu[SC], rs[SC];
    const int m = blockIdx.x, t = m % SC, m0 = m - t, ch = threadIdx.x, g = ch / SGD;
    if (ch <= t) { float s = 0.f, q = 0.f; for (int j = 0; j < 16; ++j) { s += vst[((size_t)(m0 + ch) * 16 + j) * 2]; q += vst[((size_t)(m0 + ch) * 16 + j) * 2 + 1]; }
        const float mean = s / W, var = q / W - mean * mean; mu[ch] = mean; rs[ch] = rsqrtf(var + LN_EPS); }
    __syncthreads();
    float acc = 0.f; const float gm = lng[ch], bt = lnb[ch];
    for (int s = 0; s <= t; ++s) acc += w_s[((size_t)g * SC + t) * SC + s] * ((bf2f(VG[(size_t)(m0 + s) * W + ch]) - mu[s]) * rs[s] * gm + bt);
    acc += b_s[g * SC + t];
    const size_t oi = (size_t)m * W + ch; YG[oi] = (bf16)f2bf(bf2f(UG[oi]) * acc * bf2f(ZG[oi]));
}
__global__ void __launch_bounds__(256) n_mem(const bf16* QC, const bf16* ZC, const bf16* MK, const bf16* MV, bf16* YC) {
    __shared__ float q[MD], p[NMEM], red[256];
    const int m = blockIdx.x, h = blockIdx.y, b = m / SEQ, tid = threadIdx.x;
    q[tid] = bf2f(QC[(size_t)m * W + h * MD + tid]); __syncthreads();
    float s = 0.f; { const bf16* kr = MK + (size_t)(b * NMEM + tid) * W + h * MD; for (int d = 0; d < MD; ++d) s += q[d] * bf2f(kr[d]); s *= 0.0625f; }
    red[tid] = s; __syncthreads();
    for (int o = 128; o; o >>= 1) { if (tid < o) red[tid] = fmaxf(red[tid], red[tid + o]); __syncthreads(); }
    const float mx = red[0]; __syncthreads();
    const float e = __expf(s - mx); p[tid] = e; red[tid] = e; __syncthreads();
    for (int o = 128; o; o >>= 1) { if (tid < o) red[tid] += red[tid + o]; __syncthreads(); }
    const float inv = 1.f / red[0];
    float o = 0.f; for (int k = 0; k < NMEM; ++k) o += p[k] * bf2f(MV[(size_t)(b * NMEM + k) * W + h * MD + tid]);
    const size_t oi = (size_t)m * W + h * MD + tid; YC[oi] = (bf16)f2bf(o * inv * bf2f(ZC[oi]));
}
__global__ void __launch_bounds__(256) n_branch(const bf16* Y, const float* w0, const float* w1, const float* w2, const bf16* gates, bf16* merged) {
    __shared__ float As[16][65], Bs[16][65];
    const int tx = threadIdx.x & 15, ty = threadIdx.x >> 4, m0 = blockIdx.y * 64, n0 = blockIdx.x * 64;
    float tot[4][4] = {};
    for (int br = 0; br < 3; ++br) { const bf16* A = Y + (size_t)br * ACT_STRIDE; const float* B = br == 0 ? w0 : br == 1 ? w1 : w2; float acc[4][4] = {};
        for (int k0 = 0; k0 < W; k0 += 16) {
            for (int i = threadIdx.x; i < 1024; i += 256) { const int r = i >> 4, c = i & 15; As[c][r] = bf2f(A[(size_t)(m0 + r) * W + k0 + c]); }
            for (int i = threadIdx.x; i < 1024; i += 256) { const int r = i >> 6, c = i & 63; Bs[r][c] = B[(size_t)(k0 + r) * DM + n0 + c]; }
            __syncthreads();
            for (int kk = 0; kk < 16; ++kk) for (int i = 0; i < 4; ++i) for (int j = 0; j < 4; ++j) acc[i][j] += As[kk][ty * 4 + i] * Bs[kk][tx * 4 + j];
            __syncthreads(); }
        for (int i = 0; i < 4; ++i) for (int j = 0; j < 4; ++j) tot[i][j] += bf2f(gates[(size_t)(m0 + ty * 4 + i) * (3 * DM) + br * DM + n0 + tx * 4 + j]) * acc[i][j]; }
    for (int i = 0; i < 4; ++i) for (int j = 0; j < 4; ++j) merged[(size_t)(m0 + ty * 4 + i) * DM + n0 + tx * 4 + j] = (bf16)f2bf(tot[i][j]);
}
struct EpiResid { const float* x; float* h; __device__ void operator()(int m, int n, float v) const { const size_t i = (size_t)m * DM + n; h[i] = DN_ALPHA * x[i] + v; } };
__global__ void __launch_bounds__(256) n_ln(const float* h, const float* g, const float* b, float* out) {
    __shared__ float red[256]; const int m = blockIdx.x, tid = threadIdx.x; float s = 0.f;
    for (int c = tid; c < DM; c += 256) s += h[(size_t)m * DM + c];
    red[tid] = s; __syncthreads(); for (int o = 128; o; o >>= 1) { if (tid < o) red[tid] += red[tid + o]; __syncthreads(); }
    const float mean = red[0] / DM; __syncthreads(); float q = 0.f;
    for (int c = tid; c < DM; c += 256) { const float d = h[(size_t)m * DM + c] - mean; q += d * d; }
    red[tid] = q; __syncthreads(); for (int o = 128; o; o >>= 1) { if (tid < o) red[tid] += red[tid + o]; __syncthreads(); }
    const float rstd = rsqrtf(red[0] / DM + LN_EPS);
    for (int c = tid; c < DM; c += 256) out[(size_t)m * DM + c] = (h[(size_t)m * DM + c] - mean) * rstd * g[c] + b[c];
}

#endif


extern "C" void kernel_launch(void* const* d_in, const int* in_sizes, int n_in, void* d_out, int out_size, void* d_ws, size_t ws_size, hipStream_t stream) {
    static int grid = 0;
    if (grid == 0) {
        if (n_in != 15 || in_sizes[0] != M * DM || in_sizes[2] != DM * NPROJ || out_size != M * DM || ws_size < WS_END) { fprintf(stderr, "kernel_launch: unexpected shapes (n_in %d, ws %zu); nothing launched\n", n_in, ws_size); grid = -1; return; }
        int dev = 0, cus = 0, per_cu = 0;
        if (hipGetDevice(&dev) != hipSuccess || hipDeviceGetAttribute(&cus, hipDeviceAttributeMultiprocessorCount, dev) != hipSuccess) { grid = -1; return; }
        if (hipFuncSetAttribute((const void*)mk_fwd, hipFuncAttributeMaxDynamicSharedMemorySize, LDS_BYTES) != hipSuccess) { fprintf(stderr, "kernel_launch: hipFuncSetAttribute failed\n"); grid = -1; return; }
        if (hipOccupancyMaxActiveBlocksPerMultiprocessor(&per_cu, (const void*)mk_fwd, NWAVES * 64, LDS_BYTES) != hipSuccess || per_cu < 1) fprintf(stderr, "kernel_launch: occupancy query reports %d workgroups per CU\n", per_cu);
        (void)hipGetLastError();
        grid = cus;
        if (grid != 256) fprintf(stderr, "kernel_launch: %d CUs; the one-tile-per-workgroup phases need 256\n", grid);
    }
    if (grid < 0) return;
    (void)hipMemsetAsync((char*)d_ws + WS_CTL, 0, CTL_ZERO_BYTES, stream);
    Args a{};
    for (int i = 0; i < 15; ++i) a.in[i] = (const float*)d_in[i];
    a.out = (float*)d_out; a.ws = (unsigned char*)d_ws;
#if HYBRID
    unsigned char* ws = (unsigned char*)d_ws;
    bf16* act = (bf16*)(ws + WS_ACT); bf16* memk = (bf16*)(ws + WS_MEMK); bf16* memv = (bf16*)(ws + WS_MEMV); bf16* Y = (bf16*)(ws + WS_Y); float* kmean = (float*)(ws + WS_KMEAN); float* vst = (float*)(ws + WS_VSTATS);
    a.ph_lo = 0; a.ph_hi = 4; a.li = 0;
    hipLaunchKernelGGL(mk_fwd, dim3(grid), dim3(NWAVES * 64), LDS_BYTES, stream, a);
    n_sgu<<<M, 1024, 0, stream>>>(act + A_UG * ACT_STRIDE, act + A_VG * ACT_STRIDE, act + A_ZG * ACT_STRIDE, vst, (const float*)d_in[5], (const float*)d_in[6], (const float*)d_in[7], (const float*)d_in[8], Y + ACT_STRIDE);
    n_mem<<<dim3(M, MH), 256, 0, stream>>>(act + A_QC * ACT_STRIDE, act + A_ZC * ACT_STRIDE, memk, memv, Y + 2 * ACT_STRIDE);
#if HYBRID == 2
    { bf16* gates = (bf16*)(ws + WS_GATES); bf16* merged = (bf16*)(ws + WS_MERGED); float* hbuf = (float*)(ws + WS_H);
      n_branch<<<dim3(DM / 64, M / 64), 256, 0, stream>>>(Y, (const float*)d_in[9], (const float*)d_in[10], (const float*)d_in[11], gates, merged);
      ngemm<LoadBf, EpiResid><<<dim3(DM / 64, M / 64), 256, 0, stream>>>(LoadBf{merged}, DM, (const float*)d_in[12], DM, DM, EpiResid{(const float*)d_in[0], hbuf});
      n_ln<<<M, 256, 0, stream>>>(hbuf, (const float*)d_in[13], (const float*)d_in[14], (float*)d_out); }
#else
    a.ph_lo = 4; a.ph_hi = 6; a.li = 1;
    hipLaunchKernelGGL(mk_fwd, dim3(grid), dim3(NWAVES * 64), LDS_BYTES, stream, a);
#endif
#else
    a.ph_lo = 0; a.ph_hi = N_PHASES; a.li = 0;
    hipLaunchKernelGGL(mk_fwd, dim3(grid), dim3(NWAVES * 64), LDS_BYTES, stream, a);
#endif
    const hipError_t le = hipPeekAtLastError();
    if (le != hipSuccess) fprintf(stderr, "kernel_launch: launch failed: %s\n", hipGetErrorName(le));
}
```

```cpp
#include <hip/hip_runtime.h>
#include <cstdio>
#include <cstdint>


constexpr int DM = 2048, NB = 2, SEQ = 4096, M = NB * SEQ;
constexpr int NMEM = 256, MM = NB * NMEM;
constexpr int W = 1024;
constexpr int NPROJ = 15360;
constexpr int AH = 8, AD = 128, MBLK = 256, NBLK = SEQ / MBLK;
constexpr int SG = 8, SC = 128, SGD = 128;
constexpr int MH = 4, MD = 256;
constexpr float DN_ALPHA = 1.189207115002721f;
constexpr float LN_EPS = 1e-5f;

constexpr size_t MiB = 1u << 20;
constexpr size_t WS_CTL = 0, CTL_ZERO_BYTES = 1 * MiB;
constexpr size_t WS_KMEAN = 1 * MiB;
constexpr size_t WS_C2 = 1 * MiB + 256 * 1024;
constexpr size_t WS_WSB = 1 * MiB + 512 * 1024;
constexpr size_t WS_LNS = 24 * MiB;
constexpr size_t WS_WBR = 2 * MiB;
constexpr size_t WS_WOUT = 14 * MiB;
constexpr size_t WS_VSTATS = 22 * MiB;
constexpr size_t WS_ML = 23 * MiB;
constexpr size_t WS_WIN = 32 * MiB;
constexpr size_t WS_WMKV = 92 * MiB;
constexpr size_t WS_XB = 100 * MiB;
constexpr size_t WS_MEMB = 132 * MiB;
constexpr size_t WS_ACT = 134 * MiB;
constexpr size_t ACT_STRIDE = (size_t)M * W;
constexpr size_t KM_SLOT = (size_t)NB * NBLK * W;
constexpr size_t WS_GATES = 278 * MiB;
constexpr size_t WS_MEMK = 374 * MiB;
constexpr size_t WS_MEMV = 375 * MiB;
constexpr size_t WS_Y = 376 * MiB;
constexpr size_t WS_MERGED = 424 * MiB;
constexpr float QM = 128.f;
constexpr float QX = 32.f, QW = 1024.f, QWB = 2048.f;
constexpr size_t WS_WQ = 68 * MiB;
constexpr size_t WS_XQ = 456 * MiB;
constexpr size_t WS_MQ = 472 * MiB;
constexpr size_t WS_END = 473 * MiB;
constexpr size_t WS_PO = 32 * MiB;
constexpr size_t WS_POS = 326 * MiB;
constexpr size_t WS_ML4 = 26 * MiB;
constexpr size_t WS_LIST = 28 * MiB;
constexpr int LCAP = NBLK * MBLK;
constexpr size_t WS_H = 32 * MiB;
enum { A_QA = 0, A_KA, A_VA, A_ZA, A_UG, A_VG, A_ZG, A_QC, A_ZC };
static_assert(WS_WIN + (size_t)NPROJ * DM * 2 == WS_WMKV && WS_XB + (size_t)M * DM * 2 == WS_MEMB && WS_MEMB + (size_t)MM * DM * 2 == WS_ACT, "virtual concatenations");
static_assert(WS_ACT + 9 * ACT_STRIDE * 2 == WS_GATES && WS_GATES + (size_t)M * 3 * DM * 2 == WS_MEMK && WS_Y + 3 * ACT_STRIDE * 2 == WS_MERGED, "d_ws map");

typedef unsigned short bf16;
__host__ __device__ __forceinline__ unsigned f2bf(float f) { unsigned u = __builtin_bit_cast(unsigned, f); return (u + 0x7fffu + ((u >> 16) & 1u)) >> 16; }
__host__ __device__ __forceinline__ float bf2f(unsigned short h) { return __builtin_bit_cast(float, (unsigned)h << 16); }


#define GAS __attribute__((address_space(1)))
#define LAS __attribute__((address_space(3)))
typedef unsigned v4u __attribute__((ext_vector_type(4)));
typedef unsigned v2u __attribute__((ext_vector_type(2)));
typedef float f32x4 __attribute__((ext_vector_type(4)));
typedef float f32x2v __attribute__((ext_vector_type(2)));
typedef short bf16x8 __attribute__((ext_vector_type(8)));
typedef GAS unsigned gu32;
#define RLX_AGENT __ATOMIC_RELAXED, __HIP_MEMORY_SCOPE_AGENT
#define LDS_WAIT() asm volatile("s_waitcnt lgkmcnt(0)" ::: "memory")
#define VM_WAIT() asm volatile("s_waitcnt vmcnt(0)" ::: "memory")
__device__ __forceinline__ unsigned pk2(float lo, float hi) { return f2bf(lo) | (f2bf(hi) << 16); }
typedef float f32x2_t __attribute__((ext_vector_type(2))); typedef __bf16 bf16x2_t __attribute__((ext_vector_type(2)));
__device__ __forceinline__ unsigned cvt_pk_bf16(float lo, float hi) { f32x2_t v = {lo, hi}; bf16x2_t b = __builtin_convertvector(v, bf16x2_t); return __builtin_bit_cast(unsigned, b); }
__device__ __forceinline__ unsigned q8(float v, float s) { return (unsigned)(int)__builtin_rintf(__builtin_fminf(__builtin_fmaxf(v * s, -127.f), 127.f)) & 0xffu; }
__device__ __forceinline__ unsigned pk4_i8(float a, float b, float c, float d, float s) { return q8(a, s) | (q8(b, s) << 8) | (q8(c, s) << 16) | (q8(d, s) << 24); }
__device__ __forceinline__ float bflo(unsigned w) { return __builtin_bit_cast(float, w << 16); }
__device__ __forceinline__ float bfhi(unsigned w) { return __builtin_bit_cast(float, w & 0xffff0000u); }

__device__ __forceinline__ float sum_xor16(float s) { const unsigned u = __builtin_bit_cast(unsigned, s); unsigned u2 = u; asm volatile("" : "+v"(u2)); auto r = __builtin_amdgcn_permlane16_swap(u, u2, false, false); const unsigned a_ = r[0], b_ = r[1]; return __builtin_bit_cast(float, a_) + __builtin_bit_cast(float, b_); }
__device__ __forceinline__ float sum_xor32(float s) { const unsigned u = __builtin_bit_cast(unsigned, s); unsigned u2 = u; asm volatile("" : "+v"(u2)); auto r = __builtin_amdgcn_permlane32_swap(u, u2, false, false); const unsigned a_ = r[0], b_ = r[1]; return __builtin_bit_cast(float, a_) + __builtin_bit_cast(float, b_); }
__device__ __forceinline__ int opaque_tid() { int t = threadIdx.x; asm volatile("" : "+v"(t)); return t; }

#if defined(TS_PHASE) && TS_PHASE >= 30 && TS_PHASE < 60
__device__ unsigned long long g_tsp;
#define TSP(id) do { if (((TS_PHASE == (id) && blockIdx.x == 0) || (TS_PHASE == (id) + 10 && blockIdx.x == 120)) && threadIdx.x == 448) g_tsp = __builtin_amdgcn_s_memrealtime(); } while (0)
#else
#define TSP(id) do {} while (0)
#endif

#define XB_TMO      128
#define XB_XCNT(j)  (256  + 64 * (j))
#define XB_XSUB(j)  (1280 + 64 * (j))
#define XB_XGEN(j)  (2304 + 64 * (j))
#define XB_TOP      3328
#define XB_TOPGEN   3392
#define XCD_BAR_WORDS 3456
#define XB_SPIN_CAP (1u << 18)

__device__ __forceinline__ unsigned xb_ld(unsigned* p)              { return __hip_atomic_load(p, __ATOMIC_RELAXED, __HIP_MEMORY_SCOPE_AGENT); }
__device__ __forceinline__ unsigned xb_add(unsigned* p, unsigned v) { return __hip_atomic_fetch_add(p, v, __ATOMIC_RELAXED, __HIP_MEMORY_SCOPE_AGENT); }
__device__ __forceinline__ unsigned xb_xcc_id() { return (unsigned)__builtin_amdgcn_s_getreg((3 << 11) | 20) & 0xFu; }
#define XB_SPIN(cond, bar) do { unsigned _sp = 0; while (cond) { __builtin_amdgcn_s_sleep(1); \
    if ((++_sp & 255u) == 0u) { if (xb_ld(&(bar)[XB_TMO])) break; if (_sp > XB_SPIN_CAP) { atomicAdd(&(bar)[XB_TMO], 1u); break; } } } } while (0)

struct XcdBarrier {
    unsigned* bar; unsigned x;
    volatile LAS unsigned* st;
};

__device__ __forceinline__ XcdBarrier xcd_barrier_post(unsigned* bar, volatile LAS unsigned* st) {
    XcdBarrier b; b.bar = bar; b.x = xb_xcc_id(); b.st = st;
    if (threadIdx.x == 0) (void)xb_add(&bar[XB_XCNT(b.x)], 1u);
    return b;
}
__device__ __forceinline__ void xcd_barrier_complete(unsigned* bar, unsigned x, unsigned& nloc, unsigned& nx) {
    const unsigned G = gridDim.x * gridDim.y * gridDim.z;
    unsigned sum, cnt, mine, sp = 0u;
    for (;;) {
        sum = 0u; cnt = 0u; mine = 0u;
#pragma unroll
        for (unsigned j = 0; j < 16; ++j) { const unsigned c = xb_ld(&bar[XB_XCNT(j)]); sum += c; cnt += (c > 0u) ? 1u : 0u; mine = (j == x) ? c : mine; }
        if (sum == G) break;
        __builtin_amdgcn_s_sleep(1);
        if ((++sp & 255u) == 0u) { if (xb_ld(&bar[XB_TMO])) break; if (sp > XB_SPIN_CAP) { atomicAdd(&bar[XB_TMO], 1u); break; } }
    }
    nloc = mine > 0u ? mine : 1u; nx = cnt > 0u ? cnt : 1u;
}

__device__ __forceinline__ void xcd_barrier(const XcdBarrier& b) {
    asm volatile("s_waitcnt vmcnt(0)" ::: "memory");
    __syncthreads();
    if (threadIdx.x == 0) {
        unsigned* bar = b.bar;
        __builtin_amdgcn_s_waitcnt(0);
        unsigned nloc = b.st[0], nx = b.st[1];
        if (nloc == 0u) { xcd_barrier_complete(bar, b.x, nloc, nx); b.st[0] = nloc; b.st[1] = nx; }
        const unsigned old = xb_add(&bar[XB_XSUB(b.x)], 1u);
        const unsigned gen = old / nloc;
        if (old + 1u == (gen + 1u) * nloc) {
            __builtin_amdgcn_fence(__ATOMIC_RELEASE, "agent");
            asm volatile("s_waitcnt vmcnt(0)" ::: "memory");
            const unsigned og = xb_add(&bar[XB_TOP], 1u);
            const unsigned tg = og / nx;
            if (og + 1u == (tg + 1u) * nx) xb_add(&bar[XB_TOPGEN], 1u);
            else XB_SPIN(xb_ld(&bar[XB_TOPGEN]) == tg, bar);
            __builtin_amdgcn_fence(__ATOMIC_ACQUIRE, "agent");
            xb_add(&bar[XB_XGEN(b.x)], 1u);
            asm volatile("s_waitcnt vmcnt(0)" ::: "memory");
        } else {
            XB_SPIN((int)(xb_ld(&bar[XB_XGEN(b.x)]) - gen) <= 0, bar);
            __builtin_amdgcn_fence(__ATOMIC_ACQUIRE, "agent");
            asm volatile("s_waitcnt vmcnt(0)" ::: "memory");
        }
    }
    __syncthreads();
}

__device__ __forceinline__ void xcd_barrier_arrive(const XcdBarrier& b) {
    asm volatile("s_waitcnt vmcnt(0)" ::: "memory");
    __syncthreads();
    if (threadIdx.x == 0) {
        unsigned* bar = b.bar;
        __builtin_amdgcn_s_waitcnt(0);
        unsigned nloc = b.st[0], nx = b.st[1];
        if (nloc == 0u) { xcd_barrier_complete(bar, b.x, nloc, nx); b.st[0] = nloc; b.st[1] = nx; }
        const unsigned old = xb_add(&bar[XB_XSUB(b.x)], 1u);
        const unsigned gen = old / nloc; unsigned role = 0u, tg = 0u;
        if (old + 1u == (gen + 1u) * nloc) {
            __builtin_amdgcn_fence(__ATOMIC_RELEASE, "agent");
            asm volatile("s_waitcnt vmcnt(0)" ::: "memory");
            const unsigned og = xb_add(&bar[XB_TOP], 1u);
            tg = og / nx;
            if (og + 1u == (tg + 1u) * nx) { xb_add(&bar[XB_TOPGEN], 1u); role = 2u; } else role = 1u;
        }
        b.st[2] = gen; b.st[3] = tg; b.st[4] = role;
    }
}
__device__ __forceinline__ void xcd_barrier_wait(const XcdBarrier& b) {
    __syncthreads();
    if (threadIdx.x == 0) {
        unsigned* bar = b.bar;
        const unsigned gen = b.st[2], role = b.st[4];
        XB_SPIN(xb_ld(&bar[XB_TOPGEN]) == gen, bar);
        __builtin_amdgcn_fence(__ATOMIC_ACQUIRE, "agent");
        if (role != 0u) xb_add(&bar[XB_XGEN(b.x)], 1u);
        asm volatile("s_waitcnt vmcnt(0)" ::: "memory");
    }
    __syncthreads();
}


namespace pg8 {
#define PG8_LAS __attribute__((address_space(3)))
typedef unsigned short bf16_t;
typedef unsigned u32x4 __attribute__((ext_vector_type(4)));
constexpr int BM = 256, BK = 64, HALF = 128, HTB = HALF * BK * 2  , STAGE_BYTES = 8 * HTB, NXCD = 8, WGM = 8;

__host__ __device__ __forceinline__ int lds_byte(int r, int c) { const int st = (r >> 4) * 2 + (c >> 5), rr = r & 15, cc = c & 31, ob = rr * 64 + cc * 2; return st * 1024 + (ob ^ (((ob >> 9) & 1) << 5)); }
__host__ __device__ __forceinline__ void stage_rc(int b, int& R, int& C) { const int st = b / 1024, sb = b % 1024, swz = sb ^ (((sb >> 9) & 1) << 5); R = (st >> 1) * 16 + swz / 64; C = (st & 1) * 32 + (swz % 64) / 2; }
__host__ __device__ __forceinline__ int perm32(int rho) { const int n = rho >> 4, i = rho & 15; return 8 * (i >> 2) + 4 * n + (i & 3); }

struct Unit { int pm, pn; };
struct Gemm { const bf16_t* A; const bf16_t* Bt; int K; };

struct GateOrder {
    int G, c;
    __device__ __forceinline__ bool next(int i, Unit& u) const {
        const int L = i * G + c; if (L >= 1920 + 16) return false;
        if (L >= 1920) { const int j = L - 1920; u.pm = 32 + (j >> 3); u.pn = 60 + (j & 7); return true; }
        const int wgid = (L % NXCD) * 240 + L / NXCD;
        const int w = wgid % 480; u.pm = (wgid / 480) * WGM + (w % WGM); u.pn = w / WGM; return true;
    }
    __device__ __forceinline__ void a_ready(const Unit&) const {}
    __device__ __forceinline__ void done(const Unit&) const {}
};
struct BranchOrder {
    int pm, pn;
    __device__ __forceinline__ bool next(int i, Unit& u) const { if (i >= 3) return false; u.pm = i * 32 + pm; u.pn = i * 8 + pn; return true; }
    __device__ __forceinline__ void a_ready(const Unit&) const {}
    __device__ __forceinline__ void done(const Unit&) const {}
};
struct OneOrder {
    int pm, pn;
    __device__ __forceinline__ bool next(int i, Unit& u) const { if (i >= 1) return false; u.pm = pm; u.pn = pn; return true; }
    __device__ __forceinline__ void a_ready(const Unit&) const {}
    __device__ __forceinline__ void done(const Unit&) const {}
};


typedef int v4i_t __attribute__((ext_vector_type(4)));
#if defined(TS_PHASE) && TS_PHASE >= 100
#define TS_EPI ((TS_PHASE / 100) % 10)
#define TS_BLK (TS_PHASE % 100)
__device__ unsigned g_epi_ticks;
#endif
template <class Epi, class Sched, bool ALIGN_EPI = false, bool SP2 = false, bool FP8 = false>
__device__ __forceinline__ void gemm_phase(PG8_LAS unsigned char* lds, const Gemm g, const Sched& S, const Epi& E) {
    const int tid = opaque_tid(), wid = __builtin_amdgcn_readfirstlane(tid >> 6), lane = tid & 63, wr = wid >> 2, wc = wid & 3, fr = lane & 15, fq = lane >> 4;
    const int K = g.K, nt = FP8 ? K / 128 : K / BK;
    unsigned voffA[2], voffB[2];
#pragma unroll
    for (int i = 0; i < 2; ++i) { int R, C; stage_rc(tid * 16 + i * 8192, R, C); const int Rb = Epi::PERM ? ((R & ~31) + perm32(R & 31)) : R;
        voffA[i] = FP8 ? (unsigned)(R * K + 2 * C) : (unsigned)(R * K + C) * 2u; voffB[i] = FP8 ? (unsigned)(Rb * K + 2 * C) : (unsigned)(Rb * K + C) * 2u; }
    const unsigned kstep = (unsigned)(BK * 2);
    const unsigned hstep = (unsigned)HALF * K * (FP8 ? 1 : 2);
    const unsigned tstep = 2 * hstep;
    const __amdgpu_buffer_rsrc_t rsrc_voffA = __builtin_amdgcn_make_buffer_rsrc((void*)g.A, 0, 0x7fffffff, 0x00020000), rsrc_voffB = __builtin_amdgcn_make_buffer_rsrc((void*)g.Bt, 0, 0x7fffffff, 0x00020000);
    const unsigned ldsw = (unsigned)wid * 1024u;
    const int aoff = lds_byte(wr * 64 + fr, fq * 8), boff = lds_byte(wc * 32 + fr, fq * 8);
#define PG8_SA(b, h) (((b) * 2 + (h)) * HTB)
#define PG8_SB(b, h) ((4 + (b) * 2 + (h)) * HTB)
#define PG8_STAGE(bufoff, gbase, voff) do { const unsigned _so = (unsigned)__builtin_amdgcn_readfirstlane((int)(gbase)); _Pragma("unroll") for (int _i = 0; _i < 2; ++_i) \
        __builtin_amdgcn_raw_ptr_buffer_load_lds(rsrc_##voff, (PG8_LAS unsigned*)(lds + (bufoff) + ldsw + _i * 8192), 16, (int)(voff)[_i], (int)_so, 0, 0); } while (0)
#define PG8_LDA(dst, b, h) do { _Pragma("unroll") for (int m = 0; m < 4; ++m) _Pragma("unroll") for (int k = 0; k < 2; ++k) dst[m][k] = *(const PG8_LAS bf16x8*)(lds + PG8_SA(b, h) + aoff + m * 2048 + k * 1024); } while (0)
#define PG8_LDB(dst, b, h) do { _Pragma("unroll") for (int n = 0; n < 2; ++n) _Pragma("unroll") for (int k = 0; k < 2; ++k) dst[n][k] = *(const PG8_LAS bf16x8*)(lds + PG8_SB(b, h) + boff + n * 2048 + k * 1024); } while (0)
#define PG8_MMA(ai, bj, At, Bt) do { __builtin_amdgcn_s_setprio(1); \
        if constexpr (FP8) { _Pragma("unroll") for (int m = 0; m < 4; ++m) _Pragma("unroll") for (int n = 0; n < 2; ++n) _Pragma("unroll") for (int k = 0; k < 2; ++k) \
            acc[ai][bj][m][n] = __builtin_bit_cast(f32x4, __builtin_amdgcn_mfma_i32_16x16x64_i8(__builtin_bit_cast(v4i_t, Bt[n][k]), __builtin_bit_cast(v4i_t, At[m][k]), __builtin_bit_cast(v4i_t, acc[ai][bj][m][n]), 0, 0, 0)); } \
        else { _Pragma("unroll") for (int m = 0; m < 4; ++m) _Pragma("unroll") for (int n = 0; n < 2; ++n) _Pragma("unroll") for (int k = 0; k < 2; ++k) \
            acc[ai][bj][m][n] = __builtin_amdgcn_mfma_f32_16x16x32_bf16(Bt[n][k], At[m][k], acc[ai][bj][m][n], 0, 0, 0); } \
        __builtin_amdgcn_s_setprio(0); } while (0)
#define PG8_WAIT_V(n) asm volatile("s_waitcnt vmcnt(" #n ")" ::: "memory")
#define PG8_WAIT_V1() do { if constexpr (Epi::EPI_STORES >= 16) { if (t == 0 && ui > 0) PG8_WAIT_V(24); else PG8_WAIT_V(8); } else PG8_WAIT_V(8); } while (0)
#define PG8_WAIT_L(n) asm volatile("s_waitcnt lgkmcnt(" #n ")" ::: "memory")
#define PG8_BAR __builtin_amdgcn_s_barrier()
#define PG8_SCHED __builtin_amdgcn_sched_barrier(0)
    Unit cur, nxt; int ui = 0;
#ifdef TS_EPI
    unsigned epi_ticks_ = 0;
#endif
    typename Epi::HookState xh{};
    if (!S.next(0, cur)) return;
    f32x4 acc[2][2][4][2];
#pragma unroll
    for (int a = 0; a < 2; ++a)
#pragma unroll
        for (int b = 0; b < 2; ++b)
#pragma unroll
            for (int m = 0; m < 4; ++m)
#pragma unroll
                for (int n = 0; n < 2; ++n) acc[a][b][m][n] = (f32x4){0.f, 0.f, 0.f, 0.f};
    bf16x8 At[4][2], B0[2][2], B1[2][2];
    unsigned cA = (unsigned)cur.pm * tstep, cB = (unsigned)cur.pn * tstep;
    S.a_ready(cur);
    if constexpr (SP2) {
        PG8_STAGE(PG8_SB(0, 0), cB, voffB); PG8_STAGE(PG8_SB(0, 1), cB + hstep, voffB); PG8_STAGE(PG8_SA(0, 0), cA, voffA); PG8_STAGE(PG8_SA(0, 1), cA + hstep, voffA);
        if (wr == 1) PG8_BAR;
        PG8_WAIT_V(2); PG8_BAR;
        PG8_STAGE(PG8_SB(1, 0), cB + kstep, voffB); PG8_STAGE(PG8_SA(1, 0), cA + kstep, voffA); PG8_STAGE(PG8_SB(1, 1), cB + hstep + kstep, voffB);
        PG8_WAIT_V(6); PG8_BAR;
    } else {
        PG8_STAGE(PG8_SB(0, 0), cB, voffB); PG8_STAGE(PG8_SA(0, 0), cA, voffA); PG8_STAGE(PG8_SB(0, 1), cB + hstep, voffB); PG8_STAGE(PG8_SA(0, 1), cA + hstep, voffA);
        if (wr == 1) PG8_BAR;
        PG8_WAIT_V(4); PG8_BAR;
        PG8_STAGE(PG8_SB(1, 0), cB + kstep, voffB); PG8_STAGE(PG8_SA(1, 0), cA + kstep, voffA); PG8_STAGE(PG8_SB(1, 1), cB + hstep + kstep, voffB);
        PG8_WAIT_V(6); PG8_BAR;
    }
    for (;;) {
        const bool has_next = S.next(ui + 1, nxt);
        const unsigned nA = has_next ? (unsigned)nxt.pm * tstep : cA, nB = has_next ? (unsigned)nxt.pn * tstep : cB;
        for (int t = 0; t < nt; t += 2) {
            const bool last = (t == nt - 2);
            const unsigned a1 = cA + (unsigned)(t + 1) * kstep;
            const unsigned a2 = last ? nA : cA + (unsigned)(t + 2) * kstep, b2 = last ? nB : cB + (unsigned)(t + 2) * kstep;
            const unsigned a3 = a2 + kstep, b3 = b2 + kstep;
            if (last && has_next) S.a_ready(nxt);
            if constexpr (SP2) {
            PG8_LDB(B0, 0, 0); PG8_LDB(B1, 0, 1); PG8_SCHED; PG8_LDA(At, 0, 0); PG8_STAGE(PG8_SA(1, 1), a1 + hstep, voffA);
            PG8_WAIT_V1(); PG8_WAIT_L(0); PG8_BAR; PG8_MMA(0, 0, At, B0); PG8_MMA(0, 1, At, B1); PG8_BAR; PG8_SCHED;
            PG8_LDA(At, 0, 1); PG8_STAGE(PG8_SB(0, 0), b2, voffB); PG8_STAGE(PG8_SB(0, 1), b2 + hstep, voffB); PG8_STAGE(PG8_SA(0, 0), a2, voffA);
            PG8_WAIT_V1(); PG8_WAIT_L(0); PG8_BAR; PG8_MMA(1, 0, At, B0); PG8_MMA(1, 1, At, B1); PG8_BAR; PG8_SCHED;
            PG8_LDB(B0, 1, 0); PG8_LDB(B1, 1, 1); PG8_SCHED; PG8_LDA(At, 1, 0); PG8_STAGE(PG8_SA(0, 1), a2 + hstep, voffA);
            PG8_WAIT_V(8); PG8_WAIT_L(0); PG8_BAR; PG8_MMA(0, 0, At, B0); PG8_MMA(0, 1, At, B1); PG8_BAR; PG8_SCHED;
            PG8_LDA(At, 1, 1); PG8_STAGE(PG8_SB(1, 0), b3, voffB); PG8_STAGE(PG8_SB(1, 1), b3 + hstep, voffB); PG8_STAGE(PG8_SA(1, 0), a3, voffA);
            PG8_WAIT_V(8); PG8_WAIT_L(0); PG8_BAR; PG8_MMA(1, 0, At, B0); PG8_MMA(1, 1, At, B1); PG8_BAR; PG8_SCHED;
            } else {
            PG8_LDB(B0, 0, 0); PG8_SCHED; PG8_LDA(At, 0, 0); PG8_STAGE(PG8_SA(1, 1), a1 + hstep, voffA);
            PG8_WAIT_L(8); PG8_BAR; PG8_WAIT_L(0); PG8_MMA(0, 0, At, B0); PG8_BAR; PG8_SCHED;
            PG8_LDB(B1, 0, 1); PG8_STAGE(PG8_SB(0, 0), b2, voffB);
            PG8_BAR; PG8_WAIT_L(0); PG8_MMA(0, 1, At, B1); PG8_BAR;
            PG8_LDA(At, 0, 1); PG8_STAGE(PG8_SA(0, 0), a2, voffA);
            PG8_BAR; PG8_WAIT_L(0); PG8_MMA(1, 0, At, B0); PG8_BAR; PG8_SCHED;
            PG8_STAGE(PG8_SB(0, 1), b2 + hstep, voffB);
            PG8_WAIT_V(6); PG8_BAR; PG8_MMA(1, 1, At, B1); PG8_BAR;
            PG8_LDB(B0, 1, 0); PG8_SCHED; PG8_LDA(At, 1, 0); PG8_STAGE(PG8_SA(0, 1), a2 + hstep, voffA);
            PG8_WAIT_L(8); PG8_BAR; PG8_WAIT_L(0); PG8_MMA(0, 0, At, B0); PG8_BAR; PG8_SCHED;
            PG8_LDB(B1, 1, 1); PG8_STAGE(PG8_SB(1, 0), b3, voffB);
            PG8_BAR; PG8_WAIT_L(0); PG8_MMA(0, 1, At, B1); PG8_BAR;
            PG8_LDA(At, 1, 1); PG8_STAGE(PG8_SA(1, 0), a3, voffA);
            PG8_BAR; PG8_WAIT_L(0); PG8_MMA(1, 0, At, B0); PG8_BAR; PG8_SCHED;
            PG8_STAGE(PG8_SB(1, 1), b3 + hstep, voffB);
            PG8_WAIT_V(6); PG8_BAR; PG8_MMA(1, 1, At, B1); PG8_BAR;
            }
            if constexpr (Epi::IN_LOOP) E.in_loop(acc, t, cur, wr, wc, fr, fq, xh);
        }
        if constexpr (ALIGN_EPI) { if (wr == 0) PG8_BAR; }
        bool zacc = true;
#ifdef TS_EPI
        const unsigned long long te0_ = __builtin_amdgcn_s_memrealtime();
#endif
        if constexpr (!Epi::AFTER_DRAIN) { zacc = E(acc, cur, wr, wc, fr, fq); S.done(cur); }
#ifdef TS_EPI
        epi_ticks_ += (unsigned)(__builtin_amdgcn_s_memrealtime() - te0_);
#endif
        if (!has_next) break;
        if (zacc) {
#pragma unroll
        for (int a = 0; a < 2; ++a)
#pragma unroll
            for (int b = 0; b < 2; ++b)
#pragma unroll
                for (int m = 0; m < 4; ++m)
#pragma unroll
                    for (int n = 0; n < 2; ++n) acc[a][b][m][n] = (f32x4){0.f, 0.f, 0.f, 0.f};
        }
        cur = nxt; cA = nA; cB = nB; ++ui;
        if constexpr (ALIGN_EPI) { if (wr == 1) PG8_BAR; }
    }
#ifdef TS_EPI
    if (Epi::TS_ID == TS_EPI && (int)blockIdx.x == TS_BLK && tid == 0) __hip_atomic_store(&g_epi_ticks, epi_ticks_, RLX_AGENT);
#endif
    PG8_WAIT_V(0);
    if constexpr (!ALIGN_EPI) { if (wr == 0) PG8_BAR; }
    PG8_BAR;
    if constexpr (Epi::AFTER_DRAIN) { if constexpr (Epi::IN_LOOP) E.fused(acc, cur, wr, wc, fr, fq, lds, wid, lane, xh); else E.fused(acc, cur, wr, wc, fr, fq, lds, wid, lane); S.done(cur); }
#undef PG8_SA
#undef PG8_SB
#undef PG8_STAGE
#undef PG8_LDA
#undef PG8_LDB
#undef PG8_MMA
#undef PG8_WAIT_V
#undef PG8_WAIT_L
#undef PG8_BAR
#undef PG8_SCHED
}

constexpr float LOG2E = 1.4426950408889634f;
template <int MODE> __device__ __forceinline__ float act_gate(float x) {
    constexpr float KG = -2.0f * 0.7978845608028654f * LOG2E;
    if constexpr (MODE == 1) return __builtin_amdgcn_rcpf(__builtin_fmaf(__builtin_amdgcn_exp2f(x * -LOG2E), 1.0f / 255.0f, 1.0f / 255.0f));
    if constexpr (MODE == 3) return __builtin_amdgcn_rcpf(__builtin_fmaf(__builtin_amdgcn_exp2f(x), 1.0f / 255.0f, 1.0f / 255.0f));
    const float t = MODE == 0 ? x * -LOG2E : x * (KG + (KG * 0.044715f) * (x * x));
    return x * __builtin_amdgcn_rcpf(1.0f + __builtin_amdgcn_exp2f(t));
}
struct NoHook {};
struct EpiGate {
    static constexpr int TS_ID = 1, EPI_STORES = 16;
    static constexpr bool PERM = true, AFTER_DRAIN = false, IN_LOOP = false; typedef NoHook HookState;
    template <bool STATS> __device__ __forceinline__ void act_store(const f32x4 (&acc)[2][2][4][2], bf16_t* base, int ldc, int row0, int col0, float* vsl, int fq) const {
#pragma unroll
        for (int ai = 0; ai < 2; ++ai)
#pragma unroll
            for (int m = 0; m < 4; ++m) { bf16_t* rowp = base + (size_t)(row0 + ai * HALF + m * 16) * ldc + col0; float rs = 0.f, rq = 0.f;
#pragma unroll
                for (int bj = 0; bj < 2; ++bj) { f32x4 v0 = acc[ai][bj][m][0], v1 = acc[ai][bj][m][1];
#pragma unroll
                    for (int j = 0; j < 4; ++j) { v0[j] = act_gate<2>(v0[j]); v1[j] = act_gate<2>(v1[j]); }
                    if (STATS) {
#pragma unroll
                        for (int j = 0; j < 4; ++j) { rs += v0[j] + v1[j]; rq += v0[j] * v0[j] + v1[j] * v1[j]; } }
                    u32x4 w; w.x = cvt_pk_bf16(v0[0], v0[1]); w.y = cvt_pk_bf16(v0[2], v0[3]); w.z = cvt_pk_bf16(v1[0], v1[1]); w.w = cvt_pk_bf16(v1[2], v1[3]);
                    *(u32x4*)(rowp + bj * HALF) = w; }
                if (STATS) { rs = sum_xor32(sum_xor16(rs)); rq = sum_xor32(sum_xor16(rq));
                    if (fq == 0) *(f32x2v*)(vsl + (size_t)(ai * HALF + m * 16) * 32) = (f32x2v){rs, rq}; } }
    }
    bf16_t* gates; bf16_t* act; bf16_t* memk; float* kmean; float* vst;
    __device__ __forceinline__ bool operator()(f32x4 (&acc)[2][2][4][2], const Unit& u, int wr, int wc, int fr, int fq) const {
        asm volatile("" : "+v"(fr), "+v"(fq));
        const int tq = u.pn, ct = tq; const bool ism = tq >= 60;
        const float ds = ((ct >= 8 && ct < 12) || (ct >= 16 && ct < 24) || tq >= 64) ? 1.0f / (QX * QWB) : 1.0f / (QX * QW);
        const float dsx = (!ism && ct >= 36) ? -LOG2E / (QX * QW) : ds;
#pragma unroll
        for (int ai = 0; ai < 2; ++ai)
#pragma unroll
            for (int bj = 0; bj < 2; ++bj)
#pragma unroll
                for (int m = 0; m < 4; ++m)
#pragma unroll
                    for (int n = 0; n < 2; ++n)
                    { const v4i_t iv = __builtin_bit_cast(v4i_t, acc[ai][bj][m][n]);
                      acc[ai][bj][m][n] = (f32x4){(float)iv[0] * dsx, (float)iv[1] * dsx, (float)iv[2] * dsx, (float)iv[3] * dsx}; }
        if (!ism && (ct >> 2) == A_UG) { act_store<false>(acc, act + (size_t)A_UG * ACT_STRIDE, W, u.pm * BM + wr * 64 + fr, (ct & 3) * 256 + wc * 32 + 8 * fq, nullptr, fq); return true; }
        if (!ism && (ct >> 2) == A_VG) { const int row0 = u.pm * BM + wr * 64 + fr;
            act_store<true>(acc, act + (size_t)A_VG * ACT_STRIDE, W, row0, (ct & 3) * 256 + wc * 32 + 8 * fq, vst + ((size_t)row0 * 16 + (ct & 3) * 4 + wc) * 2, fq); return true; }
        if (ism || ct < 36) { const int j = tq - 60, seg = ct >> 2; const bool sil = !ism && (seg == A_ZA || seg == A_ZG || seg == A_ZC);
            bf16_t* base = ism ? memk + (size_t)(j >> 2) * ((size_t)MM * W) : act + (size_t)seg * ACT_STRIDE; const int row0 = (ism ? (u.pm - 32) * BM : u.pm * BM) + wr * 64 + fr, col0 = ((ism ? j : ct) & 3) * 256 + wc * 32 + 8 * fq;
#pragma unroll
            for (int ai = 0; ai < 2; ++ai)
#pragma unroll
                for (int m = 0; m < 4; ++m) { bf16_t* rowp = base + (size_t)(row0 + ai * HALF + m * 16) * W + col0;
#pragma unroll
                    for (int bj = 0; bj < 2; ++bj) { f32x4 v0 = acc[ai][bj][m][0], v1 = acc[ai][bj][m][1];
                        if (sil) {
#pragma unroll
                            for (int jj = 0; jj < 4; ++jj) { v0[jj] = act_gate<0>(v0[jj]); v1[jj] = act_gate<0>(v1[jj]); } }
                        u32x4 w; w.x = cvt_pk_bf16(v0[0], v0[1]); w.y = cvt_pk_bf16(v0[2], v0[3]); w.z = cvt_pk_bf16(v1[0], v1[1]); w.w = cvt_pk_bf16(v1[2], v1[3]);
                        *(u32x4*)(rowp + bj * HALF) = w; } }
            if (!ism && seg == A_KA) {
                float* kp = kmean + (size_t)wr * KM_SLOT + (size_t)u.pm * W + col0;
#pragma unroll
                for (int bj = 0; bj < 2; ++bj)
#pragma unroll
                    for (int n = 0; n < 2; ++n) { f32x4 sv;
#pragma unroll
                        for (int j2 = 0; j2 < 4; ++j2) { float s = 0.f;
#pragma unroll
                            for (int ai = 0; ai < 2; ++ai)
#pragma unroll
                                for (int m = 0; m < 4; ++m) s += acc[ai][bj][m][n][j2];
                            s += __shfl_xor(s, 1); s += __shfl_xor(s, 2); s += __shfl_xor(s, 4); s += __shfl_xor(s, 8); sv[j2] = s * (1.0f / 256.0f); }
                        if (fr == 0) *(f32x4*)(kp + bj * HALF + 4 * n) = sv; } }
            return true; }
        const int g = ct - 36, br = g >> 3, pnl = g & 7;
        unsigned char* gb = (unsigned char*)gates + ((((size_t)(u.pm * 8 + pnl) * 3 + br) * 8 + (wr * 4 + wc)) * 16) * 512 + (fq * 16 + fr) * 8;
#pragma unroll
        for (int ai = 0; ai < 2; ++ai)
#pragma unroll
            for (int m = 0; m < 4; ++m)
#pragma unroll
                for (int bj = 0; bj < 2; ++bj) { const f32x4 v0 = acc[ai][bj][m][0], v1 = acc[ai][bj][m][1]; unsigned w0 = 0u, w1 = 0u;
#pragma unroll
                    for (int j = 0; j < 4; ++j) { w0 = __builtin_amdgcn_cvt_pk_u8_f32(act_gate<3>(v0[j]), j, w0); w1 = __builtin_amdgcn_cvt_pk_u8_f32(act_gate<3>(v1[j]), j, w1); }
                    __builtin_nontemporal_store((f32x2v){__builtin_bit_cast(float, w0), __builtin_bit_cast(float, w1)}, (f32x2v*)(gb + ((ai * 4 + m) * 2 + bj) * 512)); }
        return true;
    }
};
struct EpiBranch {
    static constexpr int TS_ID = 4, EPI_STORES = 0;
    static constexpr bool PERM = true, AFTER_DRAIN = false, IN_LOOP = false; typedef NoHook HookState;
    const bf16_t* gates; bf16_t* merged;
    __device__ __forceinline__ bool operator()(f32x4 (&acc)[2][2][4][2], const Unit& u, int wr, int wc, int fr, int fq) const {
        const int br = u.pm >> 5, pm = u.pm & 31, pn = u.pn & 7;
        const int row0 = pm * BM + wr * 64 + fr, col0 = pn * BM + wc * 32 + 8 * fq;
        const unsigned char* gp = (const unsigned char*)gates + ((((size_t)(pm * 8 + pn) * 3 + br) * 8 + (wr * 4 + wc)) * 16) * 512 + (fq * 16 + fr) * 8;
        const unsigned char* gq = gp + (br < 2 ? 8 * 16 * 512 : 0);
#define BYTE_F(w, e) ((float)((((e) < 4 ? (w).x : (w).y) >> (8 * ((e) & 3))) & 0xffu))
        v2u ga[2][4], gb[2][4];
#pragma unroll
        for (int s = 0; s < 4; ++s) { ga[0][s] = __builtin_nontemporal_load((const v2u*)(gp + s * 512)); gb[0][s] = __builtin_nontemporal_load((const v2u*)(gq + s * 512)); }
#pragma unroll
        for (int q = 0; q < 4; ++q) { const int cb = q & 1, nb = cb ^ 1;
            if (q < 3) {
#pragma unroll
                for (int s = 0; s < 4; ++s) { ga[nb][s] = __builtin_nontemporal_load((const v2u*)(gp + ((q + 1) * 4 + s) * 512)); gb[nb][s] = __builtin_nontemporal_load((const v2u*)(gq + ((q + 1) * 4 + s) * 512)); } }
#pragma unroll
            for (int s = 0; s < 4; ++s) asm volatile("" : "+v"(ga[cb][s]), "+v"(gb[cb][s]));
            if (br < 2) {
#pragma unroll
                for (int s = 0; s < 4; ++s) { const int sl = q * 4 + s, ai = sl >> 3, m = (sl >> 1) & 3, bj = sl & 1; float g[8];
#pragma unroll
                    for (int e_ = 0; e_ < 8; ++e_) g[e_] = fmaxf(BYTE_F(ga[cb][s], e_), 0.5f) * __builtin_amdgcn_rcpf(fmaxf(BYTE_F(gb[cb][s], e_), 0.5f));
#pragma unroll
                    for (int j = 0; j < 4; ++j) { acc[ai][bj][m][0][j] *= g[j]; acc[ai][bj][m][1][j] *= g[4 + j]; } }
            } else {
#pragma unroll
                for (int s = 0; s < 4; ++s) { const int sl = q * 4 + s, ai = sl >> 3, m = (sl >> 1) & 3, bj = sl & 1, row = row0 + ai * HALF + m * 16; float g[8];
#pragma unroll
                    for (int e_ = 0; e_ < 8; ++e_) g[e_] = fmaxf(BYTE_F(ga[cb][s], e_), 0.5f) * (1.0f / 255.0f);
                    f32x4 v0 = acc[ai][bj][m][0], v1 = acc[ai][bj][m][1];
#pragma unroll
                    for (int j = 0; j < 4; ++j) { v0[j] *= g[j]; v1[j] *= g[4 + j]; }
                    *(v2u*)((unsigned char*)merged + (size_t)row * DM + col0 + bj * HALF) = (v2u){pk4_i8(v0[0], v0[1], v0[2], v0[3], QM), pk4_i8(v1[0], v1[1], v1[2], v1[3], QM)}; } }
        }
#undef BYTE_F
        return br == 2;
    }
};
struct EpiOutLN {
    static constexpr int TS_ID = 5, EPI_STORES = 0;
    static constexpr bool PERM = false, AFTER_DRAIN = true, IN_LOOP = false; typedef NoHook HookState;
    const float* x; float* out; const float* lng; const float* lnb; float* lns; XcdBarrier bar;
    __device__ __forceinline__ void fused(f32x4 (&acc)[2][2][4][2], const Unit& u, int wr, int wc, int fr, int fq, PG8_LAS unsigned char* lds, int wid, int lane) const {
        PG8_LAS f32x2v* P = (PG8_LAS f32x2v*)lds;
        PG8_LAS f32x2v* S = (PG8_LAS f32x2v*)(lds + 8192);
        const int col0 = u.pn * BM + wc * 32 + 4 * fq;
        { constexpr float ds = 1.0f / (QM * QWB);
#pragma unroll
          for (int ai = 0; ai < 2; ++ai)
#pragma unroll
              for (int bj = 0; bj < 2; ++bj)
#pragma unroll
                  for (int m = 0; m < 4; ++m)
#pragma unroll
                      for (int n = 0; n < 2; ++n) { const v4i_t iv = __builtin_bit_cast(v4i_t, acc[ai][bj][m][n]); acc[ai][bj][m][n] = (f32x4){(float)iv[0] * ds, (float)iv[1] * ds, (float)iv[2] * ds, (float)iv[3] * ds}; } }
#pragma unroll
        for (int ai = 0; ai < 2; ++ai) { f32x4 xv[4][2][2];
#pragma unroll
            for (int m = 0; m < 4; ++m) { const size_t off = (size_t)(u.pm * BM + ai * HALF + wr * 64 + m * 16 + fr) * DM + col0;
#pragma unroll
                for (int bj = 0; bj < 2; ++bj)
#pragma unroll
                    for (int n = 0; n < 2; ++n) xv[m][bj][n] = __builtin_nontemporal_load((const f32x4*)(x + off + bj * HALF + n * 16)); }
#pragma unroll
            for (int m = 0; m < 4; ++m)
#pragma unroll
                for (int bj = 0; bj < 2; ++bj)
#pragma unroll
                    for (int n = 0; n < 2; ++n) acc[ai][bj][m][n] = acc[ai][bj][m][n] + xv[m][bj][n] * DN_ALPHA;
#pragma unroll
            for (int m = 0; m < 4; ++m) asm volatile("" : "+v"(acc[ai][0][m][0]), "+v"(acc[ai][0][m][1]), "+v"(acc[ai][1][m][0]), "+v"(acc[ai][1][m][1]));
            asm volatile("" ::: "memory"); }
#pragma unroll
        for (int ai = 0; ai < 2; ++ai)
#pragma unroll
            for (int m = 0; m < 4; ++m) {
                float s = 0.f;
#pragma unroll
                for (int bj = 0; bj < 2; ++bj)
#pragma unroll
                    for (int n = 0; n < 2; ++n) { const f32x4 v = acc[ai][bj][m][n]; s += (v[0] + v[1]) + (v[2] + v[3]); }
                s = sum_xor32(sum_xor16(s));
                const float mw = s * (1.0f / 64.0f); float q = 0.f;
#pragma unroll
                for (int bj = 0; bj < 2; ++bj)
#pragma unroll
                    for (int n = 0; n < 2; ++n) { const f32x4 d = acc[ai][bj][m][n] - mw; q += (d[0] * d[0] + d[1] * d[1]) + (d[2] * d[2] + d[3] * d[3]); }
                q = sum_xor32(sum_xor16(q));
                if (fq == 0) P[(ai * HALF + wr * 64 + m * 16 + fr) * 4 + wc] = (f32x2v){mw, q};
            }
        asm volatile("s_waitcnt lgkmcnt(0)" ::: "memory"); __builtin_amdgcn_s_barrier(); asm volatile("" ::: "memory");
        const int row = wid * 32 + (lane & 31);
        if (lane < 32) {
            const f32x2v a = P[row * 4 + 0], b = P[row * 4 + 1], c = P[row * 4 + 2], d = P[row * 4 + 3];
            const float mt = (a.x + b.x + c.x + d.x) * 0.25f;
            const float da = a.x - mt, db = b.x - mt, dc = c.x - mt, dd = d.x - mt;
            const float m2 = (a.y + b.y) + (c.y + d.y) + 64.0f * ((da * da + db * db) + (dc * dc + dd * dd));
            *(f32x2v*)(lns + ((size_t)(u.pm * BM + row) * 8 + u.pn) * 2) = (f32x2v){mt, m2};
        }
        xcd_barrier(bar);
        if (lane < 32) {
            const f32x4* sp = (const f32x4*)(lns + (size_t)(u.pm * BM + row) * 16); float mt[8], m2[8];
#pragma unroll
            for (int t = 0; t < 4; ++t) { const f32x4 w = sp[t]; mt[2 * t] = w[0]; m2[2 * t] = w[1]; mt[2 * t + 1] = w[2]; m2[2 * t + 1] = w[3]; }
            float ms = 0.f;
#pragma unroll
            for (int t = 0; t < 8; ++t) ms += mt[t];
            const float mean = ms * 0.125f; float q = 0.f;
#pragma unroll
            for (int t = 0; t < 8; ++t) { const float dm = mt[t] - mean; q += m2[t] + 256.0f * dm * dm; }
            S[row] = (f32x2v){mean, 1.0f / sqrtf(q * (1.0f / DM) + LN_EPS)};
        }
        asm volatile("s_waitcnt lgkmcnt(0)" ::: "memory"); __builtin_amdgcn_s_barrier(); asm volatile("" ::: "memory");
        f32x4 gv[2][2], bv[2][2];
#pragma unroll
        for (int bj = 0; bj < 2; ++bj)
#pragma unroll
            for (int n = 0; n < 2; ++n) { gv[bj][n] = *(const f32x4*)(lng + col0 + bj * HALF + n * 16); bv[bj][n] = *(const f32x4*)(lnb + col0 + bj * HALF + n * 16); }
#pragma unroll
        for (int ai = 0; ai < 2; ++ai)
#pragma unroll
            for (int m = 0; m < 4; ++m) { const int r = ai * HALF + wr * 64 + m * 16 + fr; const f32x2v sr = S[r]; const size_t off = (size_t)(u.pm * BM + r) * DM + col0;
#pragma unroll
                for (int bj = 0; bj < 2; ++bj)
#pragma unroll
                    for (int n = 0; n < 2; ++n) { const f32x4 o = (acc[ai][bj][m][n] - sr.x) * sr.y * gv[bj][n] + bv[bj][n]; __builtin_nontemporal_store(o, (f32x4*)(out + off + bj * HALF + n * 16)); } }
    }
};
}


namespace moba {
constexpr int D = 128, PITCH = W, NW = 8, QBLK = 32, KVBLK = 64, QB = NW * QBLK;
constexpr int SHM_V = KVBLK * D * 2, SHM_K = KVBLK * D * 2;
constexpr int LDS_NEED = 2 * SHM_V + 2 * SHM_K + NW * 64 * 4;
constexpr float SCALE = 0.08838834764831845f, THR = 8.f;
typedef short s16x4 __attribute__((ext_vector_type(4)));
typedef float f32x16 __attribute__((ext_vector_type(16)));
typedef unsigned u32x4 __attribute__((ext_vector_type(4)));
#define KSWZ(row, colB) ((row) * 256 + ((colB) ^ (((row) & 7) << 4)))
#define SBAR() __builtin_amdgcn_sched_barrier(0)
__device__ __forceinline__ int v_st(int k, int c) { const int kk = (k & ~0xC) | ((k & 4) << 1) | ((k & 8) >> 1); return ((kk >> 3) * 4 + (c >> 5)) * 512 + ((kk & 7) * 32 + (c & 31)) * 2; }
__device__ __forceinline__ int v_rd_base(int lane) { return ((lane & 3) << 3) | (((lane >> 2) & 3) << 6) | (((lane >> 4) & 1) << 5) | (((lane >> 5) & 1) << 8); }
constexpr int v_rd_off(int d0, int ks, int half) { return d0 * 512 + ks * 4096 + half * 2048; }
__device__ __forceinline__ int crow(int r, int hi) { return (r & 3) + 8 * (r >> 2) + 4 * hi; }
__device__ __forceinline__ bf16x8 pack8(f32x4 a, f32x4 b) { u32x4 w = {cvt_pk_bf16(a[0], a[1]), cvt_pk_bf16(a[2], a[3]), cvt_pk_bf16(b[0], b[1]), cvt_pk_bf16(b[2], b[3])}; return *reinterpret_cast<bf16x8*>(&w); }
__device__ __forceinline__ bf16x8 load8(const bf16* p) { return *reinterpret_cast<const bf16x8*>(p); }
__device__ __forceinline__ void mask_causal(f32x16& p0, f32x16& p1, int dq) {
    const float NEG = -__builtin_inff();
#pragma unroll
    for (int r = 0; r < 16; ++r) { const int c = (r & 3) + 8 * (r >> 2); if (dq - c < 0) p0[r] = NEG; if (dq - c - 32 < 0) p1[r] = NEG; }
}
__device__ __forceinline__ void mask_row(f32x16& p0, f32x16& p1, bool keep) {
    const float NEG = -__builtin_inff();
#pragma unroll
    for (int r = 0; r < 16; ++r) { p0[r] = keep ? p0[r] : NEG; p1[r] = keep ? p1[r] : NEG; }
}
__device__ __forceinline__ void partialSM(f32x16& p0, f32x16& p1, float& m_reg, float& mn, float& alpha) {
    float pmax = p0[0]; for (int r = 1; r < 16; ++r) pmax = fmaxf(pmax, p0[r]); for (int r = 0; r < 16; ++r) pmax = fmaxf(pmax, p1[r]);
    { auto rr = __builtin_amdgcn_permlane32_swap(__float_as_uint(pmax), __float_as_uint(pmax), false, false);
      pmax = fmaxf(__uint_as_float(rr[0]), __uint_as_float(rr[1])); }
    constexpr float C2 = 1.4426950408889634f * SCALE;
    if (__builtin_expect(__all((pmax - m_reg) * SCALE <= THR), 1)) { mn = m_reg; alpha = 1.f; }
    else { mn = fmaxf(m_reg, pmax); alpha = __builtin_amdgcn_exp2f((m_reg - mn) * C2); m_reg = mn; }
    const float mnL = -mn * C2;
    for (int r = 0; r < 16; ++r) p0[r] = fmaf(p0[r], C2, mnL); for (int r = 0; r < 16; ++r) p1[r] = fmaf(p1[r], C2, mnL);
    for (int r = 0; r < 16; ++r) p0[r] = __builtin_amdgcn_exp2f(p0[r]);
}
__device__ __forceinline__ void finishSM(f32x16& p0, f32x16& p1, float alpha, float& l_reg, bf16x8& pa0, bf16x8& pa1, bf16x8& pa2, bf16x8& pa3) {
    for (int r = 0; r < 16; ++r) p1[r] = __builtin_amdgcn_exp2f(p1[r]);
    float ps = 0; for (int r = 0; r < 16; ++r) ps += p0[r]; for (int r = 0; r < 16; ++r) ps += p1[r];
    { auto rr = __builtin_amdgcn_permlane32_swap(__float_as_uint(ps), __float_as_uint(ps), false, false);
      ps = __uint_as_float(rr[0]) + __uint_as_float(rr[1]); }
    l_reg = l_reg * alpha + ps;
#define PK4(P, B_, OUT) do { unsigned a0 = cvt_pk_bf16(P[B_+0], P[B_+1]), a1 = cvt_pk_bf16(P[B_+2], P[B_+3]);                          \
        unsigned b0 = cvt_pk_bf16(P[B_+4], P[B_+5]), b1 = cvt_pk_bf16(P[B_+6], P[B_+7]);                                             \
        auto r0 = __builtin_amdgcn_permlane32_swap(a0, b0, false, false); auto r1 = __builtin_amdgcn_permlane32_swap(a1, b1, false, false); \
        u32x4 w = {r0[0], r1[0], r0[1], r1[1]}; OUT = *reinterpret_cast<bf16x8*>(&w); } while (0)
    PK4(p0, 0, pa0); PK4(p0, 8, pa1); PK4(p1, 0, pa2); PK4(p1, 8, pa3);
#undef PK4
}
template <int KB>
__device__ __forceinline__ void qkt(f32x16& p0, f32x16& p1, const char* K_lds, int r32, int hi, const bf16x8* qr) {
    p0 = f32x16{}; p1 = f32x16{};
    const char* kb[4];
#pragma unroll
    for (int dd = 0; dd < 4; ++dd) kb[dd] = K_lds + KB * SHM_K + KSWZ(r32, (dd * 16 + hi * 8) * 2);
#pragma unroll
    for (int d0 = 0; d0 < 8; ++d0) { const char* a = kb[d0 & 3] + (d0 >> 2) * 128;
        bf16x8 b0 = *reinterpret_cast<const bf16x8*>(a);
        bf16x8 b1 = *reinterpret_cast<const bf16x8*>(a + 32 * 256);
        p0 = __builtin_amdgcn_mfma_f32_32x32x16_bf16(b0, qr[d0], p0, 0, 0, 0);
        p1 = __builtin_amdgcn_mfma_f32_32x32x16_bf16(b1, qr[d0], p1, 0, 0, 0); }
}
#define MOBA_TRRD(dst, off) asm volatile("ds_read_b64_tr_b16 %0, %1 offset:%2" : "=&v"(dst) : "v"(vb0), "i"(off) : "memory")
#define MOBA_PV_D0(d0) do { s16x4 l0, l1, l2, l3, h0, h1, h2, h3; constexpr int b_ = VB * SHM_V + v_rd_off(d0, 0, 0);     \
        MOBA_TRRD(l0, b_); MOBA_TRRD(h0, b_ + 2048); MOBA_TRRD(l1, b_ + 4096); MOBA_TRRD(h1, b_ + 6144); MOBA_TRRD(l2, b_ + 8192); MOBA_TRRD(h2, b_ + 10240); MOBA_TRRD(l3, b_ + 12288); MOBA_TRRD(h3, b_ + 14336); \
        asm volatile("s_waitcnt lgkmcnt(0)" ::: "memory"); SBAR();                 \
        o[d0] = __builtin_amdgcn_mfma_f32_32x32x16_bf16(pa0, (bf16x8){l0[0], l0[1], l0[2], l0[3], h0[0], h0[1], h0[2], h0[3]}, o[d0], 0, 0, 0);   \
        o[d0] = __builtin_amdgcn_mfma_f32_32x32x16_bf16(pa1, (bf16x8){l1[0], l1[1], l1[2], l1[3], h1[0], h1[1], h1[2], h1[3]}, o[d0], 0, 0, 0);   \
        o[d0] = __builtin_amdgcn_mfma_f32_32x32x16_bf16(pa2, (bf16x8){l2[0], l2[1], l2[2], l2[3], h2[0], h2[1], h2[2], h2[3]}, o[d0], 0, 0, 0);   \
        o[d0] = __builtin_amdgcn_mfma_f32_32x32x16_bf16(pa3, (bf16x8){l3[0], l3[1], l3[2], l3[3], h3[0], h3[1], h3[2], h3[3]}, o[d0], 0, 0, 0); } while (0)
template <int VB>
__device__ __forceinline__ void pv_tile(f32x16* o, int vb0, bf16x8 pa0, bf16x8 pa1, bf16x8 pa2, bf16x8 pa3) {
    MOBA_PV_D0(0); MOBA_PV_D0(1); MOBA_PV_D0(2); MOBA_PV_D0(3);
}

#define VMW() asm volatile("s_waitcnt vmcnt(0)" ::: "memory")
#if defined(TS_PHASE) && TS_PHASE >= 90 && TS_PHASE <= 95
__device__ unsigned long long g_gacc[4];
#define GT0() const unsigned long long gt0_ = __builtin_amdgcn_s_memtime()
#define GT1() const unsigned long long gt1_ = __builtin_amdgcn_s_memtime()
#define GT2() do { const unsigned long long gt2_ = __builtin_amdgcn_s_memtime(); if (blockIdx.x == 0 && tid == 0) { g_gacc[0] += gt1_ - gt0_; g_gacc[1] += gt2_ - gt1_; g_gacc[2] += 1; } } while (0)
#else
#define GT0() do {} while (0)
#define GT1() do {} while (0)
#define GT2() do {} while (0)
#endif
constexpr int SCR = 133120;
constexpr int SCR_WAVE = SCR, SCR_ROWTAB = SCR + 2048, SCR_CURSOR = SCR + 3072, SCR_U0 = SCR + 3076, SCR_P = SCR + 3136, SCR_N = SCR + 4224, SCR_DUMP = SCR + 5376  ;
__device__ __forceinline__ bf16* po_slot(unsigned char* ws, int s) { return (bf16*)(ws + (s == 3 ? WS_PO : WS_POS + (size_t)s * (ACT_STRIDE * 2))); }

struct KVRegs { bf16x8 sk[4][2], sv[4][2]; };
__device__ __forceinline__ void kv_issue(KVRegs& R, const bf16* Kb, const bf16* Vb, int tid) {
    const int sr = tid >> 4, sc = (tid & 15) * 8;
#pragma unroll
    for (int t = 0; t < 4; ++t) { R.sk[t][0] = load8(Kb + (size_t)(t * 64 + sr) * PITCH + sc); R.sk[t][1] = load8(Kb + (size_t)(t * 64 + 32 + sr) * PITCH + sc);
                                  R.sv[t][0] = load8(Vb + (size_t)(t * 64 + sr) * PITCH + sc); R.sv[t][1] = load8(Vb + (size_t)(t * 64 + 32 + sr) * PITCH + sc); }
}
__device__ __forceinline__ void kv_write(const KVRegs& R, char* V_lds, char* K_lds, int tid) {
    const int sr = tid >> 4, sc = (tid & 15) * 8, kws = KSWZ(sr, sc * 2), vst0 = v_st(sr, sc), vst1 = v_st(32 + sr, sc);
#pragma unroll
    for (int t = 0; t < 4; ++t) { *(bf16x8*)(K_lds + t * SHM_K + kws) = R.sk[t][0]; *(bf16x8*)(K_lds + t * SHM_K + kws + 32 * 256) = R.sk[t][1];
                                  *(bf16x8*)(V_lds + t * SHM_V + vst0) = R.sv[t][0]; *(bf16x8*)(V_lds + t * SHM_V + vst1) = R.sv[t][1]; }
}

template <bool OWN, class LastQ>
__device__ __forceinline__ void attn_tiles(const bf16x8* qr, const char* K_lds, int vb0, int NT, int qlo, int qm, int r32, int hi, float* al_l, f32x16* o, float& m_reg, float& l_reg, LastQ&& last_q) {
#define RESC(a) do { if (__any((a) < 1.f)) { if (hi == 0) al_l[r32] = (a); asm volatile("s_waitcnt lgkmcnt(0)" ::: "memory");              \
                     for (int d_ = 0; d_ < 4; ++d_) for (int r = 0; r < 16; ++r) o[d_][r] *= al_l[crow(r, hi)]; } } while (0)
#define GMASK(P0_, P1_, t) do { if (OWN && (t) * KVBLK + KVBLK - 1 > qlo) mask_causal(P0_, P1_, qm - (t) * KVBLK); } while (0)
    f32x16 pA0, pA1, pB0, pB1; float mnA, mnB, alA, alB; bf16x8 pa0, pa1, pa2, pa3;
    qkt<0>(pA0, pA1, K_lds, r32, hi, qr); if (NT == 1) { SBAR(); last_q(); SBAR(); }
    GMASK(pA0, pA1, 0); partialSM(pA0, pA1, m_reg, mnA, alA);
    if (NT > 1) { SBAR(); qkt<1>(pB0, pB1, K_lds, r32, hi, qr); if (NT == 2) { SBAR(); last_q(); SBAR(); } }
    finishSM(pA0, pA1, alA, l_reg, pa0, pa1, pa2, pa3); SBAR(); pv_tile<0>(o, vb0, pa0, pa1, pa2, pa3);
    if (NT > 1) {
        GMASK(pB0, pB1, 1); partialSM(pB0, pB1, m_reg, mnB, alB); RESC(alB);
        if (NT > 2) { SBAR(); qkt<2>(pA0, pA1, K_lds, r32, hi, qr); if (NT == 3) { SBAR(); last_q(); SBAR(); } }
        finishSM(pB0, pB1, alB, l_reg, pa0, pa1, pa2, pa3); SBAR(); pv_tile<1>(o, vb0, pa0, pa1, pa2, pa3);
        if (NT > 2) {
            GMASK(pA0, pA1, 2); partialSM(pA0, pA1, m_reg, mnA, alA); RESC(alA);
            if (NT > 3) { SBAR(); qkt<3>(pB0, pB1, K_lds, r32, hi, qr); SBAR(); last_q(); SBAR(); }
            finishSM(pA0, pA1, alA, l_reg, pa0, pa1, pa2, pa3); SBAR(); pv_tile<2>(o, vb0, pa0, pa1, pa2, pa3);
            if (NT > 3) { GMASK(pB0, pB1, 3); partialSM(pB0, pB1, m_reg, mnB, alB); RESC(alB);
                finishSM(pB0, pB1, alB, l_reg, pa0, pa1, pa2, pa3); SBAR(); pv_tile<3>(o, vb0, pa0, pa1, pa2, pa3); } } }
#undef RESC
#undef GMASK
}
constexpr int STG = 147456;
__device__ __forceinline__ void attn_store(unsigned char* ws, size_t rb, int h, int ent, const f32x16* o, float m_reg, float l_reg, float* li_l, int* rowtab, char* stg, int r32, int hi) {
    if (hi == 0) { li_l[r32] = l_reg; rowtab[r32] = ent;
        if (ent >= 0) *(f32x2v*)((float*)(ws + WS_ML4) + ((size_t)(ent >> 12) * M + rb + (ent & 4095)) * (2 * AH) + h * 2) = (f32x2v){m_reg, l_reg}; }
    asm volatile("s_waitcnt lgkmcnt(0)" ::: "memory");
    float rl[16];
#pragma unroll
    for (int r = 0; r < 16; ++r) rl[r] = li_l[crow(r, hi)];
    const int lane = r32 + 32 * hi, r16 = (lane >> 2) & 15, ch = lane & 3;
    const int e0 = rowtab[r16], e1 = rowtab[16 + r16];
#pragma unroll
    for (int r = 0; r < 16; ++r) rl[r] = rl[r] > 0.f ? __builtin_amdgcn_rcpf(rl[r]) : 0.f;
    const bool odd = (r32 & 1) != 0;
    char* wr = stg + (odd ? 1024 : 0) + (r32 & ~1) * 2;
    const char* rd = stg + r16 * 64 + ch * 16;
#pragma unroll
    for (int hf = 0; hf < 2; ++hf) { const int e = hf ? e1 : e0;
        bf16* dst = po_slot(ws, (e >= 0 ? e : 0) >> 12) + (rb + (size_t)((e >= 0 ? e : 0) & 4095)) * W + h * AD + ch * 8;
#pragma unroll
        for (int pp = 0; pp < 2; ++pp) {
#pragma unroll
            for (int r8 = 0; r8 < 8; ++r8) { const int r = hf * 8 + r8; const float va = o[2 * pp][r] * rl[r], vb = o[2 * pp + 1][r] * rl[r];
                const float x = odd ? va : vb;
                const float y = __builtin_bit_cast(float, __builtin_amdgcn_update_dpp(0, __builtin_bit_cast(int, x), 0xB1  , 0xF, 0xF, true));
                const unsigned pk = cvt_pk_bf16(odd ? y : va, odd ? vb : y);
                *(unsigned*)(wr + (crow(r, hi) - 16 * hf) * 64) = pk; }
            const v4u q0 = *(const v4u*)rd, q1 = *(const v4u*)(rd + 1024);
            if (e >= 0) { __builtin_nontemporal_store(q0, (v4u*)(dst + (2 * pp) * 32)); __builtin_nontemporal_store(q1, (v4u*)(dst + (2 * pp + 1) * 32)); } } }
}

constexpr int KM_ROW = 272;
constexpr int SCR_CW = SCR_P, SCR_PRE = SCR_N, SCR_BASE = SCR_N + 512;
template <class Arrive> __device__ __forceinline__ void select_own(unsigned char* ws, char* lds, gu32* cnt, int bh, int j, Arrive&& arrive) {
    const int tid = opaque_tid(), wid = __builtin_amdgcn_readfirstlane(tid >> 6), lane = tid & 63, r32 = lane & 31, hi = lane >> 5;
    const int b = bh >> 3, h = bh & 7; const size_t rb = (size_t)b * SEQ;
    const bf16* act = (const bf16*)(ws + WS_ACT);
    const bf16* Q = act + A_QA * ACT_STRIDE + (rb + (size_t)j * MBLK) * W + h * AD;
    const float* KM = (const float*)(ws + WS_KMEAN) + (size_t)(b * NBLK) * W + h * AD;
    char* V_lds = lds; char* K_lds = lds + 4 * SHM_V; char* KMH = lds; char* KML = lds + 16 * KM_ROW;
    const f32x4 km0 = *(const f32x4*)(KM + (size_t)(tid >> 5) * W + (tid & 31) * 4), km1 = *(const f32x4*)(KM + KM_SLOT + (size_t)(tid >> 5) * W + (tid & 31) * 4);
    bf16x8 qr[8];
#pragma unroll
    for (int d0 = 0; d0 < 8; ++d0) qr[d0] = load8(Q + (size_t)(wid * QBLK + r32) * PITCH + d0 * 16 + hi * 8);
    KVRegs R; kv_issue(R, act + A_KA * ACT_STRIDE + (rb + (size_t)j * MBLK) * W + h * AD, act + A_VA * ACT_STRIDE + (rb + (size_t)j * MBLK) * W + h * AD, tid);
    { const f32x4 a = km0 + km1; const unsigned h01 = cvt_pk_bf16(a[0], a[1]), h23 = cvt_pk_bf16(a[2], a[3]);
      const unsigned l01 = cvt_pk_bf16(a[0] - bflo(h01), a[1] - bfhi(h01)), l23 = cvt_pk_bf16(a[2] - bflo(h23), a[3] - bfhi(h23));
      const int o_ = (tid >> 5) * KM_ROW + (tid & 31) * 8; *(v2u*)(KMH + o_) = (v2u){h01, h23}; *(v2u*)(KML + o_) = (v2u){l01, l23}; }
    __syncthreads();
    unsigned sel = 0u;
    if (j > 0) {
        f32x16 sc_ = f32x16{};
        const char* ka = KMH + (r32 & 15) * KM_ROW + hi * 16;
#pragma unroll
        for (int d0 = 0; d0 < 8; ++d0) { const bf16x8 ah = *(const bf16x8*)(ka + d0 * 32), al = *(const bf16x8*)(ka + 16 * KM_ROW + d0 * 32);
            sc_ = __builtin_amdgcn_mfma_f32_32x32x16_bf16(ah, qr[d0], sc_, 0, 0, 0); sc_ = __builtin_amdgcn_mfma_f32_32x32x16_bf16(al, qr[d0], sc_, 0, 0, 0); }
        float v[16];
#pragma unroll
        for (int n = 0; n < 16; ++n) { const int idx = (n & 3) + 4 * (n >> 3); const float own = sc_[idx], oth = __shfl_xor(own, 32); v[n] = (hi == ((n >> 2) & 1)) ? own : oth; }
#pragma unroll
        for (int k = 0; k < 3; ++k) { float best = -__builtin_inff(); int bi = -1;
#pragma unroll
            for (int n = 0; n < 15; ++n) { const bool ok = n < j && !((sel >> n) & 1u) && (bi < 0 || v[n] > best); if (ok) { best = v[n]; bi = n; } }
            if (bi >= 0) sel |= 1u << bi; }
    }
    const int rowb = j * MBLK + wid * QBLK + r32;
    if (hi == 0) { const int ns = __builtin_popcount(sel); float* ml = (float*)(ws + WS_ML4) + (rb + rowb) * (2 * AH) + h * 2;
#pragma unroll
        for (int s = 0; s < 3; ++s) if (s >= ns) *(f32x2v*)(ml + (size_t)s * M * (2 * AH)) = (f32x2v){-1e30f, 0.f}; }
    int* cw = (int*)(lds + SCR_CW); int* pre = (int*)(lds + SCR_PRE);
#pragma unroll
    for (int k = 0; k < 15; ++k) { const unsigned long long mk = __ballot(hi == 0 && ((sel >> k) & 1u)); if (lane == 0) cw[wid * 16 + k] = __builtin_popcountll(mk); }
    TSP(30);
    __syncthreads();
    VMW(); kv_write(R, V_lds, K_lds, tid);
    if (tid < 16) { int run = 0;
#pragma unroll
        for (int w = 0; w < NW; ++w) { pre[w * 16 + tid] = run; run += cw[w * 16 + tid]; }
        if (tid < j) cnt[(bh * NBLK + tid) * NBLK + j] = (unsigned)run; }
    __syncthreads();
    TSP(31);
    unsigned* lists = (unsigned*)(ws + WS_LIST) + (size_t)(bh * NBLK) * LCAP + j * MBLK;
#pragma unroll
    for (int k = 0; k < 15; ++k) { const bool s = hi == 0 && k < j && ((sel >> k) & 1u); const unsigned long long mk = __ballot(s);
        if (s) lists[(size_t)k * LCAP + pre[wid * 16 + k] + __builtin_popcountll(mk & ((1ull << lane) - 1ull))] = (unsigned)rowb | ((unsigned)__builtin_popcount(sel & ((1u << k) - 1u)) << 12); }
    arrive();
    TSP(32);
    { float* wsc = (float*)(lds + SCR_WAVE) + wid * 64; int* rowtab = (int*)(lds + SCR_ROWTAB) + wid * 32;
      const int vb0 = (int)(uintptr_t)V_lds + v_rd_base(lane), qlo = wid * QBLK, qm = qlo + r32 - 4 * hi, NT = ((qlo + QBLK - 1) >> 6) + 1;
      float m_reg = -1e30f, l_reg = 0; f32x16 o[4] = {};
      attn_tiles<true>(qr, K_lds, vb0, NT, qlo, qm, r32, hi, wsc + 32, o, m_reg, l_reg, [] {});
      attn_store(ws, rb, h, rowb | (3 << 12), o, m_reg, l_reg, wsc, rowtab, lds + STG + wid * 2048, r32, hi); }
    TSP(33);
}

__device__ __forceinline__ void gather_unit(unsigned char* ws, char* lds, const gu32* cnt, int bh, int k, int n, int gb0, int gb1) {
    const int tid = opaque_tid(), wid = __builtin_amdgcn_readfirstlane(tid >> 6), lane = tid & 63, r32 = lane & 31, hi = lane >> 5;
    const int b = bh >> 3, h = bh & 7; const size_t rb = (size_t)b * SEQ;
    const bf16* act = (const bf16*)(ws + WS_ACT);
    const bf16* Qb = act + A_QA * ACT_STRIDE + rb * W + h * AD;
    const unsigned* list = (const unsigned*)(ws + WS_LIST) + (size_t)(bh * NBLK + k) * LCAP;
    char* V_lds = lds; char* K_lds = lds + 4 * SHM_V;
    float* wsc = (float*)(lds + SCR_WAVE) + wid * 64; int* rowtab = (int*)(lds + SCR_ROWTAB) + wid * 32; int* cursor = (int*)(lds + SCR_CURSOR); int* seg = (int*)(lds + SCR_DUMP);
    { KVRegs R; kv_issue(R, act + A_KA * ACT_STRIDE + (rb + (size_t)k * MBLK) * W + h * AD, act + A_VA * ACT_STRIDE + (rb + (size_t)k * MBLK) * W + h * AD, tid);
      int sc_[16];
      if (tid == 0) {
#pragma unroll
          for (int j = 0; j < 16; ++j) sc_[j] = j > k ? (int)__hip_atomic_load(cnt + (bh * NBLK + k) * NBLK + j, RLX_AGENT) : 0; }
      __syncthreads();
      if (tid == 0) { *cursor = 0; int run = 0;
#pragma unroll
          for (int j = 0; j < 16; ++j) { seg[j] = run; run += sc_[j]; }
          seg[16] = run; }
      VMW(); kv_write(R, V_lds, K_lds, tid); }
    __syncthreads();
    const int vb0 = (int)(uintptr_t)V_lds + v_rd_base(lane), n_items = gb1 - gb0;
#define GRAB(dst) do { int g_ = 0; if (lane == 0) g_ = __hip_atomic_fetch_add(cursor, 1, __ATOMIC_RELAXED, __HIP_MEMORY_SCOPE_WORKGROUP); dst = __builtin_amdgcn_readfirstlane(g_); } while (0)
#define ENTRY(dst, it_) do { int ix_ = (gb0 + (it_)) * 32 + r32; if (ix_ >= n) ix_ = (gb0 + (it_)) * 32; int sg_ = 0; \
        _Pragma("unroll") for (int j_ = 1; j_ < 16; ++j_) sg_ += seg[j_] <= ix_ ? 1 : 0;                  \
        dst = list[sg_ * MBLK + ix_ - seg[sg_]]; } while (0)
    int it; GRAB(it);
    if (it >= n_items) return;
    unsigned e; ENTRY(e, it);
    bf16x8 qr[8];
#pragma unroll
    for (int d0 = 0; d0 < 8; ++d0) qr[d0] = load8(Qb + (size_t)(e & 4095u) * PITCH + d0 * 16 + hi * 8);
    for (;;) {
        int it2; GRAB(it2);
        const bool more = it2 < n_items; unsigned e2 = 0u; if (more) ENTRY(e2, it2);
        const int ent = ((gb0 + it) * 32 + r32 < n) ? (int)e : -1;
        float m_reg = -1e30f, l_reg = 0; f32x16 o[4] = {};
        GT0();
        attn_tiles<false>(qr, K_lds, vb0, 4, 0, 0, r32, hi, wsc + 32, o, m_reg, l_reg, [&] { if (more) {
#pragma unroll
            for (int d0 = 0; d0 < 8; ++d0) qr[d0] = load8(Qb + (size_t)(e2 & 4095u) * PITCH + d0 * 16 + hi * 8); } });
        GT1();
        attn_store(ws, rb, h, ent, o, m_reg, l_reg, wsc, rowtab, lds + STG + wid * 2048, r32, hi);
        GT2();
        if (!more) break;
        it = it2; e = e2;
    }
#undef GRAB
#undef ENTRY
}
#undef VMW
}


namespace mix {
using moba::f32x16; using moba::s16x4; using moba::u32x4; using moba::crow; using moba::v_st; using moba::v_rd_base; using moba::SHM_V;
__device__ __forceinline__ void slab_put(char* slab, float v, int row, int col, int r32) { const float vn = __builtin_bit_cast(float, __builtin_amdgcn_update_dpp(0, __builtin_bit_cast(int, v), 0xB1  , 0xF, 0xF, true)); if ((r32 & 1) == 0) *(unsigned*)(slab + row * 256 + col * 2) = cvt_pk_bf16(v, vn); }
template <bool TWO> __device__ __forceinline__ void slab_mul_store(const char* slab, const bf16* A, const bf16* B, bf16* Y, size_t e0  , int lane) {
    asm volatile("s_waitcnt lgkmcnt(0)" ::: "memory");
#pragma unroll
    for (int h = 0; h < 2; ++h) { v4u a[4], b[4];
#pragma unroll
        for (int i = 0; i < 4; ++i) { const size_t e = e0 + (size_t)((h * 4 + i) * 4 + (lane >> 4)) * W + (lane & 15) * 8; a[i] = *(const v4u*)(A + e); if (TWO) b[i] = *(const v4u*)(B + e); }
#pragma unroll
        for (int i = 0; i < 4; ++i) { const int row = (h * 4 + i) * 4 + (lane >> 4); const v4u sv = *(const v4u*)(slab + row * 256 + (lane & 15) * 16); v4u o;
#pragma unroll
            for (int j = 0; j < 4; ++j) { float lo = bflo(sv[j]) * bflo(a[i][j]), hi = bfhi(sv[j]) * bfhi(a[i][j]); if (TWO) { lo *= bflo(b[i][j]); hi *= bfhi(b[i][j]); } o[j] = cvt_pk_bf16(lo, hi); }
            *(v4u*)(Y + e0 + (size_t)row * W + (lane & 15) * 8) = o; } }
}
__device__ __forceinline__ void sgu_unit(char* lds, unsigned char* ws, const float* b_s, const float* lng, const float* lnb, int b, int c, int gp) {
    const int tid = opaque_tid(), wid = __builtin_amdgcn_readfirstlane(tid >> 6), lane = tid & 63, r32 = lane & 31, hi = lane >> 5, hw = wid >> 2, tb = wid & 3, g = 2 * gp + hw;
    const size_t row0 = (size_t)b * SEQ + (size_t)c * SC;
    const bf16* act = (const bf16*)(ws + WS_ACT); const bf16* UG = act + A_UG * ACT_STRIDE; const bf16* VG = act + A_VG * ACT_STRIDE; const bf16* ZG = act + A_ZG * ACT_STRIDE; bf16* YG = (bf16*)(ws + WS_Y) + ACT_STRIDE;
    const float* vst = (const float*)(ws + WS_VSTATS); const bf16* wsb = (const bf16*)(ws + WS_WSB); const float* c2 = (const float*)(ws + WS_C2);
    char* V_lds = lds + hw * 2 * SHM_V; f32x2v* stab = (f32x2v*)(lds + 132096);
    const int ht = tid & 255; v4u raw[8];
#pragma unroll
    for (int i = 0; i < 8; ++i) { const int idx = ht + 256 * i, s_ = idx >> 4, col = (idx & 15) * 8; raw[i] = *(const v4u*)(VG + (row0 + s_) * W + g * SGD + col); }
    const bf16* wrow = wsb + ((size_t)g * SC + tb * 32 + r32) * SC + hi * 8;
    bf16x8 wa[8];
#pragma unroll
    for (int k = 0; k < 4; ++k) wa[k] = *(const bf16x8*)(wrow + 16 * k);
    if (tb >= 2) {
#pragma unroll
        for (int k = 4; k < 8; ++k) wa[k] = *(const bf16x8*)(wrow + 16 * k); }
    float gm[4], bt[4], cc[16], bb[16];
#pragma unroll
    for (int d0 = 0; d0 < 4; ++d0) { gm[d0] = lng[g * SGD + d0 * 32 + r32]; bt[d0] = lnb[g * SGD + d0 * 32 + r32]; }
#pragma unroll
    for (int r = 0; r < 16; ++r) { cc[r] = 0.f; bb[r] = 0.f; }
    f32x2v* cbt = (f32x2v*)(lds + 133120) + wid * 32;
    const f32x2v cb_mine = (f32x2v){c2[g * SC + tb * 32 + r32], b_s[g * SC + tb * 32 + r32]};
    if (tid < SC) { const f32x4* sp = (const f32x4*)(vst + (row0 + tid) * 32); float s = 0.f, q = 0.f;
#pragma unroll
        for (int j = 0; j < 8; ++j) { const f32x4 w = sp[j]; s += w[0] + w[2]; q += w[1] + w[3]; }
        const float mean = s * (1.0f / W), var = q * (1.0f / W) - mean * mean; stab[tid] = (f32x2v){mean, 1.0f / sqrtf(var + LN_EPS)}; }
    if (hi == 0) cbt[r32] = cb_mine;
    __syncthreads();
#pragma unroll
    for (int r = 0; r < 16; ++r) { const f32x2v cb = cbt[crow(r, hi)]; cc[r] = cb.x; bb[r] = cb.y; }
#pragma unroll
    for (int i = 0; i < 8; ++i) { const int idx = ht + 256 * i, s_ = idx >> 4, col = (idx & 15) * 8; const f32x2v st = stab[s_]; v4u o;
#pragma unroll
        for (int j = 0; j < 4; ++j) o[j] = cvt_pk_bf16((bflo(raw[i][j]) - st.x) * st.y, (bfhi(raw[i][j]) - st.x) * st.y);
        *(v4u*)(V_lds + (s_ >> 6) * SHM_V + v_st(s_ & 63, col)) = o; }
    __syncthreads();
    f32x16 o[4] = {};
    const int vb0 = (int)(uintptr_t)V_lds + v_rd_base(lane);
    moba::pv_tile<0>(o, vb0, wa[0], wa[1], wa[2], wa[3]);
    if (tb >= 2) moba::pv_tile<1>(o, vb0, wa[4], wa[5], wa[6], wa[7]);
    char* slab = lds + 4 * SHM_V + wid * 8192;
#pragma unroll
    for (int r = 0; r < 16; ++r) { const int tl = crow(r, hi);
#pragma unroll
        for (int d0 = 0; d0 < 4; ++d0) slab_put(slab, gm[d0] * o[d0][r] + bt[d0] * cc[r] + bb[r], tl, d0 * 32 + r32, r32); }
    { const size_t e0 = (row0 + tb * 32) * W + g * SGD; slab_mul_store<true>(slab, UG, ZG, YG, e0, lane); }
    __syncthreads();
}
__device__ __forceinline__ void mem_unit(char* lds, unsigned char* ws, int b, int h, int qb, int dh) {
    const int tid = opaque_tid(), wid = __builtin_amdgcn_readfirstlane(tid >> 6), lane = tid & 63, r32 = lane & 31, hi = lane >> 5;
    const bf16* act = (const bf16*)(ws + WS_ACT); const bf16* QC = act + A_QC * ACT_STRIDE; const bf16* ZC = act + A_ZC * ACT_STRIDE; bf16* YC = (bf16*)(ws + WS_Y) + 2 * ACT_STRIDE;
    const bf16* MK = (const bf16*)(ws + WS_MEMK) + (size_t)b * NMEM * W + h * MD; const bf16* MV = (const bf16*)(ws + WS_MEMV) + (size_t)b * NMEM * W + h * MD + dh * 128;
    const size_t qrow = (size_t)b * SEQ + (size_t)qb * 256 + wid * 32 + r32;
    bf16x8 qr[16];
#pragma unroll
    for (int d0 = 0; d0 < 16; ++d0) qr[d0] = *(const bf16x8*)(QC + qrow * W + h * MD + d0 * 16 + hi * 8);
#pragma unroll
    for (int i = 0; i < 16; ++i) { const int idx = tid + 512 * i, key = idx >> 5, ch = idx & 31; const v4u kv = *(const v4u*)(MK + (size_t)key * W + ch * 8);
        *(v4u*)(lds + key * 512 + ((ch ^ (key & 7)) << 4)) = kv; }
    __syncthreads();
    v4u vraw[8];
#pragma unroll
    for (int i = 0; i < 8; ++i) { const int idx = tid + 512 * i, key = idx >> 4, col = (idx & 15) * 8; vraw[i] = *(const v4u*)(MV + (size_t)key * W + col); }
    f32x16 p[8];
#pragma unroll
    for (int kg = 0; kg < 8; ++kg) { p[kg] = f32x16{};
        const char* kb = lds + (kg * 32 + r32) * 512;
#pragma unroll
        for (int d0 = 0; d0 < 16; ++d0) { const bf16x8 kf = *(const bf16x8*)(kb + (((2 * d0 + hi) ^ (r32 & 7)) << 4)); p[kg] = __builtin_amdgcn_mfma_f32_32x32x16_bf16(kf, qr[d0], p[kg], 0, 0, 0); } }
    constexpr float C2 = 1.4426950408889634f * 0.0625f;
    float mx = p[0][0];
#pragma unroll
    for (int kg = 0; kg < 8; ++kg)
#pragma unroll
        for (int r = 0; r < 16; ++r) mx = fmaxf(mx, p[kg][r]);
    { auto rr = __builtin_amdgcn_permlane32_swap(__float_as_uint(mx), __float_as_uint(mx), false, false); mx = fmaxf(__uint_as_float(rr[0]), __uint_as_float(rr[1])); }
    const float mnl = -mx * C2; float ls = 0.f;
#pragma unroll
    for (int kg = 0; kg < 8; ++kg)
#pragma unroll
        for (int r = 0; r < 16; ++r) { p[kg][r] = __builtin_amdgcn_exp2f(fmaf(p[kg][r], C2, mnl)); ls += p[kg][r]; }
    { auto rr = __builtin_amdgcn_permlane32_swap(__float_as_uint(ls), __float_as_uint(ls), false, false); ls = __uint_as_float(rr[0]) + __uint_as_float(rr[1]); }
    bf16x8 pa[4][4];
#define MIX_PK4(P, B_, OUT) do { unsigned a0 = cvt_pk_bf16(P[B_+0], P[B_+1]), a1 = cvt_pk_bf16(P[B_+2], P[B_+3]);                          \
        unsigned b0 = cvt_pk_bf16(P[B_+4], P[B_+5]), b1 = cvt_pk_bf16(P[B_+6], P[B_+7]);                                             \
        auto r0 = __builtin_amdgcn_permlane32_swap(a0, b0, false, false); auto r1 = __builtin_amdgcn_permlane32_swap(a1, b1, false, false); \
        u32x4 w = {r0[0], r1[0], r0[1], r1[1]}; OUT = *reinterpret_cast<bf16x8*>(&w); } while (0)
#pragma unroll
    for (int t = 0; t < 4; ++t) { MIX_PK4(p[2 * t], 0, pa[t][0]); MIX_PK4(p[2 * t], 8, pa[t][1]); MIX_PK4(p[2 * t + 1], 0, pa[t][2]); MIX_PK4(p[2 * t + 1], 8, pa[t][3]); }
#undef MIX_PK4
    __syncthreads();
#pragma unroll
    for (int i = 0; i < 8; ++i) { const int idx = tid + 512 * i, key = idx >> 4, col = (idx & 15) * 8; *(v4u*)(lds + (key >> 6) * SHM_V + v_st(key & 63, col)) = vraw[i]; }
    __syncthreads();
    f32x16 o[4] = {};
    const int vb0 = (int)(uintptr_t)lds + v_rd_base(lane);
    moba::pv_tile<0>(o, vb0, pa[0][0], pa[0][1], pa[0][2], pa[0][3]); moba::pv_tile<1>(o, vb0, pa[1][0], pa[1][1], pa[1][2], pa[1][3]);
    moba::pv_tile<2>(o, vb0, pa[2][0], pa[2][1], pa[2][2], pa[2][3]); moba::pv_tile<3>(o, vb0, pa[3][0], pa[3][1], pa[3][2], pa[3][3]);
    const float rl = __builtin_amdgcn_rcpf(ls);
    char* slab = lds + 4 * SHM_V + wid * 8192;
    float rliv[16];
#pragma unroll
    for (int r = 0; r < 16; ++r) rliv[r] = __shfl(rl, crow(r, hi));
#pragma unroll
    for (int r = 0; r < 16; ++r) { const int orow = crow(r, hi);
#pragma unroll
        for (int d0 = 0; d0 < 4; ++d0) slab_put(slab, o[d0][r] * rliv[r], orow, d0 * 32 + r32, r32); }
    { const size_t e0 = ((size_t)b * SEQ + (size_t)qb * 256 + wid * 32) * W + h * MD + dh * 128; slab_mul_store<false>(slab, ZC, nullptr, YC, e0, lane); }
    __syncthreads();
}
}


constexpr int NWAVES = 8;
constexpr int RING_BYTES = 131072;
constexpr int LDSCTL_OFF = RING_BYTES, MISC_OFF = LDSCTL_OFF + 320;
constexpr int LDS_BYTES = 163840;
constexpr int CW_TMO = 0, CW_CODE = 1, CW_LCNT = 16384  , CW_BAR = 4096;
constexpr int N_PHASES = 6;

struct Frame {
    LAS unsigned char* lds;
    volatile LAS unsigned* MISC;
    gu32* ctl;
    int vcu, G;
    const float *x, *mem, *w_in, *w_mk, *w_mv, *w_s, *b_s, *lnvg, *lnvb, *wba, *wbg, *wbm, *w_out, *ln_g, *ln_b; float* out;
    unsigned char* ws;
};

__device__ __forceinline__ float wave_sum(float v) {
#pragma unroll
    for (int o = 1; o < 64; o <<= 1) v += __shfl_xor(v, o);
    return v;
}
template <bool DEEP = false> __device__ __forceinline__ void p0_transpose_item(const float* Wm, int K, int N, bf16* WT, int row_off, LAS float* scr, int item, int lane) {
    const int nblk = N / 32, kb = item / nblk, nb = item % nblk, k0 = 64 * kb, n0 = 32 * nb;
    if (DEEP) { float t[32];
#pragma unroll
        for (int i = 0; i < 32; ++i) t[i] = __builtin_nontemporal_load(Wm + (size_t)(k0 + 2 * i + (lane >> 5)) * N + n0 + (lane & 31));
#pragma unroll
        for (int i = 0; i < 32; ++i) scr[(2 * i + (lane >> 5)) * 33 + (lane & 31)] = t[i]; }
    else {
#pragma unroll 8
    for (int i = 0; i < 32; ++i) { const int kk = 2 * i + (lane >> 5); scr[kk * 33 + (lane & 31)] = Wm[(size_t)(k0 + kk) * N + n0 + (lane & 31)]; } }
    LDS_WAIT(); asm volatile("" ::: "memory");
    const int c = lane & 7;
#pragma unroll
    for (int j = 0; j < 4; ++j) { const int n = (lane >> 3) + 8 * j; const LAS float* s = scr + (8 * c) * 33 + n;
        v4u o; o.x = pk2(s[0 * 33], s[1 * 33]); o.y = pk2(s[2 * 33], s[3 * 33]); o.z = pk2(s[4 * 33], s[5 * 33]); o.w = pk2(s[6 * 33], s[7 * 33]);
        *(GAS v4u*)(WT + (size_t)(row_off + n0 + n) * K + k0 + 8 * c) = o; }
    LDS_WAIT(); asm volatile("" ::: "memory");
}
__device__ __forceinline__ void p0_transpose_item_q8(const float* Wm, int K, int N, int col_off, int ncols, float sc, unsigned char* WT, LAS float* scr, int item, int lane) {
    const int nblk = ncols / 32, kb = item / nblk, nb = item % nblk, k0 = 64 * kb, n0 = 32 * nb;
    { f32x4 t[8];
#pragma unroll
      for (int i = 0; i < 8; ++i) t[i] = __builtin_nontemporal_load((const f32x4*)(Wm + (size_t)(k0 + 8 * i + (lane >> 3)) * N + col_off + n0 + 4 * (lane & 7)));
#pragma unroll
      for (int i = 0; i < 8; ++i)
#pragma unroll
          for (int j = 0; j < 4; ++j) scr[(8 * i + (lane >> 3)) * 33 + 4 * (lane & 7) + j] = t[i][j]; }
    LDS_WAIT(); asm volatile("" ::: "memory");
    const int n = lane >> 1, kh = (lane & 1) * 32; const LAS float* s = scr + kh * 33 + n; v4u o[2];
#pragma unroll
    for (int q = 0; q < 8; ++q) o[q >> 2][q & 3] = pk4_i8(s[(4 * q) * 33], s[(4 * q + 1) * 33], s[(4 * q + 2) * 33], s[(4 * q + 3) * 33], sc);
    GAS v4u* dst = (GAS v4u*)(WT + (size_t)(n0 + n) * K + k0 + kh); dst[0] = o[0]; dst[1] = o[1];
    LDS_WAIT(); asm volatile("" ::: "memory");
}
__device__ __forceinline__ void p0_prologue(Frame& F) {
    const int tid_ = opaque_tid(), lane = tid_ & 63, wave = __builtin_amdgcn_readfirstlane(tid_ >> 6);
    LAS float* scr = (LAS float*)(F.lds + wave * 16384);
    const int gw = F.vcu * NWAVES + wave, NGW = F.G * NWAVES;
    constexpr int I_GQ = (DM / 64) * (NPROJ / 32), I_MK = (DM / 64) * (W / 32);
    constexpr int NITEMS = I_GQ + 2 * I_MK;
    for (int it = gw; it < NITEMS; it += NGW) {
        int r = it;
        if (r < I_GQ) { const int nb = r % (NPROJ / 32); const bool beta = (nb >= 64 && nb < 96) || (nb >= 128 && nb < 192);
            p0_transpose_item_q8(F.w_in, DM, NPROJ, 0, NPROJ, beta ? QWB : QW, F.ws + WS_WQ, scr, r, lane); continue; } r -= I_GQ;
        if (r < I_MK) { p0_transpose_item_q8(F.w_mk, DM, W, 0, W, QW, F.ws + WS_WQ + (size_t)NPROJ * DM, scr, r, lane); continue; } r -= I_MK;
        p0_transpose_item_q8(F.w_mv, DM, W, 0, W, QWB, F.ws + WS_WQ + (size_t)(NPROJ + W) * DM, scr, r, lane);
    }
    { GAS v2u* xq = (GAS v2u*)(F.ws + WS_XQ); const GAS f32x4* xs = (const GAS f32x4*)F.x;
      for (int i = gw; i < (M * DM) / 512; i += NGW) { const size_t ch = (size_t)i * 64 + lane; const f32x4 a = __builtin_nontemporal_load(xs + 2 * ch), b = __builtin_nontemporal_load(xs + 2 * ch + 1);
          xq[ch] = (v2u){pk4_i8(a[0], a[1], a[2], a[3], QX), pk4_i8(b[0], b[1], b[2], b[3], QX)}; }
      GAS v2u* mq = (GAS v2u*)(F.ws + WS_MQ); const GAS f32x4* ms = (const GAS f32x4*)F.mem;
      for (int i = gw; i < (MM * DM) / 512; i += NGW) { const size_t ch = (size_t)i * 64 + lane; const f32x4 a = ms[2 * ch], b = ms[2 * ch + 1];
          mq[ch] = (v2u){pk4_i8(a[0], a[1], a[2], a[3], QX), pk4_i8(b[0], b[1], b[2], b[3], QX)}; } }
    { bf16* wsb = (bf16*)(F.ws + WS_WSB); float* c2 = (float*)(F.ws + WS_C2);
      for (int row = gw; row < SG * SC; row += NGW) { const int t = row % SC; float s = 0.f;
#pragma unroll
          for (int h = 0; h < 2; ++h) { const int sidx = lane + 64 * h; const float w = sidx <= t ? F.w_s[(size_t)row * SC + sidx] : 0.f; const unsigned short wb = (unsigned short)f2bf(w); wsb[(size_t)row * SC + sidx] = wb; s += bf2f(wb); }
          s = wave_sum(s); if (lane == 0) c2[row] = s; } }
}

__device__ __forceinline__ void p0_late(Frame& F, int me, int nw) {
    const int tid_ = opaque_tid(), lane = tid_ & 63, wave = __builtin_amdgcn_readfirstlane(tid_ >> 6);
    LAS float* scr = (LAS float*)(F.lds + wave * 16384);
    bf16* WBR = (bf16*)(F.ws + WS_WBR);
    constexpr int I_BR = (W / 64) * (DM / 32), I_OUT = (DM / 64) * (DM / 32);
    for (int it = me * NWAVES + wave; it < 3 * I_BR + I_OUT; it += nw * NWAVES) {
        int r = it;
        if (r < I_BR) { p0_transpose_item<true>(F.wba, W, DM, WBR, 0, scr, r, lane); continue; } r -= I_BR;
        if (r < I_BR) { p0_transpose_item<true>(F.wbg, W, DM, WBR, DM, scr, r, lane); continue; } r -= I_BR;
        if (r < I_BR) { p0_transpose_item<true>(F.wbm, W, DM, WBR, 2 * DM, scr, r, lane); continue; } r -= I_BR;
        p0_transpose_item_q8(F.w_out, DM, DM, 0, DM, QWB, F.ws + WS_WOUT, scr, r, lane);
    }
}
constexpr int CW_COMB = 2, COMB_ROWS = 16;
__device__ __forceinline__ void p3_combine(Frame& F) {
    const int tid_ = opaque_tid(), lane = tid_ & 63, wave = __builtin_amdgcn_readfirstlane(tid_ >> 6);
    const float* ml4 = (const float*)(F.ws + WS_ML4);
    const bf16* za = (const bf16*)(F.ws + WS_ACT) + A_ZA * ACT_STRIDE; bf16* ya = (bf16*)(F.ws + WS_Y);
    constexpr float C2 = 1.4426950408889634f * moba::SCALE;
    volatile LAS int* slot = (volatile LAS int*)(F.lds + moba::SCR_U0);
    if (tid_ == 0) *slot = (int)__hip_atomic_fetch_add(F.ctl + CW_COMB, 1u, RLX_AGENT);
    __syncthreads();
    int c = __builtin_amdgcn_readfirstlane(*slot);
    while (c < M / COMB_ROWS) {
        int nxt = 0; if (tid_ == 0) nxt = (int)__hip_atomic_fetch_add(F.ctl + CW_COMB, 1u, RLX_AGENT);
        const int row = c * COMB_ROWS + wave * 2;
        f32x2v ml[4][4]; v4u p[4][4], z[4]; size_t e[4];
#pragma unroll
        for (int q = 0; q < 4; ++q) { const int r_ = row + (q >> 1), col = (q & 1) * 512 + lane * 8, head = col >> 7; e[q] = (size_t)r_ * W + col;
#pragma unroll
            for (int s = 0; s < 4; ++s) { ml[q][s] = *(const f32x2v*)(ml4 + ((size_t)s * M + r_) * (2 * AH) + head * 2); p[q][s] = __builtin_nontemporal_load((const v4u*)(moba::po_slot(F.ws, s) + e[q])); }
            z[q] = __builtin_nontemporal_load((const v4u*)(za + e[q])); }
#pragma unroll
        for (int q = 0; q < 4; ++q) {
            const float mx = fmaxf(fmaxf(ml[q][0].x, ml[q][1].x), fmaxf(ml[q][2].x, ml[q][3].x)); float w[4], ws_ = 0.f;
#pragma unroll
            for (int s = 0; s < 4; ++s) { w[s] = ml[q][s].y * __builtin_amdgcn_exp2f((ml[q][s].x - mx) * C2); ws_ += w[s]; }
            const float inv = 1.0f / ws_; v4u o;
#pragma unroll
            for (int j = 0; j < 4; ++j) { float lo = 0.f, hi = 0.f;
#pragma unroll
                for (int s = 0; s < 4; ++s) { const unsigned pw = ml[q][s].y > 0.f ? p[q][s][j] : 0u; const float f = w[s] * inv; lo += f * bflo(pw); hi += f * bfhi(pw); }
                o[j] = cvt_pk_bf16(lo * bflo(z[q][j]), hi * bfhi(z[q][j])); }
            *(v4u*)(ya + e[q]) = o; }
        __syncthreads();
        if (tid_ == 0) *slot = nxt;
        __syncthreads();
        c = __builtin_amdgcn_readfirstlane(*slot);
    }
}

struct Args { const float* in[15]; float* out; unsigned char* ws; int ph_lo, ph_hi, li, pad; };
__global__ void __launch_bounds__(NWAVES * 64, 2) mk_fwd(Args args) {
    extern __shared__ __attribute__((aligned(16))) unsigned char lds[];
    Frame F;
    F.lds = (LAS unsigned char*)lds;
    F.MISC = (volatile LAS unsigned*)(F.lds + MISC_OFF);
    F.G = gridDim.x; { const int bx = blockIdx.x; F.vcu = (F.G % 8 == 0) ? (bx % 8) * (F.G / 8) + bx / 8 : bx; }
    F.ws = args.ws; F.ctl = (gu32*)(args.ws + WS_CTL);
    F.x = args.in[0]; F.mem = args.in[1]; F.w_in = args.in[2]; F.w_mk = args.in[3]; F.w_mv = args.in[4]; F.w_s = args.in[5]; F.b_s = args.in[6]; F.lnvg = args.in[7]; F.lnvb = args.in[8];
    F.wba = args.in[9]; F.wbg = args.in[10]; F.wbm = args.in[11]; F.w_out = args.in[12]; F.ln_g = args.in[13]; F.ln_b = args.in[14]; F.out = args.out;
    for (int u = threadIdx.x; u < (LDS_BYTES - LDSCTL_OFF) / 4; u += NWAVES * 64) ((LAS unsigned*)(F.lds + LDSCTL_OFF))[u] = 0u;
    __syncthreads();
    XcdBarrier bar = xcd_barrier_post((unsigned*)(F.ctl + CW_BAR) + args.li * XCD_BAR_WORDS, F.MISC + 8);
    const int lo = args.ph_lo, hi = args.ph_hi;
#ifdef TS_PHASE
    unsigned long long ts_[8], tc_[8]; int nts_ = 0; tc_[nts_] = __builtin_amdgcn_s_memtime(); ts_[nts_++] = __builtin_amdgcn_s_memrealtime();
#define STAMP() do { tc_[nts_] = __builtin_amdgcn_s_memtime(); ts_[nts_++] = __builtin_amdgcn_s_memrealtime(); } while (0)
#else
#define STAMP() do {} while (0)
#endif
#define IN(k) (lo <= (k) && (k) < hi)
#define BOTH(k) (IN(k) && IN((k) + 1))
    unsigned char* ws = args.ws;
    if (IN(0)) { p0_prologue(F); if (BOTH(0)) xcd_barrier(bar); } STAMP();
    if (IN(1)) {
        pg8::Gemm gq{(const bf16*)(ws + WS_XQ), (const bf16*)(ws + WS_WQ), DM}; pg8::GateOrder Sq{F.G, (int)blockIdx.x}; pg8::EpiGate Eq{(bf16*)(ws + WS_GATES), (bf16*)(ws + WS_ACT), (bf16*)(ws + WS_MEMK), (float*)(ws + WS_KMEAN), (float*)(ws + WS_VSTATS)};
        pg8::gemm_phase<pg8::EpiGate, pg8::GateOrder, true, true, true>(F.lds, gq, Sq, Eq);
        { const int first_idle = (1920 + 16) - 7 * F.G; if (F.G == 256 && (int)blockIdx.x >= first_idle) p0_late(F, (int)blockIdx.x - first_idle, F.G - first_idle); else if (F.G != 256) p0_late(F, (int)blockIdx.x, F.G); }
        if (BOTH(1)) xcd_barrier(bar);
    } STAMP();
    if (IN(2)) {
        if (F.G == 256) { const int v = F.vcu; gu32* lcnt = F.ctl + CW_LCNT;
            moba::select_own(ws, (char*)lds, lcnt, v >> 4, v & 15, [&] { xcd_barrier_arrive(bar); });
            xcd_barrier_wait(bar);
#if defined(TS_PHASE) && TS_PHASE == 12
            STAMP();
#endif
            constexpr int UC0 = 32;
            int* P = (int*)((char*)lds + moba::SCR_P); int* Nn = (int*)((char*)lds + moba::SCR_N); int* u0p = (int*)((char*)lds + moba::SCR_U0);
            const int tid = opaque_tid();
            if (tid < 64) { int c[4], n4[4], s = 0;
#pragma unroll
                for (int i = 0; i < 4; ++i) { const int u_ = tid * 4 + i, k_ = u_ & 15; int s_ = 0;
#pragma unroll
                    for (int j_ = 1; j_ < 16; ++j_) { const int c_ = (int)__hip_atomic_load(lcnt + u_ * 16 + j_, RLX_AGENT); s_ += j_ > k_ ? c_ : 0; }
                    n4[i] = s_; const int nb_ = (n4[i] + 31) >> 5; c[i] = n4[i] > 0 ? UC0 + 4 * nb_ : 0; s += c[i]; }
                int inc = s;
#pragma unroll
                for (int o = 1; o < 64; o <<= 1) { const int t = __shfl_up(inc, o); if (tid >= o) inc += t; }
                int ex = inc - s;
#pragma unroll
                for (int i = 0; i < 4; ++i) { P[tid * 4 + i] = ex; Nn[tid * 4 + i] = n4[i]; ex += c[i]; }
                if (tid == 63) P[256] = ex; }
            __syncthreads();
            const int C = __builtin_amdgcn_readfirstlane(P[256]), lo = (int)(((long long)C * v) >> 8), hi = (int)(((long long)C * (v + 1)) >> 8);
            int* u1p = (int*)((char*)lds + moba::SCR_CURSOR);
            if (tid == 0) *u1p = 256;
            __syncthreads();
            if (tid < 256 && P[tid] <= lo && lo < P[tid + 1]) *u0p = tid;
            if (tid < 256 && P[tid] <= hi && hi < P[tid + 1]) *u1p = tid;
            __syncthreads();
#if defined(TS_PHASE) && TS_PHASE == 13
            STAMP();
#endif
            const int ua = __builtin_amdgcn_readfirstlane(*u0p), ub = __builtin_amdgcn_readfirstlane(*u1p);
            auto cut = [&](int x, int u) -> int {
                const int pu = __builtin_amdgcn_readfirstlane(P[u]), nb = (__builtin_amdgcn_readfirstlane(Nn[u]) + 31) >> 5;
                int i = (x - pu - UC0 + 3) >> 2; i = i < 0 ? 0 : (i > nb ? nb : i);
                const int r = i & 7; i = r < 4 ? i - r : i - r + 8; return i > nb ? nb : i; };
            const int ia = cut(lo, ua), ib = ub < 256 ? cut(hi, ub) : 0;
            __syncthreads();
            for (int u = ua; u < 256 && u <= ub; ++u) {
                const int n = __builtin_amdgcn_readfirstlane(Nn[u]), nb = (n + 31) >> 5;
                const int i0 = u == ua ? ia : 0, i1 = u == ub ? ib : nb;
                if (i0 < i1) moba::gather_unit(ws, (char*)lds, lcnt, u >> 4, u & 15, n, i0, i1); }
#if defined(TS_PHASE) && TS_PHASE == 14
            STAMP();
#endif
#if defined(TS_PHASE) && (TS_PHASE == 61 || TS_PHASE == 62 || TS_PHASE == 63)
            if (threadIdx.x == 0) ((unsigned long long*)(ws + WS_CTL + 8192))[v] = __builtin_amdgcn_s_memrealtime();
#endif
        }
        if (BOTH(2)) xcd_barrier_arrive(bar);
    } STAMP();
    if (IN(3)) {
        if (F.G == 256) { const int v = F.vcu;
            mix::mem_unit((char*)lds, ws, v >> 7, (v >> 5) & 3, (v >> 1) & 15, v & 1);
#if defined(TS_PHASE) && TS_PHASE == 10
            STAMP();
#endif
            mix::sgu_unit((char*)lds, ws, F.b_s, F.lnvg, F.lnvb, v >> 7, (v >> 2) & 31, v & 3); }
#if defined(TS_PHASE) && TS_PHASE == 11
        STAMP();
#endif
        if (BOTH(2)) xcd_barrier_wait(bar);
#if defined(TS_PHASE) && (TS_PHASE >= 64 && TS_PHASE <= 69)
        if (threadIdx.x == 0 && (TS_PHASE == 64 || TS_PHASE == 65)) ((unsigned long long*)(ws + WS_CTL + 8192))[F.vcu] = __builtin_amdgcn_s_memrealtime();
#endif
        p3_combine(F);
#if defined(TS_PHASE) && (TS_PHASE >= 64 && TS_PHASE <= 69)
        if (threadIdx.x == 0 && (TS_PHASE == 66 || TS_PHASE == 67)) ((unsigned long long*)(ws + WS_CTL + 8192))[F.vcu] = __builtin_amdgcn_s_memrealtime();
#endif
        if (BOTH(3)) xcd_barrier(bar);
    } STAMP();
    const int tile = F.vcu;
    if (IN(4)) {
        pg8::Gemm g{(const bf16*)(ws + WS_Y), (const bf16*)(ws + WS_WBR), W}; pg8::BranchOrder S{tile >> 3, tile & 7};
        pg8::EpiBranch E{(const bf16*)(ws + WS_GATES), (bf16*)(ws + WS_MERGED)};
        if (F.G == 256) {
            pg8::gemm_phase<pg8::EpiBranch, pg8::BranchOrder, true, true>(F.lds, g, S, E); }
        if (BOTH(4)) xcd_barrier(bar);
    } STAMP();
    if (IN(5)) {
        pg8::Gemm g{(const bf16*)(ws + WS_MERGED), (const bf16*)(ws + WS_WOUT), DM}; pg8::OneOrder S{tile >> 3, tile & 7};
        pg8::EpiOutLN E{F.x, F.out, F.ln_g, F.ln_b, (float*)(ws + WS_LNS), bar};
        if (F.G == 256) pg8::gemm_phase<pg8::EpiOutLN, pg8::OneOrder, false, true, true>(F.lds, g, S, E);
    } STAMP();
#ifdef TS_PHASE
#if TS_PHASE >= 90 && TS_PHASE <= 95
    if (blockIdx.x == 0 && threadIdx.x == 0) { const float n_ = (float)moba::g_gacc[2]; const float val = TS_PHASE == 90 ? (float)moba::g_gacc[0] / n_ * 1e-3f : TS_PHASE == 91 ? (float)moba::g_gacc[1] / n_ * 1e-3f : n_; F.out[0] += val * 0.01f; }
#elif TS_PHASE >= 64 && TS_PHASE <= 67
    if (blockIdx.x == 0 && threadIdx.x == 0) { const unsigned long long* ft = (const unsigned long long*)(ws + WS_CTL + 8192); unsigned long long mx = 0, mn = ~0ull;
        for (int i = 0; i < 256; ++i) { const unsigned long long t_ = __hip_atomic_load(ft + i, RLX_AGENT); if (t_ > mx) mx = t_; if (t_ < mn) mn = t_; }
        const float val = (TS_PHASE & 1) ? (float)(mn - ts_[2]) * 0.01f : (float)(mx - ts_[2]) * 0.01f; F.out[0] += val * 0.001f; }
#elif TS_PHASE == 81 || TS_PHASE == 84
    if (blockIdx.x == 0 && threadIdx.x == 0) { const int k_ = TS_PHASE - 80; const float us = (float)(ts_[k_ + 1] - ts_[k_]) * 0.01f - (TS_PHASE == 81 ? 200.f : 60.f); F.out[0] += us * 0.01f; }
#elif TS_PHASE == 61 || TS_PHASE == 62 || TS_PHASE == 63
    if (blockIdx.x == 0 && threadIdx.x == 0) { const unsigned long long* ft = (const unsigned long long*)(ws + WS_CTL + 8192); unsigned long long mx = 0, mn = ~0ull; int am = 0;
        for (int i = 0; i < 256; ++i) { const unsigned long long t_ = __hip_atomic_load(ft + i, RLX_AGENT); if (t_ > mx) { mx = t_; am = i; } if (t_ < mn) mn = t_; }
        const float val = TS_PHASE == 61 ? (float)(mx - ts_[2]) * 0.01f : TS_PHASE == 62 ? (float)am : (float)(mn - ts_[2]) * 0.01f; F.out[0] += val * 0.01f; }
#elif TS_PHASE >= 70 && TS_PHASE < 80
    if (blockIdx.x == 0 && threadIdx.x == 0) { const int k_ = TS_PHASE - 70; const float r_ = (float)(tc_[k_ + 1] - tc_[k_]) / (float)(ts_[k_ + 1] - ts_[k_]); F.out[0] += r_ * 0.01f; }
#elif TS_PHASE >= 30 && TS_PHASE < 60
    if (blockIdx.x == 0 && threadIdx.x == 0) { const float us = (float)(g_tsp - ts_[2]) * 0.01f; F.out[0] += us * 0.01f; }
#elif TS_PHASE >= 100
    if (blockIdx.x == 0 && threadIdx.x == 0) { const float us = (float)__hip_atomic_load(&pg8::g_epi_ticks, RLX_AGENT) * 0.01f; F.out[0] += us * 0.01f; }
#else
    if (blockIdx.x == 0 && threadIdx.x == 0) { const int k_ = (TS_PHASE >= 12 && TS_PHASE <= 14) ? 2 : TS_PHASE >= 10 ? 3 : TS_PHASE; const float us = TS_PHASE == 20 ? (float)(ts_[nts_ - 1] - ts_[0]) * 0.001f : (float)(ts_[k_ + 1] - ts_[k_]) * 0.01f; F.out[0] += us * 0.01f; }
#endif
#endif
#undef IN
#undef BOTH
}


extern "C" void kernel_launch(void* const* d_in, const int* in_sizes, int n_in, void* d_out, int out_size, void* d_ws, size_t ws_size, hipStream_t stream) {
    static int grid = 0;
    if (grid == 0) {
        if (n_in != 15 || in_sizes[0] != M * DM || in_sizes[2] != DM * NPROJ || out_size != M * DM || ws_size < WS_END) { fprintf(stderr, "kernel_launch: unexpected shapes (n_in %d, ws %zu); nothing launched\n", n_in, ws_size); grid = -1; return; }
        int dev = 0, cus = 0, per_cu = 0;
        if (hipGetDevice(&dev) != hipSuccess || hipDeviceGetAttribute(&cus, hipDeviceAttributeMultiprocessorCount, dev) != hipSuccess) { grid = -1; return; }
        if (hipFuncSetAttribute((const void*)mk_fwd, hipFuncAttributeMaxDynamicSharedMemorySize, LDS_BYTES) != hipSuccess) { fprintf(stderr, "kernel_launch: hipFuncSetAttribute failed\n"); grid = -1; return; }
        if (hipOccupancyMaxActiveBlocksPerMultiprocessor(&per_cu, (const void*)mk_fwd, NWAVES * 64, LDS_BYTES) != hipSuccess || per_cu < 1) fprintf(stderr, "kernel_launch: occupancy query reports %d workgroups per CU\n", per_cu);
        (void)hipGetLastError();
        grid = cus;
        if (grid != 256) fprintf(stderr, "kernel_launch: %d CUs; the one-tile-per-workgroup phases need 256\n", grid);
    }
    if (grid < 0) return;
    (void)hipMemsetAsync((char*)d_ws + WS_CTL, 0, 65536, stream);
    Args a{};
    for (int i = 0; i < 15; ++i) a.in[i] = (const float*)d_in[i];
    a.out = (float*)d_out; a.ws = (unsigned char*)d_ws;
    a.ph_lo = 0; a.ph_hi = N_PHASES; a.li = 0;
    hipLaunchKernelGGL(mk_fwd, dim3(grid), dim3(NWAVES * 64), LDS_BYTES, stream, a);
    const hipError_t le = hipPeekAtLastError();
    if (le != hipSuccess) fprintf(stderr, "kernel_launch: launch failed: %s\n", hipGetErrorName(le));
}
```

```cpp
#include <hip/hip_runtime.h>
#include <cstdio>
#include <cstdint>


constexpr int DM = 2048, NB = 2, SEQ = 4096, M = NB * SEQ;
constexpr int NMEM = 256, MM = NB * NMEM;
constexpr int W = 1024;
constexpr int NPROJ = 15360;
constexpr int AH = 8, AD = 128, MBLK = 256, NBLK = SEQ / MBLK;
constexpr int SG = 8, SC = 128, SGD = 128;
constexpr int MH = 4, MD = 256;
constexpr float DN_ALPHA = 1.189207115002721f;
constexpr float LN_EPS = 1e-5f;

constexpr size_t MiB = 1u << 20;
constexpr size_t WS_CTL = 0, CTL_ZERO_BYTES = 1 * MiB;
constexpr size_t WS_KMEAN = 1 * MiB;
constexpr size_t WS_C2 = 1 * MiB + 256 * 1024;
constexpr size_t WS_WSB = 1 * MiB + 512 * 1024;
constexpr size_t WS_LNS = 24 * MiB;
constexpr size_t WS_WBR = 2 * MiB;
constexpr size_t WS_WOUT = 14 * MiB;
constexpr size_t WS_VSTATS = 22 * MiB;
constexpr size_t WS_ML = 23 * MiB;
constexpr size_t WS_WIN = 32 * MiB;
constexpr size_t WS_WMKV = 92 * MiB;
constexpr size_t WS_XB = 100 * MiB;
constexpr size_t WS_MEMB = 132 * MiB;
constexpr size_t WS_ACT = 134 * MiB;
constexpr size_t ACT_STRIDE = (size_t)M * W;
constexpr size_t KM_SLOT = (size_t)NB * NBLK * W;
constexpr size_t WS_GATES = 278 * MiB;
constexpr size_t WS_MEMK = 374 * MiB;
constexpr size_t WS_MEMV = 375 * MiB;
constexpr size_t WS_Y = 376 * MiB;
constexpr size_t WS_MERGED = 424 * MiB;
constexpr float QM = 128.f;
constexpr float QX = 32.f, QW = 1024.f, QWB = 2048.f;
constexpr size_t WS_WQ = 68 * MiB;
constexpr size_t WS_XQ = 456 * MiB;
constexpr size_t WS_MQ = 472 * MiB;
constexpr size_t WS_END = 473 * MiB;
constexpr size_t WS_PO = 32 * MiB;
constexpr size_t WS_POS = 326 * MiB;
constexpr size_t WS_ML4 = 26 * MiB;
constexpr size_t WS_LIST = 28 * MiB;
constexpr int LCAP = NBLK * MBLK;
constexpr size_t WS_H = 32 * MiB;
enum { A_QA = 0, A_KA, A_VA, A_ZA, A_UG, A_VG, A_ZG, A_QC, A_ZC };
static_assert(WS_WIN + (size_t)NPROJ * DM * 2 == WS_WMKV && WS_XB + (size_t)M * DM * 2 == WS_MEMB && WS_MEMB + (size_t)MM * DM * 2 == WS_ACT, "virtual concatenations");
static_assert(WS_ACT + 9 * ACT_STRIDE * 2 == WS_GATES && WS_GATES + (size_t)M * 3 * DM * 2 == WS_MEMK && WS_Y + 3 * ACT_STRIDE * 2 == WS_MERGED, "d_ws map");

typedef unsigned short bf16;
__host__ __device__ __forceinline__ unsigned f2bf(float f) { unsigned u = __builtin_bit_cast(unsigned, f); return (u + 0x7fffu + ((u >> 16) & 1u)) >> 16; }
__host__ __device__ __forceinline__ float bf2f(unsigned short h) { return __builtin_bit_cast(float, (unsigned)h << 16); }


#define GAS __attribute__((address_space(1)))
#define LAS __attribute__((address_space(3)))
typedef unsigned v4u __attribute__((ext_vector_type(4)));
typedef unsigned v2u __attribute__((ext_vector_type(2)));
typedef float f32x4 __attribute__((ext_vector_type(4)));
typedef float f32x2v __attribute__((ext_vector_type(2)));
typedef short bf16x8 __attribute__((ext_vector_type(8)));
typedef GAS unsigned gu32;
#define RLX_AGENT __ATOMIC_RELAXED, __HIP_MEMORY_SCOPE_AGENT
#define LDS_WAIT() asm volatile("s_waitcnt lgkmcnt(0)" ::: "memory")
#define VM_WAIT() asm volatile("s_waitcnt vmcnt(0)" ::: "memory")
__device__ __forceinline__ unsigned pk2(float lo, float hi) { return f2bf(lo) | (f2bf(hi) << 16); }
typedef float f32x2_t __attribute__((ext_vector_type(2))); typedef __bf16 bf16x2_t __attribute__((ext_vector_type(2)));
__device__ __forceinline__ unsigned cvt_pk_bf16(float lo, float hi) { f32x2_t v = {lo, hi}; bf16x2_t b = __builtin_convertvector(v, bf16x2_t); return __builtin_bit_cast(unsigned, b); }
__device__ __forceinline__ unsigned q8(float v, float s) { return (unsigned)(int)__builtin_rintf(__builtin_fminf(__builtin_fmaxf(v * s, -127.f), 127.f)) & 0xffu; }
__device__ __forceinline__ unsigned pk4_i8(float a, float b, float c, float d, float s) { return q8(a, s) | (q8(b, s) << 8) | (q8(c, s) << 16) | (q8(d, s) << 24); }
__device__ __forceinline__ float bflo(unsigned w) { return __builtin_bit_cast(float, w << 16); }
__device__ __forceinline__ float bfhi(unsigned w) { return __builtin_bit_cast(float, w & 0xffff0000u); }

__device__ __forceinline__ float sum_xor16(float s) { const unsigned u = __builtin_bit_cast(unsigned, s); unsigned u2 = u; asm volatile("" : "+v"(u2)); auto r = __builtin_amdgcn_permlane16_swap(u, u2, false, false); const unsigned a_ = r[0], b_ = r[1]; return __builtin_bit_cast(float, a_) + __builtin_bit_cast(float, b_); }
__device__ __forceinline__ float sum_xor32(float s) { const unsigned u = __builtin_bit_cast(unsigned, s); unsigned u2 = u; asm volatile("" : "+v"(u2)); auto r = __builtin_amdgcn_permlane32_swap(u, u2, false, false); const unsigned a_ = r[0], b_ = r[1]; return __builtin_bit_cast(float, a_) + __builtin_bit_cast(float, b_); }
__device__ __forceinline__ int opaque_tid() { int t = threadIdx.x; asm volatile("" : "+v"(t)); return t; }

#if defined(TS_PHASE) && TS_PHASE >= 30 && TS_PHASE < 60
__device__ unsigned long long g_tsp;
#define TSP(id) do { if (((TS_PHASE == (id) && blockIdx.x == 0) || (TS_PHASE == (id) + 10 && blockIdx.x == 120)) && threadIdx.x == 448) g_tsp = __builtin_amdgcn_s_memrealtime(); } while (0)
#else
#define TSP(id) do {} while (0)
#endif

#define XB_TMO      128
#define XB_XCNT(j)  (256  + 64 * (j))
#define XB_XSUB(j)  (1280 + 64 * (j))
#define XB_XGEN(j)  (2304 + 64 * (j))
#define XB_TOP      3328
#define XB_TOPGEN   3392
#define XCD_BAR_WORDS 3456
#define XB_SPIN_CAP (1u << 18)

__device__ __forceinline__ unsigned xb_ld(unsigned* p)              { return __hip_atomic_load(p, __ATOMIC_RELAXED, __HIP_MEMORY_SCOPE_AGENT); }
__device__ __forceinline__ unsigned xb_add(unsigned* p, unsigned v) { return __hip_atomic_fetch_add(p, v, __ATOMIC_RELAXED, __HIP_MEMORY_SCOPE_AGENT); }
__device__ __forceinline__ unsigned xb_xcc_id() { return (unsigned)__builtin_amdgcn_s_getreg((3 << 11) | 20) & 0xFu; }
#define XB_SPIN(cond, bar) do { unsigned _sp = 0; while (cond) { __builtin_amdgcn_s_sleep(1); \
    if ((++_sp & 255u) == 0u) { if (xb_ld(&(bar)[XB_TMO])) break; if (_sp > XB_SPIN_CAP) { atomicAdd(&(bar)[XB_TMO], 1u); break; } } } } while (0)

struct XcdBarrier {
    unsigned* bar; unsigned x;
    volatile LAS unsigned* st;
};

__device__ __forceinline__ XcdBarrier xcd_barrier_post(unsigned* bar, volatile LAS unsigned* st) {
    XcdBarrier b; b.bar = bar; b.x = xb_xcc_id(); b.st = st;
    if (threadIdx.x == 0) (void)xb_add(&bar[XB_XCNT(b.x)], 1u);
    return b;
}
__device__ __forceinline__ void xcd_barrier_complete(unsigned* bar, unsigned x, unsigned& nloc, unsigned& nx) {
    const unsigned G = gridDim.x * gridDim.y * gridDim.z;
    unsigned sum, cnt, mine, sp = 0u;
    for (;;) {
        sum = 0u; cnt = 0u; mine = 0u;
#pragma unroll
        for (unsigned j = 0; j < 16; ++j) { const unsigned c = xb_ld(&bar[XB_XCNT(j)]); sum += c; cnt += (c > 0u) ? 1u : 0u; mine = (j == x) ? c : mine; }
        if (sum == G) break;
        __builtin_amdgcn_s_sleep(1);
        if ((++sp & 255u) == 0u) { if (xb_ld(&bar[XB_TMO])) break; if (sp > XB_SPIN_CAP) { atomicAdd(&bar[XB_TMO], 1u); break; } }
    }
    nloc = mine > 0u ? mine : 1u; nx = cnt > 0u ? cnt : 1u;
}

__device__ __forceinline__ void xcd_barrier(const XcdBarrier& b) {
    asm volatile("s_waitcnt vmcnt(0)" ::: "memory");
    __syncthreads();
    if (threadIdx.x == 0) {
        unsigned* bar = b.bar;
        __builtin_amdgcn_s_waitcnt(0);
        unsigned nloc = b.st[0], nx = b.st[1];
        if (nloc == 0u) { xcd_barrier_complete(bar, b.x, nloc, nx); b.st[0] = nloc; b.st[1] = nx; }
        const unsigned old = xb_add(&bar[XB_XSUB(b.x)], 1u);
        const unsigned gen = old / nloc;
        if (old + 1u == (gen + 1u) * nloc) {
            __builtin_amdgcn_fence(__ATOMIC_RELEASE, "agent");
            asm volatile("s_waitcnt vmcnt(0)" ::: "memory");
            const unsigned og = xb_add(&bar[XB_TOP], 1u);
            const unsigned tg = og / nx;
            if (og + 1u == (tg + 1u) * nx) xb_add(&bar[XB_TOPGEN], 1u);
            else XB_SPIN(xb_ld(&bar[XB_TOPGEN]) == tg, bar);
            __builtin_amdgcn_fence(__ATOMIC_ACQUIRE, "agent");
            xb_add(&bar[XB_XGEN(b.x)], 1u);
            asm volatile("s_waitcnt vmcnt(0)" ::: "memory");
        } else {
            XB_SPIN((int)(xb_ld(&bar[XB_XGEN(b.x)]) - gen) <= 0, bar);
            __builtin_amdgcn_fence(__ATOMIC_ACQUIRE, "agent");
            asm volatile("s_waitcnt vmcnt(0)" ::: "memory");
        }
    }
    __syncthreads();
}

__device__ __forceinline__ void xcd_barrier_arrive(const XcdBarrier& b) {
    asm volatile("s_waitcnt vmcnt(0)" ::: "memory");
    __syncthreads();
    if (threadIdx.x == 0) {
        unsigned* bar = b.bar;
        __builtin_amdgcn_s_waitcnt(0);
        unsigned nloc = b.st[0], nx = b.st[1];
        if (nloc == 0u) { xcd_barrier_complete(bar, b.x, nloc, nx); b.st[0] = nloc; b.st[1] = nx; }
        const unsigned old = xb_add(&bar[XB_XSUB(b.x)], 1u);
        const unsigned gen = old / nloc; unsigned role = 0u, tg = 0u;
        if (old + 1u == (gen + 1u) * nloc) {
            __builtin_amdgcn_fence(__ATOMIC_RELEASE, "agent");
            asm volatile("s_waitcnt vmcnt(0)" ::: "memory");
            const unsigned og = xb_add(&bar[XB_TOP], 1u);
            tg = og / nx;
            if (og + 1u == (tg + 1u) * nx) { xb_add(&bar[XB_TOPGEN], 1u); role = 2u; } else role = 1u;
        }
        b.st[2] = gen; b.st[3] = tg; b.st[4] = role;
    }
}
__device__ __forceinline__ void xcd_barrier_wait(const XcdBarrier& b) {
    __syncthreads();
    if (threadIdx.x == 0) {
        unsigned* bar = b.bar;
        const unsigned gen = b.st[2], role = b.st[4];
        XB_SPIN(xb_ld(&bar[XB_TOPGEN]) == gen, bar);
        __builtin_amdgcn_fence(__ATOMIC_ACQUIRE, "agent");
        if (role != 0u) xb_add(&bar[XB_XGEN(b.x)], 1u);
        asm volatile("s_waitcnt vmcnt(0)" ::: "memory");
    }
    __syncthreads();
}


namespace pg8 {
#define PG8_LAS __attribute__((address_space(3)))
typedef unsigned short bf16_t;
typedef unsigned u32x4 __attribute__((ext_vector_type(4)));
constexpr int BM = 256, BK = 64, HALF = 128, HTB = HALF * BK * 2  , STAGE_BYTES = 8 * HTB, NXCD = 8, WGM = 8;

__host__ __device__ __forceinline__ int lds_byte(int r, int c) { const int st = (r >> 4) * 2 + (c >> 5), rr = r & 15, cc = c & 31, ob = rr * 64 + cc * 2; return st * 1024 + (ob ^ (((ob >> 9) & 1) << 5)); }
__host__ __device__ __forceinline__ void stage_rc(int b, int& R, int& C) { const int st = b / 1024, sb = b % 1024, swz = sb ^ (((sb >> 9) & 1) << 5); R = (st >> 1) * 16 + swz / 64; C = (st & 1) * 32 + (swz % 64) / 2; }
__host__ __device__ __forceinline__ int perm32(int rho) { const int n = rho >> 4, i = rho & 15; return 8 * (i >> 2) + 4 * n + (i & 3); }

struct Unit { int pm, pn; };
struct Gemm { const bf16_t* A; const bf16_t* Bt; int K; };

struct GateOrder {
    int G, c;
    __device__ __forceinline__ bool next(int i, Unit& u) const {
        const int L = i * G + c; if (L >= 1920 + 16) return false;
        if (L >= 1920) { const int j = L - 1920; u.pm = 32 + (j >> 3); u.pn = 60 + (j & 7); return true; }
        const int wgid = (L % NXCD) * 240 + L / NXCD;
        const int w = wgid % 480; u.pm = (wgid / 480) * WGM + (w % WGM); u.pn = w / WGM; return true;
    }
    __device__ __forceinline__ void a_ready(const Unit&) const {}
    __device__ __forceinline__ void done(const Unit&) const {}
};
struct BranchOrder {
    int pm, pn;
    __device__ __forceinline__ bool next(int i, Unit& u) const { if (i >= 3) return false; u.pm = i * 32 + pm; u.pn = i * 8 + pn; return true; }
    __device__ __forceinline__ void a_ready(const Unit&) const {}
    __device__ __forceinline__ void done(const Unit&) const {}
};
struct OneOrder {
    int pm, pn;
    __device__ __forceinline__ bool next(int i, Unit& u) const { if (i >= 1) return false; u.pm = pm; u.pn = pn; return true; }
    __device__ __forceinline__ void a_ready(const Unit&) const {}
    __device__ __forceinline__ void done(const Unit&) const {}
};


typedef int v4i_t __attribute__((ext_vector_type(4)));
#if defined(TS_PHASE) && TS_PHASE >= 100
#define TS_EPI ((TS_PHASE / 100) % 10)
#define TS_BLK (TS_PHASE % 100)
__device__ unsigned g_epi_ticks;
#endif
template <class Epi, class Sched, bool ALIGN_EPI = false, bool SP2 = false, bool FP8 = false>
__device__ __forceinline__ void gemm_phase(PG8_LAS unsigned char* lds, const Gemm g, const Sched& S, const Epi& E) {
    const int tid = opaque_tid(), wid = __builtin_amdgcn_readfirstlane(tid >> 6), lane = tid & 63, wr = wid >> 2, wc = wid & 3, fr = lane & 15, fq = lane >> 4;
    const int K = g.K, nt = FP8 ? K / 128 : K / BK;
    unsigned voffA[2], voffB[2];
#pragma unroll
    for (int i = 0; i < 2; ++i) { int R, C; stage_rc(tid * 16 + i * 8192, R, C); const int Rb = Epi::PERM ? ((R & ~31) + perm32(R & 31)) : R;
        voffA[i] = FP8 ? (unsigned)(R * K + 2 * C) : (unsigned)(R * K + C) * 2u; voffB[i] = FP8 ? (unsigned)(Rb * K + 2 * C) : (unsigned)(Rb * K + C) * 2u; }
    const unsigned kstep = (unsigned)(BK * 2);
    const unsigned hstep = (unsigned)HALF * K * (FP8 ? 1 : 2);
    const unsigned tstep = 2 * hstep;
    const __amdgpu_buffer_rsrc_t rsrc_voffA = __builtin_amdgcn_make_buffer_rsrc((void*)g.A, 0, 0x7fffffff, 0x00020000), rsrc_voffB = __builtin_amdgcn_make_buffer_rsrc((void*)g.Bt, 0, 0x7fffffff, 0x00020000);
    const unsigned ldsw = (unsigned)wid * 1024u;
    const int aoff = lds_byte(wr * 64 + fr, fq * 8), boff = lds_byte(wc * 32 + fr, fq * 8);
#define PG8_SA(b, h) (((b) * 2 + (h)) * HTB)
#define PG8_SB(b, h) ((4 + (b) * 2 + (h)) * HTB)
#define PG8_STAGE(bufoff, gbase, voff) do { const unsigned _so = (unsigned)__builtin_amdgcn_readfirstlane((int)(gbase)); _Pragma("unroll") for (int _i = 0; _i < 2; ++_i) \
        __builtin_amdgcn_raw_ptr_buffer_load_lds(rsrc_##voff, (PG8_LAS unsigned*)(lds + (bufoff) + ldsw + _i * 8192), 16, (int)(voff)[_i], (int)_so, 0, 0); } while (0)
#define PG8_LDA(dst, b, h) do { _Pragma("unroll") for (int m = 0; m < 4; ++m) _Pragma("unroll") for (int k = 0; k < 2; ++k) dst[m][k] = *(const PG8_LAS bf16x8*)(lds + PG8_SA(b, h) + aoff + m * 2048 + k * 1024); } while (0)
#define PG8_LDB(dst, b, h) do { _Pragma("unroll") for (int n = 0; n < 2; ++n) _Pragma("unroll") for (int k = 0; k < 2; ++k) dst[n][k] = *(const PG8_LAS bf16x8*)(lds + PG8_SB(b, h) + boff + n * 2048 + k * 1024); } while (0)
#define PG8_MMA(ai, bj, At, Bt) do { __builtin_amdgcn_s_setprio(1); \
        if constexpr (FP8) { _Pragma("unroll") for (int m = 0; m < 4; ++m) _Pragma("unroll") for (int n = 0; n < 2; ++n) _Pragma("unroll") for (int k = 0; k < 2; ++k) \
            acc[ai][bj][m][n] = __builtin_bit_cast(f32x4, __builtin_amdgcn_mfma_i32_16x16x64_i8(__builtin_bit_cast(v4i_t, Bt[n][k]), __builtin_bit_cast(v4i_t, At[m][k]), __builtin_bit_cast(v4i_t, acc[ai][bj][m][n]), 0, 0, 0)); } \
        else { _Pragma("unroll") for (int m = 0; m < 4; ++m) _Pragma("unroll") for (int n = 0; n < 2; ++n) _Pragma("unroll") for (int k = 0; k < 2; ++k) \
            acc[ai][bj][m][n] = __builtin_amdgcn_mfma_f32_16x16x32_bf16(Bt[n][k], At[m][k], acc[ai][bj][m][n], 0, 0, 0); } \
        __builtin_amdgcn_s_setprio(0); } while (0)
#define PG8_WAIT_V(n) asm volatile("s_waitcnt vmcnt(" #n ")" ::: "memory")
#define PG8_WAIT_V1() do { if constexpr (Epi::EPI_STORES >= 16) { if (t == 0 && ui > 0) PG8_WAIT_V(24); else PG8_WAIT_V(8); } else PG8_WAIT_V(8); } while (0)
#define PG8_WAIT_L(n) asm volatile("s_waitcnt lgkmcnt(" #n ")" ::: "memory")
#define PG8_BAR __builtin_amdgcn_s_barrier()
#define PG8_SCHED __builtin_amdgcn_sched_barrier(0)
    Unit cur, nxt; int ui = 0;
#ifdef TS_EPI
    unsigned epi_ticks_ = 0;
#endif
    typename Epi::HookState xh{};
    if (!S.next(0, cur)) return;
    f32x4 acc[2][2][4][2];
#pragma unroll
    for (int a = 0; a < 2; ++a)
#pragma unroll
        for (int b = 0; b < 2; ++b)
#pragma unroll
            for (int m = 0; m < 4; ++m)
#pragma unroll
                for (int n = 0; n < 2; ++n) acc[a][b][m][n] = (f32x4){0.f, 0.f, 0.f, 0.f};
    bf16x8 At[4][2], B0[2][2], B1[2][2];
    unsigned cA = (unsigned)cur.pm * tstep, cB = (unsigned)cur.pn * tstep;
    S.a_ready(cur);
    if constexpr (SP2) {
        PG8_STAGE(PG8_SB(0, 0), cB, voffB); PG8_STAGE(PG8_SB(0, 1), cB + hstep, voffB); PG8_STAGE(PG8_SA(0, 0), cA, voffA); PG8_STAGE(PG8_SA(0, 1), cA + hstep, voffA);
        if (wr == 1) PG8_BAR;
        PG8_WAIT_V(2); PG8_BAR;
        PG8_STAGE(PG8_SB(1, 0), cB + kstep, voffB); PG8_STAGE(PG8_SA(1, 0), cA + kstep, voffA); PG8_STAGE(PG8_SB(1, 1), cB + hstep + kstep, voffB);
        PG8_WAIT_V(6); PG8_BAR;
    } else {
        PG8_STAGE(PG8_SB(0, 0), cB, voffB); PG8_STAGE(PG8_SA(0, 0), cA, voffA); PG8_STAGE(PG8_SB(0, 1), cB + hstep, voffB); PG8_STAGE(PG8_SA(0, 1), cA + hstep, voffA);
        if (wr == 1) PG8_BAR;
        PG8_WAIT_V(4); PG8_BAR;
        PG8_STAGE(PG8_SB(1, 0), cB + kstep, voffB); PG8_STAGE(PG8_SA(1, 0), cA + kstep, voffA); PG8_STAGE(PG8_SB(1, 1), cB + hstep + kstep, voffB);
        PG8_WAIT_V(6); PG8_BAR;
    }
    for (;;) {
        const bool has_next = S.next(ui + 1, nxt);
        const unsigned nA = has_next ? (unsigned)nxt.pm * tstep : cA, nB = has_next ? (unsigned)nxt.pn * tstep : cB;
        for (int t = 0; t < nt; t += 2) {
            const bool last = (t == nt - 2);
            const unsigned a1 = cA + (unsigned)(t + 1) * kstep;
            const unsigned a2 = last ? nA : cA + (unsigned)(t + 2) * kstep, b2 = last ? nB : cB + (unsigned)(t + 2) * kstep;
            const unsigned a3 = a2 + kstep, b3 = b2 + kstep;
            if (last && has_next) S.a_ready(nxt);
            if constexpr (SP2) {
            PG8_LDB(B0, 0, 0); PG8_LDB(B1, 0, 1); PG8_SCHED; PG8_LDA(At, 0, 0); PG8_STAGE(PG8_SA(1, 1), a1 + hstep, voffA);
            PG8_WAIT_V1(); PG8_WAIT_L(0); PG8_BAR; PG8_MMA(0, 0, At, B0); PG8_MMA(0, 1, At, B1); PG8_BAR; PG8_SCHED;
            PG8_LDA(At, 0, 1); PG8_STAGE(PG8_SB(0, 0), b2, voffB); PG8_STAGE(PG8_SB(0, 1), b2 + hstep, voffB); PG8_STAGE(PG8_SA(0, 0), a2, voffA);
            PG8_WAIT_V1(); PG8_WAIT_L(0); PG8_BAR; PG8_MMA(1, 0, At, B0); PG8_MMA(1, 1, At, B1); PG8_BAR; PG8_SCHED;
            PG8_LDB(B0, 1, 0); PG8_LDB(B1, 1, 1); PG8_SCHED; PG8_LDA(At, 1, 0); PG8_STAGE(PG8_SA(0, 1), a2 + hstep, voffA);
            PG8_WAIT_V(8); PG8_WAIT_L(0); PG8_BAR; PG8_MMA(0, 0, At, B0); PG8_MMA(0, 1, At, B1); PG8_BAR; PG8_SCHED;
            PG8_LDA(At, 1, 1); PG8_STAGE(PG8_SB(1, 0), b3, voffB); PG8_STAGE(PG8_SB(1, 1), b3 + hstep, voffB); PG8_STAGE(PG8_SA(1, 0), a3, voffA);
            PG8_WAIT_V(8); PG8_WAIT_L(0); PG8_BAR; PG8_MMA(1, 0, At, B0); PG8_MMA(1, 1, At, B1); PG8_BAR; PG8_SCHED;
            } else {
            PG8_LDB(B0, 0, 0); PG8_SCHED; PG8_LDA(At, 0, 0); PG8_STAGE(PG8_SA(1, 1), a1 + hstep, voffA);
            PG8_WAIT_L(8); PG8_BAR; PG8_WAIT_L(0); PG8_MMA(0, 0, At, B0); PG8_BAR; PG8_SCHED;
            PG8_LDB(B1, 0, 1); PG8_STAGE(PG8_SB(0, 0), b2, voffB);
            PG8_BAR; PG8_WAIT_L(0); PG8_MMA(0, 1, At, B1); PG8_BAR;
            PG8_LDA(At, 0, 1); PG8_STAGE(PG8_SA(0, 0), a2, voffA);
            PG8_BAR; PG8_WAIT_L(0); PG8_MMA(1, 0, At, B0); PG8_BAR; PG8_SCHED;
            PG8_STAGE(PG8_SB(0, 1), b2 + hstep, voffB);
            PG8_WAIT_V(6); PG8_BAR; PG8_MMA(1, 1, At, B1); PG8_BAR;
            PG8_LDB(B0, 1, 0); PG8_SCHED; PG8_LDA(At, 1, 0); PG8_STAGE(PG8_SA(0, 1), a2 + hstep, voffA);
            PG8_WAIT_L(8); PG8_BAR; PG8_WAIT_L(0); PG8_MMA(0, 0, At, B0); PG8_BAR; PG8_SCHED;
            PG8_LDB(B1, 1, 1); PG8_STAGE(PG8_SB(1, 0), b3, voffB);
            PG8_BAR; PG8_WAIT_L(0); PG8_MMA(0, 1, At, B1); PG8_BAR;
            PG8_LDA(At, 1, 1); PG8_STAGE(PG8_SA(1, 0), a3, voffA);
            PG8_BAR; PG8_WAIT_L(0); PG8_MMA(1, 0, At, B0); PG8_BAR; PG8_SCHED;
            PG8_STAGE(PG8_SB(1, 1), b3 + hstep, voffB);
            PG8_WAIT_V(6); PG8_BAR; PG8_MMA(1, 1, At, B1); PG8_BAR;
            }
            if constexpr (Epi::IN_LOOP) E.in_loop(acc, t, cur, wr, wc, fr, fq, xh);
        }
        if constexpr (ALIGN_EPI) { if (wr == 0) PG8_BAR; }
        bool zacc = true;
#ifdef TS_EPI
        const unsigned long long te0_ = __builtin_amdgcn_s_memrealtime();
#endif
        if constexpr (!Epi::AFTER_DRAIN) { zacc = E(acc, cur, wr, wc, fr, fq); S.done(cur); }
#ifdef TS_EPI
        epi_ticks_ += (unsigned)(__builtin_amdgcn_s_memrealtime() - te0_);
#endif
        if (!has_next) break;
        if (zacc) {
#pragma unroll
        for (int a = 0; a < 2; ++a)
#pragma unroll
            for (int b = 0; b < 2; ++b)
#pragma unroll
                for (int m = 0; m < 4; ++m)
#pragma unroll
                    for (int n = 0; n < 2; ++n) acc[a][b][m][n] = (f32x4){0.f, 0.f, 0.f, 0.f};
        }
        cur = nxt; cA = nA; cB = nB; ++ui;
        if constexpr (ALIGN_EPI) { if (wr == 1) PG8_BAR; }
    }
#ifdef TS_EPI
    if (Epi::TS_ID == TS_EPI && (int)blockIdx.x == TS_BLK && tid == 0) __hip_atomic_store(&g_epi_ticks, epi_ticks_, RLX_AGENT);
#endif
    PG8_WAIT_V(0);
    if constexpr (!ALIGN_EPI) { if (wr == 0) PG8_BAR; }
    PG8_BAR;
    if constexpr (Epi::AFTER_DRAIN) { if constexpr (Epi::IN_LOOP) E.fused(acc, cur, wr, wc, fr, fq, lds, wid, lane, xh); else E.fused(acc, cur, wr, wc, fr, fq, lds, wid, lane); S.done(cur); }
#undef PG8_SA
#undef PG8_SB
#undef PG8_STAGE
#undef PG8_LDA
#undef PG8_LDB
#undef PG8_MMA
#undef PG8_WAIT_V
#undef PG8_WAIT_L
#undef PG8_BAR
#undef PG8_SCHED
}

constexpr float LOG2E = 1.4426950408889634f;
template <int MODE> __device__ __forceinline__ float act_gate(float x) {
    constexpr float KG = -2.0f * 0.7978845608028654f * LOG2E;
    if constexpr (MODE == 1) return __builtin_amdgcn_rcpf(__builtin_fmaf(__builtin_amdgcn_exp2f(x * -LOG2E), 1.0f / 255.0f, 1.0f / 255.0f));
    if constexpr (MODE == 3) return __builtin_amdgcn_rcpf(__builtin_fmaf(__builtin_amdgcn_exp2f(x), 1.0f / 255.0f, 1.0f / 255.0f));
    const float t = MODE == 0 ? x * -LOG2E : x * (KG + (KG * 0.044715f) * (x * x));
    return x * __builtin_amdgcn_rcpf(1.0f + __builtin_amdgcn_exp2f(t));
}
struct NoHook {};
struct EpiGate {
    static constexpr int TS_ID = 1, EPI_STORES = 16;
    static constexpr bool PERM = true, AFTER_DRAIN = false, IN_LOOP = false; typedef NoHook HookState;
    template <bool STATS> __device__ __forceinline__ void act_store(const f32x4 (&acc)[2][2][4][2], bf16_t* base, int ldc, int row0, int col0, float* vsl, int fq) const {
#pragma unroll
        for (int ai = 0; ai < 2; ++ai)
#pragma unroll
            for (int m = 0; m < 4; ++m) { bf16_t* rowp = base + (size_t)(row0 + ai * HALF + m * 16) * ldc + col0; float rs = 0.f, rq = 0.f;
#pragma unroll
                for (int bj = 0; bj < 2; ++bj) { f32x4 v0 = acc[ai][bj][m][0], v1 = acc[ai][bj][m][1];
#pragma unroll
                    for (int j = 0; j < 4; ++j) { v0[j] = act_gate<2>(v0[j]); v1[j] = act_gate<2>(v1[j]); }
                    if (STATS) {
#pragma unroll
                        for (int j = 0; j < 4; ++j) { rs += v0[j] + v1[j]; rq += v0[j] * v0[j] + v1[j] * v1[j]; } }
                    u32x4 w; w.x = cvt_pk_bf16(v0[0], v0[1]); w.y = cvt_pk_bf16(v0[2], v0[3]); w.z = cvt_pk_bf16(v1[0], v1[1]); w.w = cvt_pk_bf16(v1[2], v1[3]);
                    *(u32x4*)(rowp + bj * HALF) = w; }
                if (STATS) { rs = sum_xor32(sum_xor16(rs)); rq = sum_xor32(sum_xor16(rq));
                    if (fq == 0) *(f32x2v*)(vsl + (size_t)(ai * HALF + m * 16) * 32) = (f32x2v){rs, rq}; } }
    }
    bf16_t* gates; bf16_t* act; bf16_t* memk; float* kmean; float* vst;
    __device__ __forceinline__ bool operator()(f32x4 (&acc)[2][2][4][2], const Unit& u, int wr, int wc, int fr, int fq) const {
        asm volatile("" : "+v"(fr), "+v"(fq));
        const int tq = u.pn, ct = tq; const bool ism = tq >= 60;
        const float ds = ((ct >= 8 && ct < 12) || (ct >= 16 && ct < 24) || tq >= 64) ? 1.0f / (QX * QWB) : 1.0f / (QX * QW);
        const float dsx = (!ism && ct >= 36) ? -LOG2E / (QX * QW) : ds;
#pragma unroll
        for (int ai = 0; ai < 2; ++ai)
#pragma unroll
            for (int bj = 0; bj < 2; ++bj)
#pragma unroll
                for (int m = 0; m < 4; ++m)
#pragma unroll
                    for (int n = 0; n < 2; ++n)
                    { const v4i_t iv = __builtin_bit_cast(v4i_t, acc[ai][bj][m][n]);
                      acc[ai][bj][m][n] = (f32x4){(float)iv[0] * dsx, (float)iv[1] * dsx, (float)iv[2] * dsx, (float)iv[3] * dsx}; }
        if (!ism && (ct >> 2) == A_UG) { act_store<false>(acc, act + (size_t)A_UG * ACT_STRIDE, W, u.pm * BM + wr * 64 + fr, (ct & 3) * 256 + wc * 32 + 8 * fq, nullptr, fq); return true; }
        if (!ism && (ct >> 2) == A_VG) { const int row0 = u.pm * BM + wr * 64 + fr;
            act_store<true>(acc, act + (size_t)A_VG * ACT_STRIDE, W, row0, (ct & 3) * 256 + wc * 32 + 8 * fq, vst + ((size_t)row0 * 16 + (ct & 3) * 4 + wc) * 2, fq); return true; }
        if (ism || ct < 36) { const int j = tq - 60, seg = ct >> 2; const bool sil = !ism && (seg == A_ZA || seg == A_ZG || seg == A_ZC);
            bf16_t* base = ism ? memk + (size_t)(j >> 2) * ((size_t)MM * W) : act + (size_t)seg * ACT_STRIDE; const int row0 = (ism ? (u.pm - 32) * BM : u.pm * BM) + wr * 64 + fr, col0 = ((ism ? j : ct) & 3) * 256 + wc * 32 + 8 * fq;
#pragma unroll
            for (int ai = 0; ai < 2; ++ai)
#pragma unroll
                for (int m = 0; m < 4; ++m) { bf16_t* rowp = base + (size_t)(row0 + ai * HALF + m * 16) * W + col0;
#pragma unroll
                    for (int bj = 0; bj < 2; ++bj) { f32x4 v0 = acc[ai][bj][m][0], v1 = acc[ai][bj][m][1];
                        if (sil) {
#pragma unroll
                            for (int jj = 0; jj < 4; ++jj) { v0[jj] = act_gate<0>(v0[jj]); v1[jj] = act_gate<0>(v1[jj]); } }
                        u32x4 w; w.x = cvt_pk_bf16(v0[0], v0[1]); w.y = cvt_pk_bf16(v0[2], v0[3]); w.z = cvt_pk_bf16(v1[0], v1[1]); w.w = cvt_pk_bf16(v1[2], v1[3]);
                        *(u32x4*)(rowp + bj * HALF) = w; } }
            if (!ism && seg == A_KA) {
                float* kp = kmean + (size_t)wr * KM_SLOT + (size_t)u.pm * W + col0;
#pragma unroll
                for (int bj = 0; bj < 2; ++bj)
#pragma unroll
                    for (int n = 0; n < 2; ++n) { f32x4 sv;
#pragma unroll
                        for (int j2 = 0; j2 < 4; ++j2) { float s = 0.f;
#pragma unroll
                            for (int ai = 0; ai < 2; ++ai)
#pragma unroll
                                for (int m = 0; m < 4; ++m) s += acc[ai][bj][m][n][j2];
                            s += __shfl_xor(s, 1); s += __shfl_xor(s, 2); s += __shfl_xor(s, 4); s += __shfl_xor(s, 8); sv[j2] = s * (1.0f / 256.0f); }
                        if (fr == 0) *(f32x4*)(kp + bj * HALF + 4 * n) = sv; } }
            return true; }
        const int g = ct - 36, br = g >> 3, pnl = g & 7;
        unsigned char* gb = (unsigned char*)gates + ((((size_t)(u.pm * 8 + pnl) * 3 + br) * 8 + (wr * 4 + wc)) * 16) * 512 + (fq * 16 + fr) * 8;
#pragma unroll
        for (int ai = 0; ai < 2; ++ai)
#pragma unroll
            for (int m = 0; m < 4; ++m)
#pragma unroll
                for (int bj = 0; bj < 2; ++bj) { const f32x4 v0 = acc[ai][bj][m][0], v1 = acc[ai][bj][m][1]; unsigned w0 = 0u, w1 = 0u;
#pragma unroll
                    for (int j = 0; j < 4; ++j) { w0 = __builtin_amdgcn_cvt_pk_u8_f32(act_gate<3>(v0[j]), j, w0); w1 = __builtin_amdgcn_cvt_pk_u8_f32(act_gate<3>(v1[j]), j, w1); }
                    __builtin_nontemporal_store((f32x2v){__builtin_bit_cast(float, w0), __builtin_bit_cast(float, w1)}, (f32x2v*)(gb + ((ai * 4 + m) * 2 + bj) * 512)); }
        return true;
    }
};
struct EpiBranch {
    static constexpr int TS_ID = 4, EPI_STORES = 0;
    static constexpr bool PERM = true, AFTER_DRAIN = false, IN_LOOP = false; typedef NoHook HookState;
    const bf16_t* gates; bf16_t* merged;
    __device__ __forceinline__ bool operator()(f32x4 (&acc)[2][2][4][2], const Unit& u, int wr, int wc, int fr, int fq) const {
        const int br = u.pm >> 5, pm = u.pm & 31, pn = u.pn & 7;
        const int row0 = pm * BM + wr * 64 + fr, col0 = pn * BM + wc * 32 + 8 * fq;
        const unsigned char* gp = (const unsigned char*)gates + ((((size_t)(pm * 8 + pn) * 3 + br) * 8 + (wr * 4 + wc)) * 16) * 512 + (fq * 16 + fr) * 8;
        const unsigned char* gq = gp + (br < 2 ? 8 * 16 * 512 : 0);
#define BYTE_F(w, e) ((float)((((e) < 4 ? (w).x : (w).y) >> (8 * ((e) & 3))) & 0xffu))
        v2u ga[2][4], gb[2][4];
#pragma unroll
        for (int s = 0; s < 4; ++s) { ga[0][s] = __builtin_nontemporal_load((const v2u*)(gp + s * 512)); gb[0][s] = __builtin_nontemporal_load((const v2u*)(gq + s * 512)); }
#pragma unroll
        for (int q = 0; q < 4; ++q) { const int cb = q & 1, nb = cb ^ 1;
            if (q < 3) {
#pragma unroll
                for (int s = 0; s < 4; ++s) { ga[nb][s] = __builtin_nontemporal_load((const v2u*)(gp + ((q + 1) * 4 + s) * 512)); gb[nb][s] = __builtin_nontemporal_load((const v2u*)(gq + ((q + 1) * 4 + s) * 512)); } }
#pragma unroll
            for (int s = 0; s < 4; ++s) asm volatile("" : "+v"(ga[cb][s]), "+v"(gb[cb][s]));
            if (br < 2) {
#pragma unroll
                for (int s = 0; s < 4; ++s) { const int sl = q * 4 + s, ai = sl >> 3, m = (sl >> 1) & 3, bj = sl & 1; float g[8];
#pragma unroll
                    for (int e_ = 0; e_ < 8; ++e_) g[e_] = fmaxf(BYTE_F(ga[cb][s], e_), 0.5f) * __builtin_amdgcn_rcpf(fmaxf(BYTE_F(gb[cb][s], e_), 0.5f));
#pragma unroll
                    for (int j = 0; j < 4; ++j) { acc[ai][bj][m][0][j] *= g[j]; acc[ai][bj][m][1][j] *= g[4 + j]; } }
            } else {
#pragma unroll
                for (int s = 0; s < 4; ++s) { const int sl = q * 4 + s, ai = sl >> 3, m = (sl >> 1) & 3, bj = sl & 1, row = row0 + ai * HALF + m * 16; float g[8];
#pragma unroll
                    for (int e_ = 0; e_ < 8; ++e_) g[e_] = fmaxf(BYTE_F(ga[cb][s], e_), 0.5f) * (1.0f / 255.0f);
                    f32x4 v0 = acc[ai][bj][m][0], v1 = acc[ai][bj][m][1];
#pragma unroll
                    for (int j = 0; j < 4; ++j) { v0[j] *= g[j]; v1[j] *= g[4 + j]; }
                    *(v2u*)((unsigned char*)merged + (size_t)row * DM + col0 + bj * HALF) = (v2u){pk4_i8(v0[0], v0[1], v0[2], v0[3], QM), pk4_i8(v1[0], v1[1], v1[2], v1[3], QM)}; } }
        }
#undef BYTE_F
        return br == 2;
    }
};
struct EpiOutLN {
    static constexpr int TS_ID = 5, EPI_STORES = 0;
    static constexpr bool PERM = false, AFTER_DRAIN = true, IN_LOOP = false; typedef NoHook HookState;
    const float* x; float* out; const float* lng; const float* lnb; float* lns; XcdBarrier bar;
    __device__ __forceinline__ void fused(f32x4 (&acc)[2][2][4][2], const Unit& u, int wr, int wc, int fr, int fq, PG8_LAS unsigned char* lds, int wid, int lane) const {
        PG8_LAS f32x2v* P = (PG8_LAS f32x2v*)lds;
        PG8_LAS f32x2v* S = (PG8_LAS f32x2v*)(lds + 8192);
        const int col0 = u.pn * BM + wc * 32 + 4 * fq;
        { constexpr float ds = 1.0f / (QM * QWB);
#pragma unroll
          for (int ai = 0; ai < 2; ++ai)
#pragma unroll
              for (int bj = 0; bj < 2; ++bj)
#pragma unroll
                  for (int m = 0; m < 4; ++m)
#pragma unroll
                      for (int n = 0; n < 2; ++n) { const v4i_t iv = __builtin_bit_cast(v4i_t, acc[ai][bj][m][n]); acc[ai][bj][m][n] = (f32x4){(float)iv[0] * ds, (float)iv[1] * ds, (float)iv[2] * ds, (float)iv[3] * ds}; } }
#pragma unroll
        for (int ai = 0; ai < 2; ++ai) { f32x4 xv[4][2][2];
#pragma unroll
            for (int m = 0; m < 4; ++m) { const size_t off = (size_t)(u.pm * BM + ai * HALF + wr * 64 + m * 16 + fr) * DM + col0;
#pragma unroll
                for (int bj = 0; bj < 2; ++bj)
#pragma unroll
                    for (int n = 0; n < 2; ++n) xv[m][bj][n] = __builtin_nontemporal_load((const f32x4*)(x + off + bj * HALF + n * 16)); }
#pragma unroll
            for (int m = 0; m < 4; ++m)
#pragma unroll
                for (int bj = 0; bj < 2; ++bj)
#pragma unroll
                    for (int n = 0; n < 2; ++n) acc[ai][bj][m][n] = acc[ai][bj][m][n] + xv[m][bj][n] * DN_ALPHA;
#pragma unroll
            for (int m = 0; m < 4; ++m) asm volatile("" : "+v"(acc[ai][0][m][0]), "+v"(acc[ai][0][m][1]), "+v"(acc[ai][1][m][0]), "+v"(acc[ai][1][m][1]));
            asm volatile("" ::: "memory"); }
#pragma unroll
        for (int ai = 0; ai < 2; ++ai)
#pragma unroll
            for (int m = 0; m < 4; ++m) {
                float s = 0.f;
#pragma unroll
                for (int bj = 0; bj < 2; ++bj)
#pragma unroll
                    for (int n = 0; n < 2; ++n) { const f32x4 v = acc[ai][bj][m][n]; s += (v[0] + v[1]) + (v[2] + v[3]); }
                s = sum_xor32(sum_xor16(s));
                const float mw = s * (1.0f / 64.0f); float q = 0.f;
#pragma unroll
                for (int bj = 0; bj < 2; ++bj)
#pragma unroll
                    for (int n = 0; n < 2; ++n) { const f32x4 d = acc[ai][bj][m][n] - mw; q += (d[0] * d[0] + d[1] * d[1]) + (d[2] * d[2] + d[3] * d[3]); }
                q = sum_xor32(sum_xor16(q));
                if (fq == 0) P[(ai * HALF + wr * 64 + m * 16 + fr) * 4 + wc] = (f32x2v){mw, q};
            }
        asm volatile("s_waitcnt lgkmcnt(0)" ::: "memory"); __builtin_amdgcn_s_barrier(); asm volatile("" ::: "memory");
        const int row = wid * 32 + (lane & 31);
        if (lane < 32) {
            const f32x2v a = P[row * 4 + 0], b = P[row * 4 + 1], c = P[row * 4 + 2], d = P[row * 4 + 3];
            const float mt = (a.x + b.x + c.x + d.x) * 0.25f;
            const float da = a.x - mt, db = b.x - mt, dc = c.x - mt, dd = d.x - mt;
            const float m2 = (a.y + b.y) + (c.y + d.y) + 64.0f * ((da * da + db * db) + (dc * dc + dd * dd));
            *(f32x2v*)(lns + ((size_t)(u.pm * BM + row) * 8 + u.pn) * 2) = (f32x2v){mt, m2};
        }
        xcd_barrier(bar);
        if (lane < 32) {
            const f32x4* sp = (const f32x4*)(lns + (size_t)(u.pm * BM + row) * 16); float mt[8], m2[8];
#pragma unroll
            for (int t = 0; t < 4; ++t) { const f32x4 w = sp[t]; mt[2 * t] = w[0]; m2[2 * t] = w[1]; mt[2 * t + 1] = w[2]; m2[2 * t + 1] = w[3]; }
            float ms = 0.f;
#pragma unroll
            for (int t = 0; t < 8; ++t) ms += mt[t];
            const float mean = ms * 0.125f; float q = 0.f;
#pragma unroll
            for (int t = 0; t < 8; ++t) { const float dm = mt[t] - mean; q += m2[t] + 256.0f * dm * dm; }
            S[row] = (f32x2v){mean, 1.0f / sqrtf(q * (1.0f / DM) + LN_EPS)};
        }
        asm volatile("s_waitcnt lgkmcnt(0)" ::: "memory"); __builtin_amdgcn_s_barrier(); asm volatile("" ::: "memory");
        f32x4 gv[2][2], bv[2][2];
#pragma unroll
        for (int bj = 0; bj < 2; ++bj)
#pragma unroll
            for (int n = 0; n < 2; ++n) { gv[bj][n] = *(const f32x4*)(lng + col0 + bj * HALF + n * 16); bv[bj][n] = *(const f32x4*)(lnb + col0 + bj * HALF + n * 16); }
#pragma unroll
        for (int ai = 0; ai < 2; ++ai)
#pragma unroll
            for (int m = 0; m < 4; ++m) { const int r = ai * HALF + wr * 64 + m * 16 + fr; const f32x2v sr = S[r]; const size_t off = (size_t)(u.pm * BM + r) * DM + col0;
#pragma unroll
                for (int bj = 0; bj < 2; ++bj)
#pragma unroll
                    for (int n = 0; n < 2; ++n) { const f32x4 o = (acc[ai][bj][m][n] - sr.x) * sr.y * gv[bj][n] + bv[bj][n]; __builtin_nontemporal_store(o, (f32x4*)(out + off + bj * HALF + n * 16)); } }
    }
};
}


namespace moba {
constexpr int D = 128, PITCH = W, NW = 8, QBLK = 32, KVBLK = 64, QB = NW * QBLK;
constexpr int SHM_V = KVBLK * D * 2, SHM_K = KVBLK * D * 2;
constexpr int LDS_NEED = 2 * SHM_V + 2 * SHM_K + NW * 64 * 4;
constexpr float SCALE = 0.08838834764831845f, THR = 8.f;
typedef short s16x4 __attribute__((ext_vector_type(4)));
typedef float f32x16 __attribute__((ext_vector_type(16)));
typedef unsigned u32x4 __attribute__((ext_vector_type(4)));
#define KSWZ(row, colB) ((row) * 256 + ((colB) ^ (((row) & 7) << 4)))
#define SBAR() __builtin_amdgcn_sched_barrier(0)
__device__ __forceinline__ int v_st(int k, int c) { const int kk = (k & ~0xC) | ((k & 4) << 1) | ((k & 8) >> 1); return ((kk >> 3) * 4 + (c >> 5)) * 512 + ((kk & 7) * 32 + (c & 31)) * 2; }
__device__ __forceinline__ int v_rd_base(int lane) { return ((lane & 3) << 3) | (((lane >> 2) & 3) << 6) | (((lane >> 4) & 1) << 5) | (((lane >> 5) & 1) << 8); }
constexpr int v_rd_off(int d0, int ks, int half) { return d0 * 512 + ks * 4096 + half * 2048; }
__device__ __forceinline__ int crow(int r, int hi) { return (r & 3) + 8 * (r >> 2) + 4 * hi; }
__device__ __forceinline__ bf16x8 pack8(f32x4 a, f32x4 b) { u32x4 w = {cvt_pk_bf16(a[0], a[1]), cvt_pk_bf16(a[2], a[3]), cvt_pk_bf16(b[0], b[1]), cvt_pk_bf16(b[2], b[3])}; return *reinterpret_cast<bf16x8*>(&w); }
__device__ __forceinline__ bf16x8 load8(const bf16* p) { return *reinterpret_cast<const bf16x8*>(p); }
__device__ __forceinline__ void mask_causal(f32x16& p0, f32x16& p1, int dq) {
    const float NEG = -__builtin_inff();
#pragma unroll
    for (int r = 0; r < 16; ++r) { const int c = (r & 3) + 8 * (r >> 2); if (dq - c < 0) p0[r] = NEG; if (dq - c - 32 < 0) p1[r] = NEG; }
}
__device__ __forceinline__ void mask_row(f32x16& p0, f32x16& p1, bool keep) {
    const float NEG = -__builtin_inff();
#pragma unroll
    for (int r = 0; r < 16; ++r) { p0[r] = keep ? p0[r] : NEG; p1[r] = keep ? p1[r] : NEG; }
}
__device__ __forceinline__ void partialSM(f32x16& p0, f32x16& p1, float& m_reg, float& mn, float& alpha) {
    float pmax = p0[0]; for (int r = 1; r < 16; ++r) pmax = fmaxf(pmax, p0[r]); for (int r = 0; r < 16; ++r) pmax = fmaxf(pmax, p1[r]);
    { auto rr = __builtin_amdgcn_permlane32_swap(__float_as_uint(pmax), __float_as_uint(pmax), false, false);
      pmax = fmaxf(__uint_as_float(rr[0]), __uint_as_float(rr[1])); }
    constexpr float C2 = 1.4426950408889634f * SCALE;
    if (__builtin_expect(__all((pmax - m_reg) * SCALE <= THR), 1)) { mn = m_reg; alpha = 1.f; }
    else { mn = fmaxf(m_reg, pmax); alpha = __builtin_amdgcn_exp2f((m_reg - mn) * C2); m_reg = mn; }
    const float mnL = -mn * C2;
    for (int r = 0; r < 16; ++r) p0[r] = fmaf(p0[r], C2, mnL); for (int r = 0; r < 16; ++r) p1[r] = fmaf(p1[r], C2, mnL);
    for (int r = 0; r < 16; ++r) p0[r] = __builtin_amdgcn_exp2f(p0[r]);
}
__device__ __forceinline__ void finishSM(f32x16& p0, f32x16& p1, float alpha, float& l_reg, bf16x8& pa0, bf16x8& pa1, bf16x8& pa2, bf16x8& pa3) {
    for (int r = 0; r < 16; ++r) p1[r] = __builtin_amdgcn_exp2f(p1[r]);
    float ps = 0; for (int r = 0; r < 16; ++r) ps += p0[r]; for (int r = 0; r < 16; ++r) ps += p1[r];
    { auto rr = __builtin_amdgcn_permlane32_swap(__float_as_uint(ps), __float_as_uint(ps), false, false);
      ps = __uint_as_float(rr[0]) + __uint_as_float(rr[1]); }
    l_reg = l_reg * alpha + ps;
#define PK4(P, B_, OUT) do { unsigned a0 = cvt_pk_bf16(P[B_+0], P[B_+1]), a1 = cvt_pk_bf16(P[B_+2], P[B_+3]);                          \
        unsigned b0 = cvt_pk_bf16(P[B_+4], P[B_+5]), b1 = cvt_pk_bf16(P[B_+6], P[B_+7]);                                             \
        auto r0 = __builtin_amdgcn_permlane32_swap(a0, b0, false, false); auto r1 = __builtin_amdgcn_permlane32_swap(a1, b1, false, false); \
        u32x4 w = {r0[0], r1[0], r0[1], r1[1]}; OUT = *reinterpret_cast<bf16x8*>(&w); } while (0)
    PK4(p0, 0, pa0); PK4(p0, 8, pa1); PK4(p1, 0, pa2); PK4(p1, 8, pa3);
#undef PK4
}
template <int KB>
__device__ __forceinline__ void qkt(f32x16& p0, f32x16& p1, const char* K_lds, int r32, int hi, const bf16x8* qr) {
    p0 = f32x16{}; p1 = f32x16{};
    const char* kb[4];
#pragma unroll
    for (int dd = 0; dd < 4; ++dd) kb[dd] = K_lds + KB * SHM_K + KSWZ(r32, (dd * 16 + hi * 8) * 2);
#pragma unroll
    for (int d0 = 0; d0 < 8; ++d0) { const char* a = kb[d0 & 3] + (d0 >> 2) * 128;
        bf16x8 b0 = *reinterpret_cast<const bf16x8*>(a);
        bf16x8 b1 = *reinterpret_cast<const bf16x8*>(a + 32 * 256);
        p0 = __builtin_amdgcn_mfma_f32_32x32x16_bf16(b0, qr[d0], p0, 0, 0, 0);
        p1 = __builtin_amdgcn_mfma_f32_32x32x16_bf16(b1, qr[d0], p1, 0, 0, 0); }
}
#define MOBA_TRRD(dst, off) asm volatile("ds_read_b64_tr_b16 %0, %1 offset:%2" : "=&v"(dst) : "v"(vb0), "i"(off) : "memory")
#define MOBA_PV_D0(d0) do { s16x4 l0, l1, l2, l3, h0, h1, h2, h3; constexpr int b_ = VB * SHM_V + v_rd_off(d0, 0, 0);     \
        MOBA_TRRD(l0, b_); MOBA_TRRD(h0, b_ + 2048); MOBA_TRRD(l1, b_ + 4096); MOBA_TRRD(h1, b_ + 6144); MOBA_TRRD(l2, b_ + 8192); MOBA_TRRD(h2, b_ + 10240); MOBA_TRRD(l3, b_ + 12288); MOBA_TRRD(h3, b_ + 14336); \
        asm volatile("s_waitcnt lgkmcnt(0)" ::: "memory"); SBAR();                 \
        o[d0] = __builtin_amdgcn_mfma_f32_32x32x16_bf16(pa0, (bf16x8){l0[0], l0[1], l0[2], l0[3], h0[0], h0[1], h0[2], h0[3]}, o[d0], 0, 0, 0);   \
        o[d0] = __builtin_amdgcn_mfma_f32_32x32x16_bf16(pa1, (bf16x8){l1[0], l1[1], l1[2], l1[3], h1[0], h1[1], h1[2], h1[3]}, o[d0], 0, 0, 0);   \
        o[d0] = __builtin_amdgcn_mfma_f32_32x32x16_bf16(pa2, (bf16x8){l2[0], l2[1], l2[2], l2[3], h2[0], h2[1], h2[2], h2[3]}, o[d0], 0, 0, 0);   \
        o[d0] = __builtin_amdgcn_mfma_f32_32x32x16_bf16(pa3, (bf16x8){l3[0], l3[1], l3[2], l3[3], h3[0], h3[1], h3[2], h3[3]}, o[d0], 0, 0, 0); } while (0)
template <int VB>
__device__ __forceinline__ void pv_tile(f32x16* o, int vb0, bf16x8 pa0, bf16x8 pa1, bf16x8 pa2, bf16x8 pa3) {
    MOBA_PV_D0(0); MOBA_PV_D0(1); MOBA_PV_D0(2); MOBA_PV_D0(3);
}

#define VMW() asm volatile("s_waitcnt vmcnt(0)" ::: "memory")
#if defined(TS_PHASE) && TS_PHASE >= 90 && TS_PHASE <= 95
__device__ unsigned long long g_gacc[4];
#define GT0() const unsigned long long gt0_ = __builtin_amdgcn_s_memtime()
#define GT1() const unsigned long long gt1_ = __builtin_amdgcn_s_memtime()
#define GT2() do { const unsigned long long gt2_ = __builtin_amdgcn_s_memtime(); if (blockIdx.x == 0 && tid == 0) { g_gacc[0] += gt1_ - gt0_; g_gacc[1] += gt2_ - gt1_; g_gacc[2] += 1; } } while (0)
#else
#define GT0() do {} while (0)
#define GT1() do {} while (0)
#define GT2() do {} while (0)
#endif
constexpr int SCR = 133120;
constexpr int SCR_WAVE = SCR, SCR_ROWTAB = SCR + 2048, SCR_CURSOR = SCR + 3072, SCR_U0 = SCR + 3076, SCR_P = SCR + 3136, SCR_N = SCR + 4224, SCR_DUMP = SCR + 5376  ;
__device__ __forceinline__ bf16* po_slot(unsigned char* ws, int s) { return (bf16*)(ws + (s == 3 ? WS_PO : WS_POS + (size_t)s * (ACT_STRIDE * 2))); }

struct KVRegs { bf16x8 sk[4][2], sv[4][2]; };
__device__ __forceinline__ void kv_issue(KVRegs& R, const bf16* Kb, const bf16* Vb, int tid) {
    const int sr = tid >> 4, sc = (tid & 15) * 8;
#pragma unroll
    for (int t = 0; t < 4; ++t) { R.sk[t][0] = load8(Kb + (size_t)(t * 64 + sr) * PITCH + sc); R.sk[t][1] = load8(Kb + (size_t)(t * 64 + 32 + sr) * PITCH + sc);
                                  R.sv[t][0] = load8(Vb + (size_t)(t * 64 + sr) * PITCH + sc); R.sv[t][1] = load8(Vb + (size_t)(t * 64 + 32 + sr) * PITCH + sc); }
}
__device__ __forceinline__ void kv_write(const KVRegs& R, char* V_lds, char* K_lds, int tid) {
    const int sr = tid >> 4, sc = (tid & 15) * 8, kws = KSWZ(sr, sc * 2), vst0 = v_st(sr, sc), vst1 = v_st(32 + sr, sc);
#pragma unroll
    for (int t = 0; t < 4; ++t) { *(bf16x8*)(K_lds + t * SHM_K + kws) = R.sk[t][0]; *(bf16x8*)(K_lds + t * SHM_K + kws + 32 * 256) = R.sk[t][1];
                                  *(bf16x8*)(V_lds + t * SHM_V + vst0) = R.sv[t][0]; *(bf16x8*)(V_lds + t * SHM_V + vst1) = R.sv[t][1]; }
}

template <bool OWN, class LastQ>
__device__ __forceinline__ void attn_tiles(const bf16x8* qr, const char* K_lds, int vb0, int NT, int qlo, int qm, int r32, int hi, float* al_l, f32x16* o, float& m_reg, float& l_reg, LastQ&& last_q) {
#define RESC(a) do { if (__any((a) < 1.f)) { if (hi == 0) al_l[r32] = (a); asm volatile("s_waitcnt lgkmcnt(0)" ::: "memory");              \
                     for (int d_ = 0; d_ < 4; ++d_) for (int r = 0; r < 16; ++r) o[d_][r] *= al_l[crow(r, hi)]; } } while (0)
#define GMASK(P0_, P1_, t) do { if (OWN && (t) * KVBLK + KVBLK - 1 > qlo) mask_causal(P0_, P1_, qm - (t) * KVBLK); } while (0)
    f32x16 pA0, pA1, pB0, pB1; float mnA, mnB, alA, alB; bf16x8 pa0, pa1, pa2, pa3;
    qkt<0>(pA0, pA1, K_lds, r32, hi, qr); if (NT == 1) { SBAR(); last_q(); SBAR(); }
    GMASK(pA0, pA1, 0); partialSM(pA0, pA1, m_reg, mnA, alA);
    if (NT > 1) { SBAR(); qkt<1>(pB0, pB1, K_lds, r32, hi, qr); if (NT == 2) { SBAR(); last_q(); SBAR(); } }
    finishSM(pA0, pA1, alA, l_reg, pa0, pa1, pa2, pa3); SBAR(); pv_tile<0>(o, vb0, pa0, pa1, pa2, pa3);
    if (NT > 1) {
        GMASK(pB0, pB1, 1); partialSM(pB0, pB1, m_reg, mnB, alB); RESC(alB);
        if (NT > 2) { SBAR(); qkt<2>(pA0, pA1, K_lds, r32, hi, qr); if (NT == 3) { SBAR(); last_q(); SBAR(); } }
        finishSM(pB0, pB1, alB, l_reg, pa0, pa1, pa2, pa3); SBAR(); pv_tile<1>(o, vb0, pa0, pa1, pa2, pa3);
        if (NT > 2) {
            GMASK(pA0, pA1, 2); partialSM(pA0, pA1, m_reg, mnA, alA); RESC(alA);
            if (NT > 3) { SBAR(); qkt<3>(pB0, pB1, K_lds, r32, hi, qr); SBAR(); last_q(); SBAR(); }
            finishSM(pA0, pA1, alA, l_reg, pa0, pa1, pa2, pa3); SBAR(); pv_tile<2>(o, vb0, pa0, pa1, pa2, pa3);
            if (NT > 3) { GMASK(pB0, pB1, 3); partialSM(pB0, pB1, m_reg, mnB, alB); RESC(alB);
                finishSM(pB0, pB1, alB, l_reg, pa0, pa1, pa2, pa3); SBAR(); pv_tile<3>(o, vb0, pa0, pa1, pa2, pa3); } } }
#undef RESC
#undef GMASK
}
constexpr int STG = 147456;
__device__ __forceinline__ void attn_store(unsigned char* ws, size_t rb, int h, int ent, const f32x16* o, float m_reg, float l_reg, float* li_l, int* rowtab, char* stg, int r32, int hi) {
    if (hi == 0) { li_l[r32] = l_reg; rowtab[r32] = ent;
        if (ent >= 0) *(f32x2v*)((float*)(ws + WS_ML4) + ((size_t)(ent >> 12) * M + rb + (ent & 4095)) * (2 * AH) + h * 2) = (f32x2v){m_reg, l_reg}; }
    asm volatile("s_waitcnt lgkmcnt(0)" ::: "memory");
    float rl[16];
#pragma unroll
    for (int r = 0; r < 16; ++r) rl[r] = li_l[crow(r, hi)];
    const int lane = r32 + 32 * hi, r16 = (lane >> 2) & 15, ch = lane & 3;
    const int e0 = rowtab[r16], e1 = rowtab[16 + r16];
#pragma unroll
    for (int r = 0; r < 16; ++r) rl[r] = rl[r] > 0.f ? __builtin_amdgcn_rcpf(rl[r]) : 0.f;
    const bool odd = (r32 & 1) != 0;
    char* wr = stg + (odd ? 1024 : 0) + (r32 & ~1) * 2;
    const char* rd = stg + r16 * 64 + ch * 16;
#pragma unroll
    for (int hf = 0; hf < 2; ++hf) { const int e = hf ? e1 : e0;
        bf16* dst = po_slot(ws, (e >= 0 ? e : 0) >> 12) + (rb + (size_t)((e >= 0 ? e : 0) & 4095)) * W + h * AD + ch * 8;
#pragma unroll
        for (int pp = 0; pp < 2; ++pp) {
#pragma unroll
            for (int r8 = 0; r8 < 8; ++r8) { const int r = hf * 8 + r8; const float va = o[2 * pp][r] * rl[r], vb = o[2 * pp + 1][r] * rl[r];
                const float x = odd ? va : vb;
                const float y = __builtin_bit_cast(float, __builtin_amdgcn_update_dpp(0, __builtin_bit_cast(int, x), 0xB1  , 0xF, 0xF, true));
                const unsigned pk = cvt_pk_bf16(odd ? y : va, odd ? vb : y);
                *(unsigned*)(wr + (crow(r, hi) - 16 * hf) * 64) = pk; }
            const v4u q0 = *(const v4u*)rd, q1 = *(const v4u*)(rd + 1024);
            if (e >= 0) { __builtin_nontemporal_store(q0, (v4u*)(dst + (2 * pp) * 32)); __builtin_nontemporal_store(q1, (v4u*)(dst + (2 * pp + 1) * 32)); } } }
}

constexpr int KM_ROW = 272;
constexpr int SCR_CW = SCR_P, SCR_PRE = SCR_N, SCR_BASE = SCR_N + 512;
template <class Arrive> __device__ __forceinline__ void select_own(unsigned char* ws, char* lds, gu32* cnt, int bh, int j, Arrive&& arrive) {
    const int tid = opaque_tid(), wid = __builtin_amdgcn_readfirstlane(tid >> 6), lane = tid & 63, r32 = lane & 31, hi = lane >> 5;
    const int b = bh >> 3, h = bh & 7; const size_t rb = (size_t)b * SEQ;
    const bf16* act = (const bf16*)(ws + WS_ACT);
    const bf16* Q = act + A_QA * ACT_STRIDE + (rb + (size_t)j * MBLK) * W + h * AD;
    const float* KM = (const float*)(ws + WS_KMEAN) + (size_t)(b * NBLK) * W + h * AD;
    char* V_lds = lds; char* K_lds = lds + 4 * SHM_V; char* KMH = lds; char* KML = lds + 16 * KM_ROW;
    const f32x4 km0 = *(const f32x4*)(KM + (size_t)(tid >> 5) * W + (tid & 31) * 4), km1 = *(const f32x4*)(KM + KM_SLOT + (size_t)(tid >> 5) * W + (tid & 31) * 4);
    bf16x8 qr[8];
#pragma unroll
    for (int d0 = 0; d0 < 8; ++d0) qr[d0] = load8(Q + (size_t)(wid * QBLK + r32) * PITCH + d0 * 16 + hi * 8);
    KVRegs R; kv_issue(R, act + A_KA * ACT_STRIDE + (rb + (size_t)j * MBLK) * W + h * AD, act + A_VA * ACT_STRIDE + (rb + (size_t)j * MBLK) * W + h * AD, tid);
    { const f32x4 a = km0 + km1; const unsigned h01 = cvt_pk_bf16(a[0], a[1]), h23 = cvt_pk_bf16(a[2], a[3]);
      const unsigned l01 = cvt_pk_bf16(a[0] - bflo(h01), a[1] - bfhi(h01)), l23 = cvt_pk_bf16(a[2] - bflo(h23), a[3] - bfhi(h23));
      const int o_ = (tid >> 5) * KM_ROW + (tid & 31) * 8; *(v2u*)(KMH + o_) = (v2u){h01, h23}; *(v2u*)(KML + o_) = (v2u){l01, l23}; }
    __syncthreads();
    unsigned sel = 0u;
    if (j > 0) {
        f32x16 sc_ = f32x16{};
        const char* ka = KMH + (r32 & 15) * KM_ROW + hi * 16;
#pragma unroll
        for (int d0 = 0; d0 < 8; ++d0) { const bf16x8 ah = *(const bf16x8*)(ka + d0 * 32), al = *(const bf16x8*)(ka + 16 * KM_ROW + d0 * 32);
            sc_ = __builtin_amdgcn_mfma_f32_32x32x16_bf16(ah, qr[d0], sc_, 0, 0, 0); sc_ = __builtin_amdgcn_mfma_f32_32x32x16_bf16(al, qr[d0], sc_, 0, 0, 0); }
        float v[16];
#pragma unroll
        for (int n = 0; n < 16; ++n) { const int idx = (n & 3) + 4 * (n >> 3); const float own = sc_[idx], oth = __shfl_xor(own, 32); v[n] = (hi == ((n >> 2) & 1)) ? own : oth; }
#pragma unroll
        for (int k = 0; k < 3; ++k) { float best = -__builtin_inff(); int bi = -1;
#pragma unroll
            for (int n = 0; n < 15; ++n) { const bool ok = n < j && !((sel >> n) & 1u) && (bi < 0 || v[n] > best); if (ok) { best = v[n]; bi = n; } }
            if (bi >= 0) sel |= 1u << bi; }
    }
    const int rowb = j * MBLK + wid * QBLK + r32;
    if (hi == 0) { const int ns = __builtin_popcount(sel); float* ml = (float*)(ws + WS_ML4) + (rb + rowb) * (2 * AH) + h * 2;
#pragma unroll
        for (int s = 0; s < 3; ++s) if (s >= ns) *(f32x2v*)(ml + (size_t)s * M * (2 * AH)) = (f32x2v){-1e30f, 0.f}; }
    int* cw = (int*)(lds + SCR_CW); int* pre = (int*)(lds + SCR_PRE);
#pragma unroll
    for (int k = 0; k < 15; ++k) { const unsigned long long mk = __ballot(hi == 0 && ((sel >> k) & 1u)); if (lane == 0) cw[wid * 16 + k] = __builtin_popcountll(mk); }
    TSP(30);
    __syncthreads();
    VMW(); kv_write(R, V_lds, K_lds, tid);
    if (tid < 16) { int run = 0;
#pragma unroll
        for (int w = 0; w < NW; ++w) { pre[w * 16 + tid] = run; run += cw[w * 16 + tid]; }
        if (tid < j) cnt[(bh * NBLK + tid) * NBLK + j] = (unsigned)run; }
    __syncthreads();
    TSP(31);
    unsigned* lists = (unsigned*)(ws + WS_LIST) + (size_t)(bh * NBLK) * LCAP + j * MBLK;
#pragma unroll
    for (int k = 0; k < 15; ++k) { const bool s = hi == 0 && k < j && ((sel >> k) & 1u); const unsigned long long mk = __ballot(s);
        if (s) lists[(size_t)k * LCAP + pre[wid * 16 + k] + __builtin_popcountll(mk & ((1ull << lane) - 1ull))] = (unsigned)rowb | ((unsigned)__builtin_popcount(sel & ((1u << k) - 1u)) << 12); }
    arrive();
    TSP(32);
    { float* wsc = (float*)(lds + SCR_WAVE) + wid * 64; int* rowtab = (int*)(lds + SCR_ROWTAB) + wid * 32;
      const int vb0 = (int)(uintptr_t)V_lds + v_rd_base(lane), qlo = wid * QBLK, qm = qlo + r32 - 4 * hi, NT = ((qlo + QBLK - 1) >> 6) + 1;
      float m_reg = -1e30f, l_reg = 0; f32x16 o[4] = {};
      attn_tiles<true>(qr, K_lds, vb0, NT, qlo, qm, r32, hi, wsc + 32, o, m_reg, l_reg, [] {});
      attn_store(ws, rb, h, rowb | (3 << 12), o, m_reg, l_reg, wsc, rowtab, lds + STG + wid * 2048, r32, hi); }
    TSP(33);
}

__device__ __forceinline__ void gather_unit(unsigned char* ws, char* lds, const gu32* cnt, int bh, int k, int n, int gb0, int gb1) {
    const int tid = opaque_tid(), wid = __builtin_amdgcn_readfirstlane(tid >> 6), lane = tid & 63, r32 = lane & 31, hi = lane >> 5;
    const int b = bh >> 3, h = bh & 7; const size_t rb = (size_t)b * SEQ;
    const bf16* act = (const bf16*)(ws + WS_ACT);
    const bf16* Qb = act + A_QA * ACT_STRIDE + rb * W + h * AD;
    const unsigned* list = (const unsigned*)(ws + WS_LIST) + (size_t)(bh * NBLK + k) * LCAP;
    char* V_lds = lds; char* K_lds = lds + 4 * SHM_V;
    float* wsc = (float*)(lds + SCR_WAVE) + wid * 64; int* rowtab = (int*)(lds + SCR_ROWTAB) + wid * 32; int* cursor = (int*)(lds + SCR_CURSOR); int* seg = (int*)(lds + SCR_DUMP);
    { KVRegs R; kv_issue(R, act + A_KA * ACT_STRIDE + (rb + (size_t)k * MBLK) * W + h * AD, act + A_VA * ACT_STRIDE + (rb + (size_t)k * MBLK) * W + h * AD, tid);
      int sc_[16];
      if (tid == 0) {
#pragma unroll
          for (int j = 0; j < 16; ++j) sc_[j] = j > k ? (int)__hip_atomic_load(cnt + (bh * NBLK + k) * NBLK + j, RLX_AGENT) : 0; }
      __syncthreads();
      if (tid == 0) { *cursor = 0; int run = 0;
#pragma unroll
          for (int j = 0; j < 16; ++j) { seg[j] = run; run += sc_[j]; }
          seg[16] = run; }
      VMW(); kv_write(R, V_lds, K_lds, tid); }
    __syncthreads();
    const int vb0 = (int)(uintptr_t)V_lds + v_rd_base(lane), n_items = gb1 - gb0;
#define GRAB(dst) do { int g_ = 0; if (lane == 0) g_ = __hip_atomic_fetch_add(cursor, 1, __ATOMIC_RELAXED, __HIP_MEMORY_SCOPE_WORKGROUP); dst = __builtin_amdgcn_readfirstlane(g_); } while (0)
#define ENTRY(dst, it_) do { int ix_ = (gb0 + (it_)) * 32 + r32; if (ix_ >= n) ix_ = (gb0 + (it_)) * 32; int sg_ = 0; \
        _Pragma("unroll") for (int j_ = 1; j_ < 16; ++j_) sg_ += seg[j_] <= ix_ ? 1 : 0;                  \
        dst = list[sg_ * MBLK + ix_ - seg[sg_]]; } while (0)
    int it; GRAB(it);
    if (it >= n_items) return;
    unsigned e; ENTRY(e, it);
    bf16x8 qr[8];
#pragma unroll
    for (int d0 = 0; d0 < 8; ++d0) qr[d0] = load8(Qb + (size_t)(e & 4095u) * PITCH + d0 * 16 + hi * 8);
    for (;;) {
        int it2; GRAB(it2);
        const bool more = it2 < n_items; unsigned e2 = 0u; if (more) ENTRY(e2, it2);
        const int ent = ((gb0 + it) * 32 + r32 < n) ? (int)e : -1;
        float m_reg = -1e30f, l_reg = 0; f32x16 o[4] = {};
        GT0();
        attn_tiles<false>(qr, K_lds, vb0, 4, 0, 0, r32, hi, wsc + 32, o, m_reg, l_reg, [&] { if (more) {
#pragma unroll
            for (int d0 = 0; d0 < 8; ++d0) qr[d0] = load8(Qb + (size_t)(e2 & 4095u) * PITCH + d0 * 16 + hi * 8); } });
        GT1();
        attn_store(ws, rb, h, ent, o, m_reg, l_reg, wsc, rowtab, lds + STG + wid * 2048, r32, hi);
        GT2();
        if (!more) break;
        it = it2; e = e2;
    }
#undef GRAB
#undef ENTRY
}
#undef VMW
}


namespace mix {
#if defined(TS_PHASE) && TS_PHASE >= 110 && TS_PHASE <= 119
__device__ unsigned long long g_mt[8];
#define MT(i) do { if (blockIdx.x == 0 && tid == 0) g_mt[i] = __builtin_amdgcn_s_memtime(); } while (0)
#else
#define MT(i) do {} while (0)
#endif
using moba::f32x16; using moba::s16x4; using moba::u32x4; using moba::crow; using moba::v_st; using moba::v_rd_base; using moba::SHM_V;
__device__ __forceinline__ void slab_put(char* slab, float v, int row, int col, int r32) { const float vn = __builtin_bit_cast(float, __builtin_amdgcn_update_dpp(0, __builtin_bit_cast(int, v), 0xB1  , 0xF, 0xF, true)); if ((r32 & 1) == 0) *(unsigned*)(slab + row * 256 + col * 2) = cvt_pk_bf16(v, vn); }
template <bool TWO> __device__ __forceinline__ void slab_mul_store(const char* slab, const bf16* A, const bf16* B, bf16* Y, size_t e0  , int lane) {
    asm volatile("s_waitcnt lgkmcnt(0)" ::: "memory");
#pragma unroll
    for (int h = 0; h < 2; ++h) { v4u a[4], b[4];
#pragma unroll
        for (int i = 0; i < 4; ++i) { const size_t e = e0 + (size_t)((h * 4 + i) * 4 + (lane >> 4)) * W + (lane & 15) * 8; a[i] = *(const v4u*)(A + e); if (TWO) b[i] = *(const v4u*)(B + e); }
#pragma unroll
        for (int i = 0; i < 4; ++i) { const int row = (h * 4 + i) * 4 + (lane >> 4); const v4u sv = *(const v4u*)(slab + row * 256 + (lane & 15) * 16); v4u o;
#pragma unroll
            for (int j = 0; j < 4; ++j) { float lo = bflo(sv[j]) * bflo(a[i][j]), hi = bfhi(sv[j]) * bfhi(a[i][j]); if (TWO) { lo *= bflo(b[i][j]); hi *= bfhi(b[i][j]); } o[j] = cvt_pk_bf16(lo, hi); }
            *(v4u*)(Y + e0 + (size_t)row * W + (lane & 15) * 8) = o; } }
}
template <bool TWO> __device__ __forceinline__ void slab_loads(const bf16* A, const bf16* B, size_t e0, int lane, v4u (&a)[8], v4u (&b)[8]) {
#pragma unroll
    for (int i = 0; i < 8; ++i) { const size_t e = e0 + (size_t)(i * 4 + (lane >> 4)) * W + (lane & 15) * 8; a[i] = __builtin_nontemporal_load((const v4u*)(A + e)); if (TWO) b[i] = __builtin_nontemporal_load((const v4u*)(B + e)); }
}
template <bool TWO> __device__ __forceinline__ void slab_finish(const char* slab, const v4u (&a)[8], const v4u (&b)[8], bf16* Y, size_t e0, int lane) {
    asm volatile("s_waitcnt lgkmcnt(0)" ::: "memory");
#pragma unroll
    for (int i = 0; i < 8; ++i) { const int row = i * 4 + (lane >> 4); const v4u sv = *(const v4u*)(slab + row * 256 + (lane & 15) * 16); v4u o;
#pragma unroll
        for (int j = 0; j < 4; ++j) { float lo = bflo(sv[j]) * bflo(a[i][j]), hi = bfhi(sv[j]) * bfhi(a[i][j]); if (TWO) { lo *= bflo(b[i][j]); hi *= bfhi(b[i][j]); } o[j] = cvt_pk_bf16(lo, hi); }
        *(v4u*)(Y + e0 + (size_t)row * W + (lane & 15) * 8) = o; }
}
__device__ __forceinline__ void sgu_unit(char* lds, unsigned char* ws, const float* b_s, const float* lng, const float* lnb, int b, int c, int gp) {
    const int tid = opaque_tid(), wid = __builtin_amdgcn_readfirstlane(tid >> 6), lane = tid & 63, r32 = lane & 31, hi = lane >> 5, hw = wid >> 2, tb = wid & 3, g = 2 * gp + hw;
    const size_t row0 = (size_t)b * SEQ + (size_t)c * SC;
    const bf16* act = (const bf16*)(ws + WS_ACT); const bf16* UG = act + A_UG * ACT_STRIDE; const bf16* VG = act + A_VG * ACT_STRIDE; const bf16* ZG = act + A_ZG * ACT_STRIDE; bf16* YG = (bf16*)(ws + WS_Y) + ACT_STRIDE;
    const float* vst = (const float*)(ws + WS_VSTATS); const bf16* wsb = (const bf16*)(ws + WS_WSB); const float* c2 = (const float*)(ws + WS_C2);
    char* V_lds = lds + hw * 2 * SHM_V; f32x2v* stab = (f32x2v*)(lds + 132096);
    const int ht = tid & 255; v4u raw[8];
#pragma unroll
    for (int i = 0; i < 8; ++i) { const int idx = ht + 256 * i, s_ = idx >> 4, col = (idx & 15) * 8; raw[i] = *(const v4u*)(VG + (row0 + s_) * W + g * SGD + col); }
    const bf16* wrow = wsb + ((size_t)g * SC + tb * 32 + r32) * SC + hi * 8;
    bf16x8 wa[8];
#pragma unroll
    for (int k = 0; k < 4; ++k) wa[k] = *(const bf16x8*)(wrow + 16 * k);
    if (tb >= 2) {
#pragma unroll
        for (int k = 4; k < 8; ++k) wa[k] = *(const bf16x8*)(wrow + 16 * k); }
    float gm[4], bt[4], cc[16], bb[16];
#pragma unroll
    for (int d0 = 0; d0 < 4; ++d0) { gm[d0] = lng[g * SGD + d0 * 32 + r32]; bt[d0] = lnb[g * SGD + d0 * 32 + r32]; }
#pragma unroll
    for (int r = 0; r < 16; ++r) { cc[r] = 0.f; bb[r] = 0.f; }
    f32x2v* cbt = (f32x2v*)(lds + 133120) + wid * 32;
    const f32x2v cb_mine = (f32x2v){c2[g * SC + tb * 32 + r32], b_s[g * SC + tb * 32 + r32]};
    if (tid < SC) { const f32x4* sp = (const f32x4*)(vst + (row0 + tid) * 32); float s = 0.f, q = 0.f;
#pragma unroll
        for (int j = 0; j < 8; ++j) { const f32x4 w = sp[j]; s += w[0] + w[2]; q += w[1] + w[3]; }
        const float mean = s * (1.0f / W), var = q * (1.0f / W) - mean * mean; stab[tid] = (f32x2v){mean, 1.0f / sqrtf(var + LN_EPS)}; }
    if (hi == 0) cbt[r32] = cb_mine;
    __syncthreads();
#pragma unroll
    for (int r = 0; r < 16; ++r) { const f32x2v cb = cbt[crow(r, hi)]; cc[r] = cb.x; bb[r] = cb.y; }
#pragma unroll
    for (int i = 0; i < 8; ++i) { const int idx = ht + 256 * i, s_ = idx >> 4, col = (idx & 15) * 8; const f32x2v st = stab[s_]; v4u o;
#pragma unroll
        for (int j = 0; j < 4; ++j) o[j] = cvt_pk_bf16((bflo(raw[i][j]) - st.x) * st.y, (bfhi(raw[i][j]) - st.x) * st.y);
        *(v4u*)(V_lds + (s_ >> 6) * SHM_V + v_st(s_ & 63, col)) = o; }
    __syncthreads();
    f32x16 o[4] = {};
    const int vb0 = (int)(uintptr_t)V_lds + v_rd_base(lane);
    v4u ua[8], za[8]; const size_t e0s = (row0 + tb * 32) * W + g * SGD; slab_loads<true>(UG, ZG, e0s, lane, ua, za);
    moba::pv_tile<0>(o, vb0, wa[0], wa[1], wa[2], wa[3]);
    if (tb >= 2) moba::pv_tile<1>(o, vb0, wa[4], wa[5], wa[6], wa[7]);
    char* slab = lds + 4 * SHM_V + wid * 8192;
#pragma unroll
    for (int r = 0; r < 16; ++r) { const int tl = crow(r, hi);
#pragma unroll
        for (int d0 = 0; d0 < 4; ++d0) slab_put(slab, gm[d0] * o[d0][r] + bt[d0] * cc[r] + bb[r], tl, d0 * 32 + r32, r32); }
    slab_finish<true>(slab, ua, za, YG, e0s, lane);
    __syncthreads();
}
__device__ __forceinline__ void mem_unit(char* lds, unsigned char* ws, int b, int h, int qb, int dh) {
    const int tid = opaque_tid(), wid = __builtin_amdgcn_readfirstlane(tid >> 6), lane = tid & 63, r32 = lane & 31, hi = lane >> 5;
    const bf16* act = (const bf16*)(ws + WS_ACT); const bf16* QC = act + A_QC * ACT_STRIDE; const bf16* ZC = act + A_ZC * ACT_STRIDE; bf16* YC = (bf16*)(ws + WS_Y) + 2 * ACT_STRIDE;
    const bf16* MK = (const bf16*)(ws + WS_MEMK) + (size_t)b * NMEM * W + h * MD; const bf16* MV = (const bf16*)(ws + WS_MEMV) + (size_t)b * NMEM * W + h * MD + dh * 128;
    const size_t qrow = (size_t)b * SEQ + (size_t)qb * 256 + wid * 32 + r32;
    MT(0);
    v4u kst[16];
#pragma unroll
    for (int i = 0; i < 16; ++i) { const int idx = tid + 512 * i, key = idx >> 5, ch = idx & 31; kst[i] = *(const v4u*)(MK + (size_t)key * W + ch * 8); }
    bf16x8 qr[16];
#pragma unroll
    for (int d0 = 0; d0 < 16; ++d0) qr[d0] = *(const bf16x8*)(QC + qrow * W + h * MD + d0 * 16 + hi * 8);
#pragma unroll
    for (int i = 0; i < 16; ++i) { const int idx = tid + 512 * i, key = idx >> 5, ch = idx & 31; *(v4u*)(lds + key * 512 + ((ch ^ (key & 7)) << 4)) = kst[i]; }
    __syncthreads();
    MT(1);
    v4u vraw[8];
#pragma unroll
    for (int i = 0; i < 8; ++i) { const int idx = tid + 512 * i, key = idx >> 4, col = (idx & 15) * 8; vraw[i] = *(const v4u*)(MV + (size_t)key * W + col); }
    f32x16 p[8];
#pragma unroll
    for (int kg = 0; kg < 8; ++kg) { p[kg] = f32x16{};
        const char* kb = lds + (kg * 32 + r32) * 512;
#pragma unroll
        for (int d0 = 0; d0 < 16; ++d0) { const bf16x8 kf = *(const bf16x8*)(kb + (((2 * d0 + hi) ^ (r32 & 7)) << 4)); p[kg] = __builtin_amdgcn_mfma_f32_32x32x16_bf16(kf, qr[d0], p[kg], 0, 0, 0); } }
    MT(2);
    constexpr float C2 = 1.4426950408889634f * 0.0625f;
    float mx = p[0][0];
#pragma unroll
    for (int kg = 0; kg < 8; ++kg)
#pragma unroll
        for (int r = 0; r < 16; ++r) mx = fmaxf(mx, p[kg][r]);
    { auto rr = __builtin_amdgcn_permlane32_swap(__float_as_uint(mx), __float_as_uint(mx), false, false); mx = fmaxf(__uint_as_float(rr[0]), __uint_as_float(rr[1])); }
    const float mnl = -mx * C2; float ls = 0.f;
#pragma unroll
    for (int kg = 0; kg < 8; ++kg)
#pragma unroll
        for (int r = 0; r < 16; ++r) { p[kg][r] = __builtin_amdgcn_exp2f(fmaf(p[kg][r], C2, mnl)); ls += p[kg][r]; }
    { auto rr = __builtin_amdgcn_permlane32_swap(__float_as_uint(ls), __float_as_uint(ls), false, false); ls = __uint_as_float(rr[0]) + __uint_as_float(rr[1]); }
    bf16x8 pa[4][4];
#define MIX_PK4(P, B_, OUT) do { unsigned a0 = cvt_pk_bf16(P[B_+0], P[B_+1]), a1 = cvt_pk_bf16(P[B_+2], P[B_+3]);                          \
        unsigned b0 = cvt_pk_bf16(P[B_+4], P[B_+5]), b1 = cvt_pk_bf16(P[B_+6], P[B_+7]);                                             \
        auto r0 = __builtin_amdgcn_permlane32_swap(a0, b0, false, false); auto r1 = __builtin_amdgcn_permlane32_swap(a1, b1, false, false); \
        u32x4 w = {r0[0], r1[0], r0[1], r1[1]}; OUT = *reinterpret_cast<bf16x8*>(&w); } while (0)
#pragma unroll
    for (int t = 0; t < 4; ++t) { MIX_PK4(p[2 * t], 0, pa[t][0]); MIX_PK4(p[2 * t], 8, pa[t][1]); MIX_PK4(p[2 * t + 1], 0, pa[t][2]); MIX_PK4(p[2 * t + 1], 8, pa[t][3]); }
#undef MIX_PK4
    MT(3);
    __syncthreads();
#pragma unroll
    for (int i = 0; i < 8; ++i) { const int idx = tid + 512 * i, key = idx >> 4, col = (idx & 15) * 8; *(v4u*)(lds + (key >> 6) * SHM_V + v_st(key & 63, col)) = vraw[i]; }
    __syncthreads();
    MT(4);
    f32x16 o[4] = {};
    const int vb0 = (int)(uintptr_t)lds + v_rd_base(lane);
    v4u zc[8], zdummy[8]; const size_t e0m = ((size_t)b * SEQ + (size_t)qb * 256 + wid * 32) * W + h * MD + dh * 128; slab_loads<false>(ZC, nullptr, e0m, lane, zc, zdummy);
    moba::pv_tile<0>(o, vb0, pa[0][0], pa[0][1], pa[0][2], pa[0][3]); moba::pv_tile<1>(o, vb0, pa[1][0], pa[1][1], pa[1][2], pa[1][3]);
    moba::pv_tile<2>(o, vb0, pa[2][0], pa[2][1], pa[2][2], pa[2][3]); moba::pv_tile<3>(o, vb0, pa[3][0], pa[3][1], pa[3][2], pa[3][3]);
    MT(5);
    const float rl = __builtin_amdgcn_rcpf(ls);
    char* slab = lds + 4 * SHM_V + wid * 8192;
    float rliv[16];
#pragma unroll
    for (int r = 0; r < 16; ++r) rliv[r] = __shfl(rl, crow(r, hi));
#pragma unroll
    for (int r = 0; r < 16; ++r) { const int orow = crow(r, hi);
#pragma unroll
        for (int d0 = 0; d0 < 4; ++d0) slab_put(slab, o[d0][r] * rliv[r], orow, d0 * 32 + r32, r32); }
    MT(6);
    slab_finish<false>(slab, zc, zdummy, YC, e0m, lane);
    __syncthreads();
    MT(7);
}
}


constexpr int NWAVES = 8;
constexpr int RING_BYTES = 131072;
constexpr int LDSCTL_OFF = RING_BYTES, MISC_OFF = LDSCTL_OFF + 320;
constexpr int LDS_BYTES = 163840;
constexpr int CW_TMO = 0, CW_CODE = 1, CW_LCNT = 16384  , CW_BAR = 4096;
constexpr int N_PHASES = 6;

struct Frame {
    LAS unsigned char* lds;
    volatile LAS unsigned* MISC;
    gu32* ctl;
    int vcu, G;
    const float *x, *mem, *w_in, *w_mk, *w_mv, *w_s, *b_s, *lnvg, *lnvb, *wba, *wbg, *wbm, *w_out, *ln_g, *ln_b; float* out;
    unsigned char* ws;
};

__device__ __forceinline__ float wave_sum(float v) {
#pragma unroll
    for (int o = 1; o < 64; o <<= 1) v += __shfl_xor(v, o);
    return v;
}
template <bool DEEP = false> __device__ __forceinline__ void p0_transpose_item(const float* Wm, int K, int N, bf16* WT, int row_off, LAS float* scr, int item, int lane) {
    const int nblk = N / 32, kb = item / nblk, nb = item % nblk, k0 = 64 * kb, n0 = 32 * nb;
    if (DEEP) { float t[32];
#pragma unroll
        for (int i = 0; i < 32; ++i) t[i] = __builtin_nontemporal_load(Wm + (size_t)(k0 + 2 * i + (lane >> 5)) * N + n0 + (lane & 31));
#pragma unroll
        for (int i = 0; i < 32; ++i) scr[(2 * i + (lane >> 5)) * 33 + (lane & 31)] = t[i]; }
    else {
#pragma unroll 8
    for (int i = 0; i < 32; ++i) { const int kk = 2 * i + (lane >> 5); scr[kk * 33 + (lane & 31)] = Wm[(size_t)(k0 + kk) * N + n0 + (lane & 31)]; } }
    LDS_WAIT(); asm volatile("" ::: "memory");
    const int c = lane & 7;
#pragma unroll
    for (int j = 0; j < 4; ++j) { const int n = (lane >> 3) + 8 * j; const LAS float* s = scr + (8 * c) * 33 + n;
        v4u o; o.x = pk2(s[0 * 33], s[1 * 33]); o.y = pk2(s[2 * 33], s[3 * 33]); o.z = pk2(s[4 * 33], s[5 * 33]); o.w = pk2(s[6 * 33], s[7 * 33]);
        *(GAS v4u*)(WT + (size_t)(row_off + n0 + n) * K + k0 + 8 * c) = o; }
    LDS_WAIT(); asm volatile("" ::: "memory");
}
__device__ __forceinline__ void p0_transpose_item_q8(const float* Wm, int K, int N, int col_off, int ncols, float sc, unsigned char* WT, LAS float* scr, int item, int lane) {
    const int nblk = ncols / 32, kb = item / nblk, nb = item % nblk, k0 = 64 * kb, n0 = 32 * nb;
    { f32x4 t[8];
#pragma unroll
      for (int i = 0; i < 8; ++i) t[i] = __builtin_nontemporal_load((const f32x4*)(Wm + (size_t)(k0 + 8 * i + (lane >> 3)) * N + col_off + n0 + 4 * (lane & 7)));
#pragma unroll
      for (int i = 0; i < 8; ++i)
#pragma unroll
          for (int j = 0; j < 4; ++j) scr[(8 * i + (lane >> 3)) * 33 + 4 * (lane & 7) + j] = t[i][j]; }
    LDS_WAIT(); asm volatile("" ::: "memory");
    const int n = lane >> 1, kh = (lane & 1) * 32; const LAS float* s = scr + kh * 33 + n; v4u o[2];
#pragma unroll
    for (int q = 0; q < 8; ++q) o[q >> 2][q & 3] = pk4_i8(s[(4 * q) * 33], s[(4 * q + 1) * 33], s[(4 * q + 2) * 33], s[(4 * q + 3) * 33], sc);
    GAS v4u* dst = (GAS v4u*)(WT + (size_t)(n0 + n) * K + k0 + kh); dst[0] = o[0]; dst[1] = o[1];
    LDS_WAIT(); asm volatile("" ::: "memory");
}
__device__ __forceinline__ void p0_prologue(Frame& F) {
    const int tid_ = opaque_tid(), lane = tid_ & 63, wave = __builtin_amdgcn_readfirstlane(tid_ >> 6);
    LAS float* scr = (LAS float*)(F.lds + wave * 16384);
    const int gw = F.vcu * NWAVES + wave, NGW = F.G * NWAVES;
    constexpr int I_GQ = (DM / 64) * (NPROJ / 32), I_MK = (DM / 64) * (W / 32);
    constexpr int NITEMS = I_GQ + 2 * I_MK;
    for (int it = gw; it < NITEMS; it += NGW) {
        int r = it;
        if (r < I_GQ) { const int nb = r % (NPROJ / 32); const bool beta = (nb >= 64 && nb < 96) || (nb >= 128 && nb < 192);
            p0_transpose_item_q8(F.w_in, DM, NPROJ, 0, NPROJ, beta ? QWB : QW, F.ws + WS_WQ, scr, r, lane); continue; } r -= I_GQ;
        if (r < I_MK) { p0_transpose_item_q8(F.w_mk, DM, W, 0, W, QW, F.ws + WS_WQ + (size_t)NPROJ * DM, scr, r, lane); continue; } r -= I_MK;
        p0_transpose_item_q8(F.w_mv, DM, W, 0, W, QWB, F.ws + WS_WQ + (size_t)(NPROJ + W) * DM, scr, r, lane);
    }
    { GAS v2u* xq = (GAS v2u*)(F.ws + WS_XQ); const GAS f32x4* xs = (const GAS f32x4*)F.x;
      for (int i = gw; i < (M * DM) / 512; i += NGW) { const size_t ch = (size_t)i * 64 + lane; const f32x4 a = __builtin_nontemporal_load(xs + 2 * ch), b = __builtin_nontemporal_load(xs + 2 * ch + 1);
          xq[ch] = (v2u){pk4_i8(a[0], a[1], a[2], a[3], QX), pk4_i8(b[0], b[1], b[2], b[3], QX)}; }
      GAS v2u* mq = (GAS v2u*)(F.ws + WS_MQ); const GAS f32x4* ms = (const GAS f32x4*)F.mem;
      for (int i = gw; i < (MM * DM) / 512; i += NGW) { const size_t ch = (size_t)i * 64 + lane; const f32x4 a = ms[2 * ch], b = ms[2 * ch + 1];
          mq[ch] = (v2u){pk4_i8(a[0], a[1], a[2], a[3], QX), pk4_i8(b[0], b[1], b[2], b[3], QX)}; } }
    { bf16* wsb = (bf16*)(F.ws + WS_WSB); float* c2 = (float*)(F.ws + WS_C2);
      for (int row = gw; row < SG * SC; row += NGW) { const int t = row % SC; float s = 0.f;
#pragma unroll
          for (int h = 0; h < 2; ++h) { const int sidx = lane + 64 * h; const float w = sidx <= t ? F.w_s[(size_t)row * SC + sidx] : 0.f; const unsigned short wb = (unsigned short)f2bf(w); wsb[(size_t)row * SC + sidx] = wb; s += bf2f(wb); }
          s = wave_sum(s); if (lane == 0) c2[row] = s; } }
}

__device__ __forceinline__ void p0_late(Frame& F, int me, int nw) {
    const int tid_ = opaque_tid(), lane = tid_ & 63, wave = __builtin_amdgcn_readfirstlane(tid_ >> 6);
    LAS float* scr = (LAS float*)(F.lds + wave * 16384);
    bf16* WBR = (bf16*)(F.ws + WS_WBR);
    constexpr int I_BR = (W / 64) * (DM / 32), I_OUT = (DM / 64) * (DM / 32);
    for (int it = me * NWAVES + wave; it < 3 * I_BR + I_OUT; it += nw * NWAVES) {
        int r = it;
        if (r < I_BR) { p0_transpose_item<true>(F.wba, W, DM, WBR, 0, scr, r, lane); continue; } r -= I_BR;
        if (r < I_BR) { p0_transpose_item<true>(F.wbg, W, DM, WBR, DM, scr, r, lane); continue; } r -= I_BR;
        if (r < I_BR) { p0_transpose_item<true>(F.wbm, W, DM, WBR, 2 * DM, scr, r, lane); continue; } r -= I_BR;
        p0_transpose_item_q8(F.w_out, DM, DM, 0, DM, QWB, F.ws + WS_WOUT, scr, r, lane);
    }
}
constexpr int CW_COMB = 2, COMB_ROWS = 16;
__device__ __forceinline__ void p3_combine(Frame& F) {
    const int tid_ = opaque_tid(), lane = tid_ & 63, wave = __builtin_amdgcn_readfirstlane(tid_ >> 6);
    const float* ml4 = (const float*)(F.ws + WS_ML4);
    const bf16* za = (const bf16*)(F.ws + WS_ACT) + A_ZA * ACT_STRIDE; bf16* ya = (bf16*)(F.ws + WS_Y);
    constexpr float C2 = 1.4426950408889634f * moba::SCALE;
    volatile LAS int* slot = (volatile LAS int*)(F.lds + moba::SCR_U0);
    if (tid_ == 0) *slot = (int)__hip_atomic_fetch_add(F.ctl + CW_COMB, 1u, RLX_AGENT);
    __syncthreads();
    int c = __builtin_amdgcn_readfirstlane(*slot);
    while (c < M / COMB_ROWS) {
        int nxt = 0; if (tid_ == 0) nxt = (int)__hip_atomic_fetch_add(F.ctl + CW_COMB, 1u, RLX_AGENT);
        const int row = c * COMB_ROWS + wave * 2;
        f32x2v ml[4][4]; v4u p[4][4], z[4]; size_t e[4];
#pragma unroll
        for (int q = 0; q < 4; ++q) { const int r_ = row + (q >> 1), col = (q & 1) * 512 + lane * 8, head = col >> 7; e[q] = (size_t)r_ * W + col;
#pragma unroll
            for (int s = 0; s < 4; ++s) { ml[q][s] = *(const f32x2v*)(ml4 + ((size_t)s * M + r_) * (2 * AH) + head * 2); p[q][s] = __builtin_nontemporal_load((const v4u*)(moba::po_slot(F.ws, s) + e[q])); }
            z[q] = __builtin_nontemporal_load((const v4u*)(za + e[q])); }
#pragma unroll
        for (int q = 0; q < 4; ++q) {
            const float mx = fmaxf(fmaxf(ml[q][0].x, ml[q][1].x), fmaxf(ml[q][2].x, ml[q][3].x)); float w[4], ws_ = 0.f;
#pragma unroll
            for (int s = 0; s < 4; ++s) { w[s] = ml[q][s].y * __builtin_amdgcn_exp2f((ml[q][s].x - mx) * C2); ws_ += w[s]; }
            const float inv = 1.0f / ws_; v4u o;
#pragma unroll
            for (int j = 0; j < 4; ++j) { float lo = 0.f, hi = 0.f;
#pragma unroll
                for (int s = 0; s < 4; ++s) { const unsigned pw = ml[q][s].y > 0.f ? p[q][s][j] : 0u; const float f = w[s] * inv; lo += f * bflo(pw); hi += f * bfhi(pw); }
                o[j] = cvt_pk_bf16(lo * bflo(z[q][j]), hi * bfhi(z[q][j])); }
            *(v4u*)(ya + e[q]) = o; }
        __syncthreads();
        if (tid_ == 0) *slot = nxt;
        __syncthreads();
        c = __builtin_amdgcn_readfirstlane(*slot);
    }
}

struct Args { const float* in[15]; float* out; unsigned char* ws; int ph_lo, ph_hi, li, pad; };
__global__ void __launch_bounds__(NWAVES * 64, 2) mk_fwd(Args args) {
    extern __shared__ __attribute__((aligned(16))) unsigned char lds[];
    Frame F;
    F.lds = (LAS unsigned char*)lds;
    F.MISC = (volatile LAS unsigned*)(F.lds + MISC_OFF);
    F.G = gridDim.x; { const int bx = blockIdx.x; F.vcu = (F.G % 8 == 0) ? (bx % 8) * (F.G / 8) + bx / 8 : bx; }
    F.ws = args.ws; F.ctl = (gu32*)(args.ws + WS_CTL);
    F.x = args.in[0]; F.mem = args.in[1]; F.w_in = args.in[2]; F.w_mk = args.in[3]; F.w_mv = args.in[4]; F.w_s = args.in[5]; F.b_s = args.in[6]; F.lnvg = args.in[7]; F.lnvb = args.in[8];
    F.wba = args.in[9]; F.wbg = args.in[10]; F.wbm = args.in[11]; F.w_out = args.in[12]; F.ln_g = args.in[13]; F.ln_b = args.in[14]; F.out = args.out;
    for (int u = threadIdx.x; u < (LDS_BYTES - LDSCTL_OFF) / 4; u += NWAVES * 64) ((LAS unsigned*)(F.lds + LDSCTL_OFF))[u] = 0u;
    __syncthreads();
    XcdBarrier bar = xcd_barrier_post((unsigned*)(F.ctl + CW_BAR) + args.li * XCD_BAR_WORDS, F.MISC + 8);
    const int lo = args.ph_lo, hi = args.ph_hi;
#ifdef TS_PHASE
    unsigned long long ts_[8], tc_[8]; int nts_ = 0; tc_[nts_] = __builtin_amdgcn_s_memtime(); ts_[nts_++] = __builtin_amdgcn_s_memrealtime();
#define STAMP() do { tc_[nts_] = __builtin_amdgcn_s_memtime(); ts_[nts_++] = __builtin_amdgcn_s_memrealtime(); } while (0)
#else
#define STAMP() do {} while (0)
#endif
#define IN(k) (lo <= (k) && (k) < hi)
#define BOTH(k) (IN(k) && IN((k) + 1))
    unsigned char* ws = args.ws;
    if (IN(0)) { p0_prologue(F); if (BOTH(0)) xcd_barrier(bar); } STAMP();
    if (IN(1)) {
        pg8::Gemm gq{(const bf16*)(ws + WS_XQ), (const bf16*)(ws + WS_WQ), DM}; pg8::GateOrder Sq{F.G, (int)blockIdx.x}; pg8::EpiGate Eq{(bf16*)(ws + WS_GATES), (bf16*)(ws + WS_ACT), (bf16*)(ws + WS_MEMK), (float*)(ws + WS_KMEAN), (float*)(ws + WS_VSTATS)};
        pg8::gemm_phase<pg8::EpiGate, pg8::GateOrder, true, true, true>(F.lds, gq, Sq, Eq);
        { const int first_idle = (1920 + 16) - 7 * F.G; if (F.G == 256 && (int)blockIdx.x >= first_idle) p0_late(F, (int)blockIdx.x - first_idle, F.G - first_idle); else if (F.G != 256) p0_late(F, (int)blockIdx.x, F.G); }
        if (BOTH(1)) xcd_barrier(bar);
    } STAMP();
    if (IN(2)) {
        if (F.G == 256) { const int v = F.vcu; gu32* lcnt = F.ctl + CW_LCNT;
            moba::select_own(ws, (char*)lds, lcnt, v >> 4, v & 15, [&] { xcd_barrier_arrive(bar); });
            xcd_barrier_wait(bar);
#if defined(TS_PHASE) && TS_PHASE == 12
            STAMP();
#endif
            constexpr int UC0 = 32;
            int* P = (int*)((char*)lds + moba::SCR_P); int* Nn = (int*)((char*)lds + moba::SCR_N); int* u0p = (int*)((char*)lds + moba::SCR_U0);
            const int tid = opaque_tid();
            if (tid < 64) { int c[4], n4[4], s = 0;
#pragma unroll
                for (int i = 0; i < 4; ++i) { const int u_ = tid * 4 + i, k_ = u_ & 15; int s_ = 0;
#pragma unroll
                    for (int j_ = 1; j_ < 16; ++j_) { const int c_ = (int)__hip_atomic_load(lcnt + u_ * 16 + j_, RLX_AGENT); s_ += j_ > k_ ? c_ : 0; }
                    n4[i] = s_; const int nb_ = (n4[i] + 31) >> 5; c[i] = n4[i] > 0 ? UC0 + 4 * nb_ : 0; s += c[i]; }
                int inc = s;
#pragma unroll
                for (int o = 1; o < 64; o <<= 1) { const int t = __shfl_up(inc, o); if (tid >= o) inc += t; }
                int ex = inc - s;
#pragma unroll
                for (int i = 0; i < 4; ++i) { P[tid * 4 + i] = ex; Nn[tid * 4 + i] = n4[i]; ex += c[i]; }
                if (tid == 63) P[256] = ex; }
            __syncthreads();
            const int C = __builtin_amdgcn_readfirstlane(P[256]), lo = (int)(((long long)C * v) >> 8), hi = (int)(((long long)C * (v + 1)) >> 8);
            int* u1p = (int*)((char*)lds + moba::SCR_CURSOR);
            if (tid == 0) *u1p = 256;
            __syncthreads();
            if (tid < 256 && P[tid] <= lo && lo < P[tid + 1]) *u0p = tid;
            if (tid < 256 && P[tid] <= hi && hi < P[tid + 1]) *u1p = tid;
            __syncthreads();
#if defined(TS_PHASE) && TS_PHASE == 13
            STAMP();
#endif
            const int ua = __builtin_amdgcn_readfirstlane(*u0p), ub = __builtin_amdgcn_readfirstlane(*u1p);
            auto cut = [&](int x, int u) -> int {
                const int pu = __builtin_amdgcn_readfirstlane(P[u]), nb = (__builtin_amdgcn_readfirstlane(Nn[u]) + 31) >> 5;
                int i = (x - pu - UC0 + 3) >> 2; i = i < 0 ? 0 : (i > nb ? nb : i);
                const int r = i & 7; i = r < 4 ? i - r : i - r + 8; return i > nb ? nb : i; };
            const int ia = cut(lo, ua), ib = ub < 256 ? cut(hi, ub) : 0;
            __syncthreads();
            for (int u = ua; u < 256 && u <= ub; ++u) {
                const int n = __builtin_amdgcn_readfirstlane(Nn[u]), nb = (n + 31) >> 5;
                const int i0 = u == ua ? ia : 0, i1 = u == ub ? ib : nb;
                if (i0 < i1) moba::gather_unit(ws, (char*)lds, lcnt, u >> 4, u & 15, n, i0, i1); }
#if defined(TS_PHASE) && TS_PHASE == 14
            STAMP();
#endif
#if defined(TS_PHASE) && (TS_PHASE == 61 || TS_PHASE == 62 || TS_PHASE == 63)
            if (threadIdx.x == 0) ((unsigned long long*)(ws + WS_CTL + 8192))[v] = __builtin_amdgcn_s_memrealtime();
#endif
        }
        if (BOTH(2)) xcd_barrier_arrive(bar);
    } STAMP();
    if (IN(3)) {
        if (F.G == 256) { const int v = F.vcu;
            mix::mem_unit((char*)lds, ws, v >> 7, (v >> 5) & 3, (v >> 1) & 15, v & 1);
#if defined(TS_PHASE) && TS_PHASE == 10
            STAMP();
#endif
            mix::sgu_unit((char*)lds, ws, F.b_s, F.lnvg, F.lnvb, v >> 7, (v >> 2) & 31, v & 3); }
#if defined(TS_PHASE) && TS_PHASE == 11
        STAMP();
#endif
        if (BOTH(2)) xcd_barrier_wait(bar);
#if defined(TS_PHASE) && (TS_PHASE >= 64 && TS_PHASE <= 69)
        if (threadIdx.x == 0 && (TS_PHASE == 64 || TS_PHASE == 65)) ((unsigned long long*)(ws + WS_CTL + 8192))[F.vcu] = __builtin_amdgcn_s_memrealtime();
#endif
        p3_combine(F);
#if defined(TS_PHASE) && (TS_PHASE >= 64 && TS_PHASE <= 69)
        if (threadIdx.x == 0 && (TS_PHASE == 66 || TS_PHASE == 67)) ((unsigned long long*)(ws + WS_CTL + 8192))[F.vcu] = __builtin_amdgcn_s_memrealtime();
#endif
        if (BOTH(3)) xcd_barrier(bar);
    } STAMP();
    const int tile = F.vcu;
    if (IN(4)) {
        pg8::Gemm g{(const bf16*)(ws + WS_Y), (const bf16*)(ws + WS_WBR), W}; pg8::BranchOrder S{tile >> 3, tile & 7};
        pg8::EpiBranch E{(const bf16*)(ws + WS_GATES), (bf16*)(ws + WS_MERGED)};
        if (F.G == 256) {
            pg8::gemm_phase<pg8::EpiBranch, pg8::BranchOrder, true, true>(F.lds, g, S, E); }
        if (BOTH(4)) xcd_barrier(bar);
    } STAMP();
    if (IN(5)) {
        pg8::Gemm g{(const bf16*)(ws + WS_MERGED), (const bf16*)(ws + WS_WOUT), DM}; pg8::OneOrder S{tile >> 3, tile & 7};
        pg8::EpiOutLN E{F.x, F.out, F.ln_g, F.ln_b, (float*)(ws + WS_LNS), bar};
        if (F.G == 256) pg8::gemm_phase<pg8::EpiOutLN, pg8::OneOrder, false, true, true>(F.lds, g, S, E);
    } STAMP();
#ifdef TS_PHASE
#if TS_PHASE >= 110 && TS_PHASE <= 119
    if (blockIdx.x == 0 && threadIdx.x == 0) { const int i_ = TS_PHASE - 110; F.out[0] += (float)(mix::g_mt[i_ + 1] - mix::g_mt[i_]) * 1e-3f * 0.01f; }
#elif TS_PHASE >= 90 && TS_PHASE <= 95
    if (blockIdx.x == 0 && threadIdx.x == 0) { const float n_ = (float)moba::g_gacc[2]; const float val = TS_PHASE == 90 ? (float)moba::g_gacc[0] / n_ * 1e-3f : TS_PHASE == 91 ? (float)moba::g_gacc[1] / n_ * 1e-3f : n_; F.out[0] += val * 0.01f; }
#elif TS_PHASE >= 64 && TS_PHASE <= 67
    if (blockIdx.x == 0 && threadIdx.x == 0) { const unsigned long long* ft = (const unsigned long long*)(ws + WS_CTL + 8192); unsigned long long mx = 0, mn = ~0ull;
        for (int i = 0; i < 256; ++i) { const unsigned long long t_ = __hip_atomic_load(ft + i, RLX_AGENT); if (t_ > mx) mx = t_; if (t_ < mn) mn = t_; }
        const float val = (TS_PHASE & 1) ? (float)(mn - ts_[2]) * 0.01f : (float)(mx - ts_[2]) * 0.01f; F.out[0] += val * 0.001f; }
#elif TS_PHASE == 81 || TS_PHASE == 84
    if (blockIdx.x == 0 && threadIdx.x == 0) { const int k_ = TS_PHASE - 80; const float us = (float)(ts_[k_ + 1] - ts_[k_]) * 0.01f - (TS_PHASE == 81 ? 200.f : 60.f); F.out[0] += us * 0.01f; }
#elif TS_PHASE == 61 || TS_PHASE == 62 || TS_PHASE == 63
    if (blockIdx.x == 0 && threadIdx.x == 0) { const unsigned long long* ft = (const unsigned long long*)(ws + WS_CTL + 8192); unsigned long long mx = 0, mn = ~0ull; int am = 0;
        for (int i = 0; i < 256; ++i) { const unsigned long long t_ = __hip_atomic_load(ft + i, RLX_AGENT); if (t_ > mx) { mx = t_; am = i; } if (t_ < mn) mn = t_; }
        const float val = TS_PHASE == 61 ? (float)(mx - ts_[2]) * 0.01f : TS_PHASE == 62 ? (float)am : (float)(mn - ts_[2]) * 0.01f; F.out[0] += val * 0.01f; }
#elif TS_PHASE >= 70 && TS_PHASE < 80
    if (blockIdx.x == 0 && threadIdx.x == 0) { const int k_ = TS_PHASE - 70; const float r_ = (float)(tc_[k_ + 1] - tc_[k_]) / (float)(ts_[k_ + 1] - ts_[k_]); F.out[0] += r_ * 0.01f; }
#elif TS_PHASE >= 30 && TS_PHASE < 60
    if (blockIdx.x == 0 && threadIdx.x == 0) { const float us = (float)(g_tsp - ts_[2]) * 0.01f; F.out[0] += us * 0.01f; }
#elif TS_PHASE >= 100
    if (blockIdx.x == 0 && threadIdx.x == 0) { const float us = (float)__hip_atomic_load(&pg8::g_epi_ticks, RLX_AGENT) * 0.01f; F.out[0] += us * 0.01f; }
#else
    if (blockIdx.x == 0 && threadIdx.x == 0) { const int k_ = (TS_PHASE >= 12 && TS_PHASE <= 14) ? 2 : TS_PHASE >= 10 ? 3 : TS_PHASE; const float us = TS_PHASE == 20 ? (float)(ts_[nts_ - 1] - ts_[0]) * 0.001f : (float)(ts_[k_ + 1] - ts_[k_]) * 0.01f; F.out[0] += us * 0.01f; }
#endif
#endif
#undef IN
#undef BOTH
}


extern "C" void kernel_launch(void* const* d_in, const int* in_sizes, int n_in, void* d_out, int out_size, void* d_ws, size_t ws_size, hipStream_t stream) {
    static int grid = 0;
    if (grid == 0) {
        if (n_in != 15 || in_sizes[0] != M * DM || in_sizes[2] != DM * NPROJ || out_size != M * DM || ws_size < WS_END) { fprintf(stderr, "kernel_launch: unexpected shapes (n_in %d, ws %zu); nothing launched\n", n_in, ws_size); grid = -1; return; }
        int dev = 0, cus = 0, per_cu = 0;
        if (hipGetDevice(&dev) != hipSuccess || hipDeviceGetAttribute(&cus, hipDeviceAttributeMultiprocessorCount, dev) != hipSuccess) { grid = -1; return; }
        if (hipFuncSetAttribute((const void*)mk_fwd, hipFuncAttributeMaxDynamicSharedMemorySize, LDS_BYTES) != hipSuccess) { fprintf(stderr, "kernel_launch: hipFuncSetAttribute failed\n"); grid = -1; return; }
        if (hipOccupancyMaxActiveBlocksPerMultiprocessor(&per_cu, (const void*)mk_fwd, NWAVES * 64, LDS_BYTES) != hipSuccess || per_cu < 1) fprintf(stderr, "kernel_launch: occupancy query reports %d workgroups per CU\n", per_cu);
        (void)hipGetLastError();
        grid = cus;
        if (grid != 256) fprintf(stderr, "kernel_launch: %d CUs; the one-tile-per-workgroup phases need 256\n", grid);
    }
    if (grid < 0) return;
    (void)hipMemsetAsync((char*)d_ws + WS_CTL, 0, 65536, stream);
    Args a{};
    for (int i = 0; i < 15; ++i) a.in[i] = (const float*)d_in[i];
    a.out = (float*)d_out; a.ws = (unsigned char*)d_ws;
    a.ph_lo = 0; a.ph_hi = N_PHASES; a.li = 0;
    hipLaunchKernelGGL(mk_fwd, dim3(grid), dim3(NWAVES * 64), LDS_BYTES, stream, a);
    const hipError_t le = hipPeekAtLastError();
    if (le != hipSuccess) fprintf(stderr, "kernel_launch: launch failed: %s\n", hipGetErrorName(le));
}
```

```cpp
#include <hip/hip_runtime.h>
#include <cstdio>
#include <cstdint>


constexpr int DM = 2048, NB = 2, SEQ = 4096, M = NB * SEQ;
constexpr int NMEM = 256, MM = NB * NMEM;
constexpr int W = 1024;
constexpr int NPROJ = 15360;
constexpr int AH = 8, AD = 128, MBLK = 256, NBLK = SEQ / MBLK;
constexpr int SG = 8, SC = 128, SGD = 128;
constexpr int MH = 4, MD = 256;
constexpr float DN_ALPHA = 1.189207115002721f;
constexpr float LN_EPS = 1e-5f;

constexpr size_t MiB = 1u << 20;
constexpr size_t WS_CTL = 0, CTL_ZERO_BYTES = 1 * MiB;
constexpr size_t WS_KMEAN = 1 * MiB;
constexpr size_t WS_C2 = 1 * MiB + 256 * 1024;
constexpr size_t WS_WSB = 1 * MiB + 512 * 1024;
constexpr size_t WS_LNS = 24 * MiB;
constexpr size_t WS_WBR = 2 * MiB;
constexpr size_t WS_WOUT = 14 * MiB;
constexpr size_t WS_VSTATS = 22 * MiB;
constexpr size_t WS_ML = 23 * MiB;
constexpr size_t WS_WIN = 32 * MiB;
constexpr size_t WS_WMKV = 92 * MiB;
constexpr size_t WS_XB = 100 * MiB;
constexpr size_t WS_MEMB = 132 * MiB;
constexpr size_t WS_ACT = 134 * MiB;
constexpr size_t ACT_STRIDE = (size_t)M * W;
constexpr size_t KM_SLOT = (size_t)NB * NBLK * W;
constexpr size_t WS_GATES = 278 * MiB;
constexpr size_t WS_MEMK = 374 * MiB;
constexpr size_t WS_MEMV = 375 * MiB;
constexpr size_t WS_Y = 376 * MiB;
constexpr size_t WS_MERGED = 424 * MiB;
constexpr float QM = 128.f;
constexpr float QX = 32.f, QW = 1024.f, QWB = 2048.f;
constexpr size_t WS_WQ = 68 * MiB;
constexpr size_t WS_XQ = 456 * MiB;
constexpr size_t WS_MQ = 472 * MiB;
constexpr size_t WS_END = 473 * MiB;
constexpr size_t WS_PO = 32 * MiB;
constexpr size_t WS_POS = 326 * MiB;
constexpr size_t WS_ML4 = 26 * MiB;
constexpr size_t WS_LIST = 28 * MiB;
constexpr int LCAP = NBLK * MBLK;
constexpr size_t WS_H = 32 * MiB;
enum { A_QA = 0, A_KA, A_VA, A_ZA, A_UG, A_VG, A_ZG, A_QC, A_ZC };
static_assert(WS_WIN + (size_t)NPROJ * DM * 2 == WS_WMKV && WS_XB + (size_t)M * DM * 2 == WS_MEMB && WS_MEMB + (size_t)MM * DM * 2 == WS_ACT, "virtual concatenations");
static_assert(WS_ACT + 9 * ACT_STRIDE * 2 == WS_GATES && WS_GATES + (size_t)M * 3 * DM * 2 == WS_MEMK && WS_Y + 3 * ACT_STRIDE * 2 == WS_MERGED, "d_ws map");

typedef unsigned short bf16;
__host__ __device__ __forceinline__ unsigned f2bf(float f) { unsigned u = __builtin_bit_cast(unsigned, f); return (u + 0x7fffu + ((u >> 16) & 1u)) >> 16; }
__host__ __device__ __forceinline__ float bf2f(unsigned short h) { return __builtin_bit_cast(float, (unsigned)h << 16); }


#define GAS __attribute__((address_space(1)))
#define LAS __attribute__((address_space(3)))
typedef unsigned v4u __attribute__((ext_vector_type(4)));
typedef unsigned v2u __attribute__((ext_vector_type(2)));
typedef float f32x4 __attribute__((ext_vector_type(4)));
typedef float f32x2v __attribute__((ext_vector_type(2)));
typedef short bf16x8 __attribute__((ext_vector_type(8)));
typedef GAS unsigned gu32;
#define RLX_AGENT __ATOMIC_RELAXED, __HIP_MEMORY_SCOPE_AGENT
#define LDS_WAIT() asm volatile("s_waitcnt lgkmcnt(0)" ::: "memory")
#define VM_WAIT() asm volatile("s_waitcnt vmcnt(0)" ::: "memory")
__device__ __forceinline__ unsigned pk2(float lo, float hi) { return f2bf(lo) | (f2bf(hi) << 16); }
typedef float f32x2_t __attribute__((ext_vector_type(2))); typedef __bf16 bf16x2_t __attribute__((ext_vector_type(2)));
__device__ __forceinline__ unsigned cvt_pk_bf16(float lo, float hi) { f32x2_t v = {lo, hi}; bf16x2_t b = __builtin_convertvector(v, bf16x2_t); return __builtin_bit_cast(unsigned, b); }
__device__ __forceinline__ unsigned q8(float v, float s) { return (unsigned)(int)__builtin_rintf(__builtin_fminf(__builtin_fmaxf(v * s, -127.f), 127.f)) & 0xffu; }
__device__ __forceinline__ unsigned pk4_i8(float a, float b, float c, float d, float s) { return q8(a, s) | (q8(b, s) << 8) | (q8(c, s) << 16) | (q8(d, s) << 24); }
__device__ __forceinline__ float bflo(unsigned w) { return __builtin_bit_cast(float, w << 16); }
__device__ __forceinline__ float bfhi(unsigned w) { return __builtin_bit_cast(float, w & 0xffff0000u); }

__device__ __forceinline__ float sum_xor16(float s) { const unsigned u = __builtin_bit_cast(unsigned, s); unsigned u2 = u; asm volatile("" : "+v"(u2)); auto r = __builtin_amdgcn_permlane16_swap(u, u2, false, false); const unsigned a_ = r[0], b_ = r[1]; return __builtin_bit_cast(float, a_) + __builtin_bit_cast(float, b_); }
__device__ __forceinline__ float sum_xor32(float s) { const unsigned u = __builtin_bit_cast(unsigned, s); unsigned u2 = u; asm volatile("" : "+v"(u2)); auto r = __builtin_amdgcn_permlane32_swap(u, u2, false, false); const unsigned a_ = r[0], b_ = r[1]; return __builtin_bit_cast(float, a_) + __builtin_bit_cast(float, b_); }
__device__ __forceinline__ int opaque_tid() { int t = threadIdx.x; asm volatile("" : "+v"(t)); return t; }

#if defined(TS_PHASE) && TS_PHASE >= 30 && TS_PHASE < 60
__device__ unsigned long long g_tsp;
#define TSP(id) do { if (((TS_PHASE == (id) && blockIdx.x == 0) || (TS_PHASE == (id) + 10 && blockIdx.x == 120)) && threadIdx.x == 448) g_tsp = __builtin_amdgcn_s_memrealtime(); } while (0)
#else
#define TSP(id) do {} while (0)
#endif

#define XB_TMO      128
#define XB_XCNT(j)  (256  + 64 * (j))
#define XB_XSUB(j)  (1280 + 64 * (j))
#define XB_XGEN(j)  (2304 + 64 * (j))
#define XB_TOP      3328
#define XB_TOPGEN   3392
#define XCD_BAR_WORDS 3456
#define XB_SPIN_CAP (1u << 18)

__device__ __forceinline__ unsigned xb_ld(unsigned* p)              { return __hip_atomic_load(p, __ATOMIC_RELAXED, __HIP_MEMORY_SCOPE_AGENT); }
__device__ __forceinline__ unsigned xb_add(unsigned* p, unsigned v) { return __hip_atomic_fetch_add(p, v, __ATOMIC_RELAXED, __HIP_MEMORY_SCOPE_AGENT); }
__device__ __forceinline__ unsigned xb_xcc_id() { return (unsigned)__builtin_amdgcn_s_getreg((3 << 11) | 20) & 0xFu; }
#define XB_SPIN(cond, bar) do { unsigned _sp = 0; while (cond) { __builtin_amdgcn_s_sleep(1); \
    if ((++_sp & 255u) == 0u) { if (xb_ld(&(bar)[XB_TMO])) break; if (_sp > XB_SPIN_CAP) { atomicAdd(&(bar)[XB_TMO], 1u); break; } } } } while (0)

struct XcdBarrier {
    unsigned* bar; unsigned x;
    volatile LAS unsigned* st;
};

__device__ __forceinline__ XcdBarrier xcd_barrier_post(unsigned* bar, volatile LAS unsigned* st) {
    XcdBarrier b; b.bar = bar; b.x = xb_xcc_id(); b.st = st;
    if (threadIdx.x == 0) (void)xb_add(&bar[XB_XCNT(b.x)], 1u);
    return b;
}
__device__ __forceinline__ void xcd_barrier_complete(unsigned* bar, unsigned x, unsigned& nloc, unsigned& nx) {
    const unsigned G = gridDim.x * gridDim.y * gridDim.z;
    unsigned sum, cnt, mine, sp = 0u;
    for (;;) {
        sum = 0u; cnt = 0u; mine = 0u;
#pragma unroll
        for (unsigned j = 0; j < 16; ++j) { const unsigned c = xb_ld(&bar[XB_XCNT(j)]); sum += c; cnt += (c > 0u) ? 1u : 0u; mine = (j == x) ? c : mine; }
        if (sum == G) break;
        __builtin_amdgcn_s_sleep(1);
        if ((++sp & 255u) == 0u) { if (xb_ld(&bar[XB_TMO])) break; if (sp > XB_SPIN_CAP) { atomicAdd(&bar[XB_TMO], 1u); break; } }
    }
    nloc = mine > 0u ? mine : 1u; nx = cnt > 0u ? cnt : 1u;
}

__device__ __forceinline__ void xcd_barrier(const XcdBarrier& b) {
    asm volatile("s_waitcnt vmcnt(0)" ::: "memory");
    __syncthreads();
    if (threadIdx.x == 0) {
        unsigned* bar = b.bar;
        __builtin_amdgcn_s_waitcnt(0);
        unsigned nloc = b.st[0], nx = b.st[1];
        if (nloc == 0u) { xcd_barrier_complete(bar, b.x, nloc, nx); b.st[0] = nloc; b.st[1] = nx; }
        const unsigned old = xb_add(&bar[XB_XSUB(b.x)], 1u);
        const unsigned gen = old / nloc;
        if (old + 1u == (gen + 1u) * nloc) {
            __builtin_amdgcn_fence(__ATOMIC_RELEASE, "agent");
            asm volatile("s_waitcnt vmcnt(0)" ::: "memory");
            const unsigned og = xb_add(&bar[XB_TOP], 1u);
            const unsigned tg = og / nx;
            if (og + 1u == (tg + 1u) * nx) xb_add(&bar[XB_TOPGEN], 1u);
            else XB_SPIN(xb_ld(&bar[XB_TOPGEN]) == tg, bar);
            __builtin_amdgcn_fence(__ATOMIC_ACQUIRE, "agent");
            xb_add(&bar[XB_XGEN(b.x)], 1u);
            asm volatile("s_waitcnt vmcnt(0)" ::: "memory");
        } else {
            XB_SPIN((int)(xb_ld(&bar[XB_XGEN(b.x)]) - gen) <= 0, bar);
            __builtin_amdgcn_fence(__ATOMIC_ACQUIRE, "agent");
            asm volatile("s_waitcnt vmcnt(0)" ::: "memory");
        }
    }
    __syncthreads();
}

__device__ __forceinline__ void xcd_barrier_arrive(const XcdBarrier& b) {
    asm volatile("s_waitcnt vmcnt(0)" ::: "memory");
    __syncthreads();
    if (threadIdx.x == 0) {
        unsigned* bar = b.bar;
        __builtin_amdgcn_s_waitcnt(0);
        unsigned nloc = b.st[0], nx = b.st[1];
        if (nloc == 0u) { xcd_barrier_complete(bar, b.x, nloc, nx); b.st[0] = nloc; b.st[1] = nx; }
        const unsigned old = xb_add(&bar[XB_XSUB(b.x)], 1u);
        const unsigned gen = old / nloc; unsigned role = 0u, tg = 0u;
        if (old + 1u == (gen + 1u) * nloc) {
            __builtin_amdgcn_fence(__ATOMIC_RELEASE, "agent");
            asm volatile("s_waitcnt vmcnt(0)" ::: "memory");
            const unsigned og = xb_add(&bar[XB_TOP], 1u);
            tg = og / nx;
            if (og + 1u == (tg + 1u) * nx) { xb_add(&bar[XB_TOPGEN], 1u); role = 2u; } else role = 1u;
        }
        b.st[2] = gen; b.st[3] = tg; b.st[4] = role;
    }
}
__device__ __forceinline__ void xcd_barrier_wait(const XcdBarrier& b) {
    __syncthreads();
    if (threadIdx.x == 0) {
        unsigned* bar = b.bar;
        const unsigned gen = b.st[2], role = b.st[4];
        XB_SPIN(xb_ld(&bar[XB_TOPGEN]) == gen, bar);
        __builtin_amdgcn_fence(__ATOMIC_ACQUIRE, "agent");
        if (role != 0u) xb_add(&bar[XB_XGEN(b.x)], 1u);
        asm volatile("s_waitcnt vmcnt(0)" ::: "memory");
    }
    __syncthreads();
}


namespace pg8 {
#define PG8_LAS __attribute__((address_space(3)))
typedef unsigned short bf16_t;
typedef unsigned u32x4 __attribute__((ext_vector_type(4)));
constexpr int BM = 256, BK = 64, HALF = 128, HTB = HALF * BK * 2  , STAGE_BYTES = 8 * HTB, NXCD = 8, WGM = 8;

__host__ __device__ __forceinline__ int lds_byte(int r, int c) { const int st = (r >> 4) * 2 + (c >> 5), rr = r & 15, cc = c & 31, ob = rr * 64 + cc * 2; return st * 1024 + (ob ^ (((ob >> 9) & 1) << 5)); }
__host__ __device__ __forceinline__ void stage_rc(int b, int& R, int& C) { const int st = b / 1024, sb = b % 1024, swz = sb ^ (((sb >> 9) & 1) << 5); R = (st >> 1) * 16 + swz / 64; C = (st & 1) * 32 + (swz % 64) / 2; }
__host__ __device__ __forceinline__ int perm32(int rho) { const int n = rho >> 4, i = rho & 15; return 8 * (i >> 2) + 4 * n + (i & 3); }

struct Unit { int pm, pn; };
struct Gemm { const bf16_t* A; const bf16_t* Bt; int K; };

struct GateOrder {
    int G, c;
    __device__ __forceinline__ bool next(int i, Unit& u) const {
        const int L = i * G + c; if (L >= 1920 + 16) return false;
        if (L >= 1920) { const int j = L - 1920; u.pm = 32 + (j >> 3); u.pn = 60 + (j & 7); return true; }
        const int wgid = (L % NXCD) * 240 + L / NXCD;
        const int w = wgid % 480; u.pm = (wgid / 480) * WGM + (w % WGM); u.pn = w / WGM; return true;
    }
    __device__ __forceinline__ void a_ready(const Unit&) const {}
    __device__ __forceinline__ void done(const Unit&) const {}
};
struct BranchOrder {
    int pm, pn;
    __device__ __forceinline__ bool next(int i, Unit& u) const { if (i >= 3) return false; u.pm = i * 32 + pm; u.pn = i * 8 + pn; return true; }
    __device__ __forceinline__ void a_ready(const Unit&) const {}
    __device__ __forceinline__ void done(const Unit&) const {}
};
struct OneOrder {
    int pm, pn;
    __device__ __forceinline__ bool next(int i, Unit& u) const { if (i >= 1) return false; u.pm = pm; u.pn = pn; return true; }
    __device__ __forceinline__ void a_ready(const Unit&) const {}
    __device__ __forceinline__ void done(const Unit&) const {}
};


typedef int v4i_t __attribute__((ext_vector_type(4)));
#if defined(TS_PHASE) && TS_PHASE >= 100
#define TS_EPI ((TS_PHASE / 100) % 10)
#define TS_BLK (TS_PHASE % 100)
__device__ unsigned g_epi_ticks;
#endif
template <class Epi, class Sched, bool ALIGN_EPI = false, bool SP2 = false, bool FP8 = false>
__device__ __forceinline__ void gemm_phase(PG8_LAS unsigned char* lds, const Gemm g, const Sched& S, const Epi& E) {
    const int tid = opaque_tid(), wid = __builtin_amdgcn_readfirstlane(tid >> 6), lane = tid & 63, wr = wid >> 2, wc = wid & 3, fr = lane & 15, fq = lane >> 4;
    const int K = g.K, nt = FP8 ? K / 128 : K / BK;
    unsigned voffA[2], voffB[2];
#pragma unroll
    for (int i = 0; i < 2; ++i) { int R, C; stage_rc(tid * 16 + i * 8192, R, C); const int Rb = Epi::PERM ? ((R & ~31) + perm32(R & 31)) : R;
        voffA[i] = FP8 ? (unsigned)(R * K + 2 * C) : (unsigned)(R * K + C) * 2u; voffB[i] = FP8 ? (unsigned)(Rb * K + 2 * C) : (unsigned)(Rb * K + C) * 2u; }
    const unsigned kstep = (unsigned)(BK * 2);
    const unsigned hstep = (unsigned)HALF * K * (FP8 ? 1 : 2);
    const unsigned tstep = 2 * hstep;
    const __amdgpu_buffer_rsrc_t rsrc_voffA = __builtin_amdgcn_make_buffer_rsrc((void*)g.A, 0, 0x7fffffff, 0x00020000), rsrc_voffB = __builtin_amdgcn_make_buffer_rsrc((void*)g.Bt, 0, 0x7fffffff, 0x00020000);
    const unsigned ldsw = (unsigned)wid * 1024u;
    const int aoff = lds_byte(wr * 64 + fr, fq * 8), boff = lds_byte(wc * 32 + fr, fq * 8);
#define PG8_SA(b, h) (((b) * 2 + (h)) * HTB)
#define PG8_SB(b, h) ((4 + (b) * 2 + (h)) * HTB)
#define PG8_STAGE(bufoff, gbase, voff) do { const unsigned _so = (unsigned)__builtin_amdgcn_readfirstlane((int)(gbase)); _Pragma("unroll") for (int _i = 0; _i < 2; ++_i) \
        __builtin_amdgcn_raw_ptr_buffer_load_lds(rsrc_##voff, (PG8_LAS unsigned*)(lds + (bufoff) + ldsw + _i * 8192), 16, (int)(voff)[_i], (int)_so, 0, 0); } while (0)
#define PG8_LDA(dst, b, h) do { _Pragma("unroll") for (int m = 0; m < 4; ++m) _Pragma("unroll") for (int k = 0; k < 2; ++k) dst[m][k] = *(const PG8_LAS bf16x8*)(lds + PG8_SA(b, h) + aoff + m * 2048 + k * 1024); } while (0)
#define PG8_LDB(dst, b, h) do { _Pragma("unroll") for (int n = 0; n < 2; ++n) _Pragma("unroll") for (int k = 0; k < 2; ++k) dst[n][k] = *(const PG8_LAS bf16x8*)(lds + PG8_SB(b, h) + boff + n * 2048 + k * 1024); } while (0)
#define PG8_MMA(ai, bj, At, Bt) do { __builtin_amdgcn_s_setprio(1); \
        if constexpr (FP8) { _Pragma("unroll") for (int m = 0; m < 4; ++m) _Pragma("unroll") for (int n = 0; n < 2; ++n) _Pragma("unroll") for (int k = 0; k < 2; ++k) \
            acc[ai][bj][m][n] = __builtin_bit_cast(f32x4, __builtin_amdgcn_mfma_i32_16x16x64_i8(__builtin_bit_cast(v4i_t, Bt[n][k]), __builtin_bit_cast(v4i_t, At[m][k]), __builtin_bit_cast(v4i_t, acc[ai][bj][m][n]), 0, 0, 0)); } \
        else { _Pragma("unroll") for (int m = 0; m < 4; ++m) _Pragma("unroll") for (int n = 0; n < 2; ++n) _Pragma("unroll") for (int k = 0; k < 2; ++k) \
            acc[ai][bj][m][n] = __builtin_amdgcn_mfma_f32_16x16x32_bf16(Bt[n][k], At[m][k], acc[ai][bj][m][n], 0, 0, 0); } \
        __builtin_amdgcn_s_setprio(0); } while (0)
#define PG8_WAIT_V(n) asm volatile("s_waitcnt vmcnt(" #n ")" ::: "memory")
#define PG8_WAIT_V1() do { if constexpr (Epi::EPI_STORES >= 16) { if (t == 0 && ui > 0) PG8_WAIT_V(24); else PG8_WAIT_V(8); } else PG8_WAIT_V(8); } while (0)
#define PG8_WAIT_L(n) asm volatile("s_waitcnt lgkmcnt(" #n ")" ::: "memory")
#define PG8_BAR __builtin_amdgcn_s_barrier()
#define PG8_SCHED __builtin_amdgcn_sched_barrier(0)
    Unit cur, nxt; int ui = 0;
#ifdef TS_EPI
    unsigned epi_ticks_ = 0;
#endif
    typename Epi::HookState xh{};
    if (!S.next(0, cur)) return;
    f32x4 acc[2][2][4][2];
#pragma unroll
    for (int a = 0; a < 2; ++a)
#pragma unroll
        for (int b = 0; b < 2; ++b)
#pragma unroll
            for (int m = 0; m < 4; ++m)
#pragma unroll
                for (int n = 0; n < 2; ++n) acc[a][b][m][n] = (f32x4){0.f, 0.f, 0.f, 0.f};
    bf16x8 At[4][2], B0[2][2], B1[2][2];
    unsigned cA = (unsigned)cur.pm * tstep, cB = (unsigned)cur.pn * tstep;
    S.a_ready(cur);
    if constexpr (SP2) {
        PG8_STAGE(PG8_SB(0, 0), cB, voffB); PG8_STAGE(PG8_SB(0, 1), cB + hstep, voffB); PG8_STAGE(PG8_SA(0, 0), cA, voffA); PG8_STAGE(PG8_SA(0, 1), cA + hstep, voffA);
        if (wr == 1) PG8_BAR;
        PG8_WAIT_V(2); PG8_BAR;
        PG8_STAGE(PG8_SB(1, 0), cB + kstep, voffB); PG8_STAGE(PG8_SA(1, 0), cA + kstep, voffA); PG8_STAGE(PG8_SB(1, 1), cB + hstep + kstep, voffB);
        PG8_WAIT_V(6); PG8_BAR;
    } else {
        PG8_STAGE(PG8_SB(0, 0), cB, voffB); PG8_STAGE(PG8_SA(0, 0), cA, voffA); PG8_STAGE(PG8_SB(0, 1), cB + hstep, voffB); PG8_STAGE(PG8_SA(0, 1), cA + hstep, voffA);
        if (wr == 1) PG8_BAR;
        PG8_WAIT_V(4); PG8_BAR;
        PG8_STAGE(PG8_SB(1, 0), cB + kstep, voffB); PG8_STAGE(PG8_SA(1, 0), cA + kstep, voffA); PG8_STAGE(PG8_SB(1, 1), cB + hstep + kstep, voffB);
        PG8_WAIT_V(6); PG8_BAR;
    }
    for (;;) {
        const bool has_next = S.next(ui + 1, nxt);
        const unsigned nA = has_next ? (unsigned)nxt.pm * tstep : cA, nB = has_next ? (unsigned)nxt.pn * tstep : cB;
        for (int t = 0; t < nt; t += 2) {
            const bool last = (t == nt - 2);
            const unsigned a1 = cA + (unsigned)(t + 1) * kstep;
            const unsigned a2 = last ? nA : cA + (unsigned)(t + 2) * kstep, b2 = last ? nB : cB + (unsigned)(t + 2) * kstep;
            const unsigned a3 = a2 + kstep, b3 = b2 + kstep;
            if (last && has_next) S.a_ready(nxt);
            if constexpr (SP2) {
            PG8_LDB(B0, 0, 0); PG8_LDB(B1, 0, 1); PG8_SCHED; PG8_LDA(At, 0, 0); PG8_STAGE(PG8_SA(1, 1), a1 + hstep, voffA);
            PG8_WAIT_V1(); PG8_WAIT_L(0); PG8_BAR; PG8_MMA(0, 0, At, B0); PG8_MMA(0, 1, At, B1); PG8_BAR; PG8_SCHED;
            PG8_LDA(At, 0, 1); PG8_STAGE(PG8_SB(0, 0), b2, voffB); PG8_STAGE(PG8_SB(0, 1), b2 + hstep, voffB); PG8_STAGE(PG8_SA(0, 0), a2, voffA);
            PG8_WAIT_V1(); PG8_WAIT_L(0); PG8_BAR; PG8_MMA(1, 0, At, B0); PG8_MMA(1, 1, At, B1); PG8_BAR; PG8_SCHED;
            PG8_LDB(B0, 1, 0); PG8_LDB(B1, 1, 1); PG8_SCHED; PG8_LDA(At, 1, 0); PG8_STAGE(PG8_SA(0, 1), a2 + hstep, voffA);
            PG8_WAIT_V(8); PG8_WAIT_L(0); PG8_BAR; PG8_MMA(0, 0, At, B0); PG8_MMA(0, 1, At, B1); PG8_BAR; PG8_SCHED;
            PG8_LDA(At, 1, 1); PG8_STAGE(PG8_SB(1, 0), b3, voffB); PG8_STAGE(PG8_SB(1, 1), b3 + hstep, voffB); PG8_STAGE(PG8_SA(1, 0), a3, voffA);
            PG8_WAIT_V(8); PG8_WAIT_L(0); PG8_BAR; PG8_MMA(1, 0, At, B0); PG8_MMA(1, 1, At, B1); PG8_BAR; PG8_SCHED;
            } else {
            PG8_LDB(B0, 0, 0); PG8_SCHED; PG8_LDA(At, 0, 0); PG8_STAGE(PG8_SA(1, 1), a1 + hstep, voffA);
            PG8_WAIT_L(8); PG8_BAR; PG8_WAIT_L(0); PG8_MMA(0, 0, At, B0); PG8_BAR; PG8_SCHED;
            PG8_LDB(B1, 0, 1); PG8_STAGE(PG8_SB(0, 0), b2, voffB);
            PG8_BAR; PG8_WAIT_L(0); PG8_MMA(0, 1, At, B1); PG8_BAR;
            PG8_LDA(At, 0, 1); PG8_STAGE(PG8_SA(0, 0), a2, voffA);
            PG8_BAR; PG8_WAIT_L(0); PG8_MMA(1, 0, At, B0); PG8_BAR; PG8_SCHED;
            PG8_STAGE(PG8_SB(0, 1), b2 + hstep, voffB);
            PG8_WAIT_V(6); PG8_BAR; PG8_MMA(1, 1, At, B1); PG8_BAR;
            PG8_LDB(B0, 1, 0); PG8_SCHED; PG8_LDA(At, 1, 0); PG8_STAGE(PG8_SA(0, 1), a2 + hstep, voffA);
            PG8_WAIT_L(8); PG8_BAR; PG8_WAIT_L(0); PG8_MMA(0, 0, At, B0); PG8_BAR; PG8_SCHED;
            PG8_LDB(B1, 1, 1); PG8_STAGE(PG8_SB(1, 0), b3, voffB);
            PG8_BAR; PG8_WAIT_L(0); PG8_MMA(0, 1, At, B1); PG8_BAR;
            PG8_LDA(At, 1, 1); PG8_STAGE(PG8_SA(1, 0), a3, voffA);
            PG8_BAR; PG8_WAIT_L(0); PG8_MMA(1, 0, At, B0); PG8_BAR; PG8_SCHED;
            PG8_STAGE(PG8_SB(1, 1), b3 + hstep, voffB);
            PG8_WAIT_V(6); PG8_BAR; PG8_MMA(1, 1, At, B1); PG8_BAR;
            }
            if constexpr (Epi::IN_LOOP) E.in_loop(acc, t, cur, wr, wc, fr, fq, xh);
        }
        if constexpr (ALIGN_EPI) { if (wr == 0) PG8_BAR; }
        bool zacc = true;
#ifdef TS_EPI
        const unsigned long long te0_ = __builtin_amdgcn_s_memrealtime();
#endif
        if constexpr (!Epi::AFTER_DRAIN) { zacc = E(acc, cur, wr, wc, fr, fq); S.done(cur); }
#ifdef TS_EPI
        epi_ticks_ += (unsigned)(__builtin_amdgcn_s_memrealtime() - te0_);
#endif
        if (!has_next) break;
        if (zacc) {
#pragma unroll
        for (int a = 0; a < 2; ++a)
#pragma unroll
            for (int b = 0; b < 2; ++b)
#pragma unroll
                for (int m = 0; m < 4; ++m)
#pragma unroll
                    for (int n = 0; n < 2; ++n) acc[a][b][m][n] = (f32x4){0.f, 0.f, 0.f, 0.f};
        }
        cur = nxt; cA = nA; cB = nB; ++ui;
        if constexpr (ALIGN_EPI) { if (wr == 1) PG8_BAR; }
    }
#ifdef TS_EPI
    if (Epi::TS_ID == TS_EPI && (int)blockIdx.x == TS_BLK && tid == 0) __hip_atomic_store(&g_epi_ticks, epi_ticks_, RLX_AGENT);
#endif
    PG8_WAIT_V(0);
    if constexpr (!ALIGN_EPI) { if (wr == 0) PG8_BAR; }
    PG8_BAR;
    if constexpr (Epi::AFTER_DRAIN) { if constexpr (Epi::IN_LOOP) E.fused(acc, cur, wr, wc, fr, fq, lds, wid, lane, xh); else E.fused(acc, cur, wr, wc, fr, fq, lds, wid, lane); S.done(cur); }
#undef PG8_SA
#undef PG8_SB
#undef PG8_STAGE
#undef PG8_LDA
#undef PG8_LDB
#undef PG8_MMA
#undef PG8_WAIT_V
#undef PG8_WAIT_L
#undef PG8_BAR
#undef PG8_SCHED
}

constexpr float LOG2E = 1.4426950408889634f;
template <int MODE> __device__ __forceinline__ float act_gate(float x) {
    constexpr float KG = -2.0f * 0.7978845608028654f * LOG2E;
    if constexpr (MODE == 1) return __builtin_amdgcn_rcpf(__builtin_fmaf(__builtin_amdgcn_exp2f(x * -LOG2E), 1.0f / 255.0f, 1.0f / 255.0f));
    if constexpr (MODE == 3) return __builtin_amdgcn_rcpf(__builtin_fmaf(__builtin_amdgcn_exp2f(x), 1.0f / 255.0f, 1.0f / 255.0f));
    const float t = MODE == 0 ? x * -LOG2E : x * (KG + (KG * 0.044715f) * (x * x));
    return x * __builtin_amdgcn_rcpf(1.0f + __builtin_amdgcn_exp2f(t));
}
struct NoHook {};
struct EpiGate {
    static constexpr int TS_ID = 1, EPI_STORES = 16;
    static constexpr bool PERM = true, AFTER_DRAIN = false, IN_LOOP = false; typedef NoHook HookState;
    template <bool STATS> __device__ __forceinline__ void act_store(const f32x4 (&acc)[2][2][4][2], bf16_t* base, int ldc, int row0, int col0, float* vsl, int fq) const {
#pragma unroll
        for (int ai = 0; ai < 2; ++ai)
#pragma unroll
            for (int m = 0; m < 4; ++m) { bf16_t* rowp = base + (size_t)(row0 + ai * HALF + m * 16) * ldc + col0; float rs = 0.f, rq = 0.f;
#pragma unroll
                for (int bj = 0; bj < 2; ++bj) { f32x4 v0 = acc[ai][bj][m][0], v1 = acc[ai][bj][m][1];
#pragma unroll
                    for (int j = 0; j < 4; ++j) { v0[j] = act_gate<2>(v0[j]); v1[j] = act_gate<2>(v1[j]); }
                    if (STATS) {
#pragma unroll
                        for (int j = 0; j < 4; ++j) { rs += v0[j] + v1[j]; rq += v0[j] * v0[j] + v1[j] * v1[j]; } }
                    u32x4 w; w.x = cvt_pk_bf16(v0[0], v0[1]); w.y = cvt_pk_bf16(v0[2], v0[3]); w.z = cvt_pk_bf16(v1[0], v1[1]); w.w = cvt_pk_bf16(v1[2], v1[3]);
                    *(u32x4*)(rowp + bj * HALF) = w; }
                if (STATS) { rs = sum_xor32(sum_xor16(rs)); rq = sum_xor32(sum_xor16(rq));
                    if (fq == 0) *(f32x2v*)(vsl + (size_t)(ai * HALF + m * 16) * 32) = (f32x2v){rs, rq}; } }
    }
    bf16_t* gates; bf16_t* act; bf16_t* memk; float* kmean; float* vst;
    __device__ __forceinline__ bool operator()(f32x4 (&acc)[2][2][4][2], const Unit& u, int wr, int wc, int fr, int fq) const {
        asm volatile("" : "+v"(fr), "+v"(fq));
        const int tq = u.pn, ct = tq; const bool ism = tq >= 60;
        const float ds = ((ct >= 8 && ct < 12) || (ct >= 16 && ct < 24) || tq >= 64) ? 1.0f / (QX * QWB) : 1.0f / (QX * QW);
        const float dsx = (!ism && ct >= 36) ? -LOG2E / (QX * QW) : ds;
#pragma unroll
        for (int ai = 0; ai < 2; ++ai)
#pragma unroll
            for (int bj = 0; bj < 2; ++bj)
#pragma unroll
                for (int m = 0; m < 4; ++m)
#pragma unroll
                    for (int n = 0; n < 2; ++n)
                    { const v4i_t iv = __builtin_bit_cast(v4i_t, acc[ai][bj][m][n]);
                      acc[ai][bj][m][n] = (f32x4){(float)iv[0] * dsx, (float)iv[1] * dsx, (float)iv[2] * dsx, (float)iv[3] * dsx}; }
        if (!ism && (ct >> 2) == A_UG) { act_store<false>(acc, act + (size_t)A_UG * ACT_STRIDE, W, u.pm * BM + wr * 64 + fr, (ct & 3) * 256 + wc * 32 + 8 * fq, nullptr, fq); return true; }
        if (!ism && (ct >> 2) == A_VG) { const int row0 = u.pm * BM + wr * 64 + fr;
            act_store<true>(acc, act + (size_t)A_VG * ACT_STRIDE, W, row0, (ct & 3) * 256 + wc * 32 + 8 * fq, vst + ((size_t)row0 * 16 + (ct & 3) * 4 + wc) * 2, fq); return true; }
        if (ism || ct < 36) { const int j = tq - 60, seg = ct >> 2; const bool sil = !ism && (seg == A_ZA || seg == A_ZG || seg == A_ZC);
            bf16_t* base = ism ? memk + (size_t)(j >> 2) * ((size_t)MM * W) : act + (size_t)seg * ACT_STRIDE; const int row0 = (ism ? (u.pm - 32) * BM : u.pm * BM) + wr * 64 + fr, col0 = ((ism ? j : ct) & 3) * 256 + wc * 32 + 8 * fq;
#pragma unroll
            for (int ai = 0; ai < 2; ++ai)
#pragma unroll
                for (int m = 0; m < 4; ++m) { bf16_t* rowp = base + (size_t)(row0 + ai * HALF + m * 16) * W + col0;
#pragma unroll
                    for (int bj = 0; bj < 2; ++bj) { f32x4 v0 = acc[ai][bj][m][0], v1 = acc[ai][bj][m][1];
                        if (sil) {
#pragma unroll
                            for (int jj = 0; jj < 4; ++jj) { v0[jj] = act_gate<0>(v0[jj]); v1[jj] = act_gate<0>(v1[jj]); } }
                        u32x4 w; w.x = cvt_pk_bf16(v0[0], v0[1]); w.y = cvt_pk_bf16(v0[2], v0[3]); w.z = cvt_pk_bf16(v1[0], v1[1]); w.w = cvt_pk_bf16(v1[2], v1[3]);
                        *(u32x4*)(rowp + bj * HALF) = w; } }
            if (!ism && seg == A_KA) {
                float* kp = kmean + (size_t)wr * KM_SLOT + (size_t)u.pm * W + col0;
#pragma unroll
                for (int bj = 0; bj < 2; ++bj)
#pragma unroll
                    for (int n = 0; n < 2; ++n) { f32x4 sv;
#pragma unroll
                        for (int j2 = 0; j2 < 4; ++j2) { float s = 0.f;
#pragma unroll
                            for (int ai = 0; ai < 2; ++ai)
#pragma unroll
                                for (int m = 0; m < 4; ++m) s += acc[ai][bj][m][n][j2];
                            s += __shfl_xor(s, 1); s += __shfl_xor(s, 2); s += __shfl_xor(s, 4); s += __shfl_xor(s, 8); sv[j2] = s * (1.0f / 256.0f); }
                        if (fr == 0) *(f32x4*)(kp + bj * HALF + 4 * n) = sv; } }
            return true; }
        const int g = ct - 36, br = g >> 3, pnl = g & 7;
        unsigned char* gb = (unsigned char*)gates + ((((size_t)(u.pm * 8 + pnl) * 3 + br) * 8 + (wr * 4 + wc)) * 16) * 512 + (fq * 16 + fr) * 8;
#pragma unroll
        for (int ai = 0; ai < 2; ++ai)
#pragma unroll
            for (int m = 0; m < 4; ++m)
#pragma unroll
                for (int bj = 0; bj < 2; ++bj) { const f32x4 v0 = acc[ai][bj][m][0], v1 = acc[ai][bj][m][1]; unsigned w0 = 0u, w1 = 0u;
#pragma unroll
                    for (int j = 0; j < 4; ++j) { w0 = __builtin_amdgcn_cvt_pk_u8_f32(act_gate<3>(v0[j]), j, w0); w1 = __builtin_amdgcn_cvt_pk_u8_f32(act_gate<3>(v1[j]), j, w1); }
                    __builtin_nontemporal_store((f32x2v){__builtin_bit_cast(float, w0), __builtin_bit_cast(float, w1)}, (f32x2v*)(gb + ((ai * 4 + m) * 2 + bj) * 512)); }
        return true;
    }
};
struct EpiBranch {
    static constexpr int TS_ID = 4, EPI_STORES = 0;
    static constexpr bool PERM = true, AFTER_DRAIN = false, IN_LOOP = false; typedef NoHook HookState;
    const bf16_t* gates; bf16_t* merged;
    __device__ __forceinline__ bool operator()(f32x4 (&acc)[2][2][4][2], const Unit& u, int wr, int wc, int fr, int fq) const {
        const int br = u.pm >> 5, pm = u.pm & 31, pn = u.pn & 7;
        const int row0 = pm * BM + wr * 64 + fr, col0 = pn * BM + wc * 32 + 8 * fq;
        const unsigned char* gp = (const unsigned char*)gates + ((((size_t)(pm * 8 + pn) * 3 + br) * 8 + (wr * 4 + wc)) * 16) * 512 + (fq * 16 + fr) * 8;
        const unsigned char* gq = gp + (br < 2 ? 8 * 16 * 512 : 0);
#define BYTE_F(w, e) ((float)((((e) < 4 ? (w).x : (w).y) >> (8 * ((e) & 3))) & 0xffu))
        v2u ga[2][4], gb[2][4];
#pragma unroll
        for (int s = 0; s < 4; ++s) { ga[0][s] = __builtin_nontemporal_load((const v2u*)(gp + s * 512)); gb[0][s] = __builtin_nontemporal_load((const v2u*)(gq + s * 512)); }
#pragma unroll
        for (int q = 0; q < 4; ++q) { const int cb = q & 1, nb = cb ^ 1;
            if (q < 3) {
#pragma unroll
                for (int s = 0; s < 4; ++s) { ga[nb][s] = __builtin_nontemporal_load((const v2u*)(gp + ((q + 1) * 4 + s) * 512)); gb[nb][s] = __builtin_nontemporal_load((const v2u*)(gq + ((q + 1) * 4 + s) * 512)); } }
#pragma unroll
            for (int s = 0; s < 4; ++s) asm volatile("" : "+v"(ga[cb][s]), "+v"(gb[cb][s]));
            if (br < 2) {
#pragma unroll
                for (int s = 0; s < 4; ++s) { const int sl = q * 4 + s, ai = sl >> 3, m = (sl >> 1) & 3, bj = sl & 1; float g[8];
#pragma unroll
                    for (int e_ = 0; e_ < 8; ++e_) g[e_] = fmaxf(BYTE_F(ga[cb][s], e_), 0.5f) * __builtin_amdgcn_rcpf(fmaxf(BYTE_F(gb[cb][s], e_), 0.5f));
#pragma unroll
                    for (int j = 0; j < 4; ++j) { acc[ai][bj][m][0][j] *= g[j]; acc[ai][bj][m][1][j] *= g[4 + j]; } }
            } else {
#pragma unroll
                for (int s = 0; s < 4; ++s) { const int sl = q * 4 + s, ai = sl >> 3, m = (sl >> 1) & 3, bj = sl & 1, row = row0 + ai * HALF + m * 16; float g[8];
#pragma unroll
                    for (int e_ = 0; e_ < 8; ++e_) g[e_] = fmaxf(BYTE_F(ga[cb][s], e_), 0.5f) * (1.0f / 255.0f);
                    f32x4 v0 = acc[ai][bj][m][0], v1 = acc[ai][bj][m][1];
#pragma unroll
                    for (int j = 0; j < 4; ++j) { v0[j] *= g[j]; v1[j] *= g[4 + j]; }
                    *(v2u*)((unsigned char*)merged + (size_t)row * DM + col0 + bj * HALF) = (v2u){pk4_i8(v0[0], v0[1], v0[2], v0[3], QM), pk4_i8(v1[0], v1[1], v1[2], v1[3], QM)}; } }
        }
#undef BYTE_F
        return br == 2;
    }
};
struct EpiOutLN {
    static constexpr int TS_ID = 5, EPI_STORES = 0;
    static constexpr bool PERM = false, AFTER_DRAIN = true, IN_LOOP = false; typedef NoHook HookState;
    const float* x; float* out; const float* lng; const float* lnb; float* lns; XcdBarrier bar;
    __device__ __forceinline__ void fused(f32x4 (&acc)[2][2][4][2], const Unit& u, int wr, int wc, int fr, int fq, PG8_LAS unsigned char* lds, int wid, int lane) const {
        PG8_LAS f32x2v* P = (PG8_LAS f32x2v*)lds;
        PG8_LAS f32x2v* S = (PG8_LAS f32x2v*)(lds + 8192);
        const int col0 = u.pn * BM + wc * 32 + 4 * fq;
        { constexpr float ds = 1.0f / (QM * QWB);
#pragma unroll
          for (int ai = 0; ai < 2; ++ai)
#pragma unroll
              for (int bj = 0; bj < 2; ++bj)
#pragma unroll
                  for (int m = 0; m < 4; ++m)
#pragma unroll
                      for (int n = 0; n < 2; ++n) { const v4i_t iv = __builtin_bit_cast(v4i_t, acc[ai][bj][m][n]); acc[ai][bj][m][n] = (f32x4){(float)iv[0] * ds, (float)iv[1] * ds, (float)iv[2] * ds, (float)iv[3] * ds}; } }
#pragma unroll
        for (int ai = 0; ai < 2; ++ai) { f32x4 xv[4][2][2];
#pragma unroll
            for (int m = 0; m < 4; ++m) { const size_t off = (size_t)(u.pm * BM + ai * HALF + wr * 64 + m * 16 + fr) * DM + col0;
#pragma unroll
                for (int bj = 0; bj < 2; ++bj)
#pragma unroll
                    for (int n = 0; n < 2; ++n) xv[m][bj][n] = __builtin_nontemporal_load((const f32x4*)(x + off + bj * HALF + n * 16)); }
#pragma unroll
            for (int m = 0; m < 4; ++m)
#pragma unroll
                for (int bj = 0; bj < 2; ++bj)
#pragma unroll
                    for (int n = 0; n < 2; ++n) acc[ai][bj][m][n] = acc[ai][bj][m][n] + xv[m][bj][n] * DN_ALPHA;
#pragma unroll
            for (int m = 0; m < 4; ++m) asm volatile("" : "+v"(acc[ai][0][m][0]), "+v"(acc[ai][0][m][1]), "+v"(acc[ai][1][m][0]), "+v"(acc[ai][1][m][1]));
            asm volatile("" ::: "memory"); }
#pragma unroll
        for (int ai = 0; ai < 2; ++ai)
#pragma unroll
            for (int m = 0; m < 4; ++m) {
                float s = 0.f;
#pragma unroll
                for (int bj = 0; bj < 2; ++bj)
#pragma unroll
                    for (int n = 0; n < 2; ++n) { const f32x4 v = acc[ai][bj][m][n]; s += (v[0] + v[1]) + (v[2] + v[3]); }
                s = sum_xor32(sum_xor16(s));
                const float mw = s * (1.0f / 64.0f); float q = 0.f;
#pragma unroll
                for (int bj = 0; bj < 2; ++bj)
#pragma unroll
                    for (int n = 0; n < 2; ++n) { const f32x4 d = acc[ai][bj][m][n] - mw; q += (d[0] * d[0] + d[1] * d[1]) + (d[2] * d[2] + d[3] * d[3]); }
                q = sum_xor32(sum_xor16(q));
                if (fq == 0) P[(ai * HALF + wr * 64 + m * 16 + fr) * 4 + wc] = (f32x2v){mw, q};
            }
        asm volatile("s_waitcnt lgkmcnt(0)" ::: "memory"); __builtin_amdgcn_s_barrier(); asm volatile("" ::: "memory");
        const int row = wid * 32 + (lane & 31);
        if (lane < 32) {
            const f32x2v a = P[row * 4 + 0], b = P[row * 4 + 1], c = P[row * 4 + 2], d = P[row * 4 + 3];
            const float mt = (a.x + b.x + c.x + d.x) * 0.25f;
            const float da = a.x - mt, db = b.x - mt, dc = c.x - mt, dd = d.x - mt;
            const float m2 = (a.y + b.y) + (c.y + d.y) + 64.0f * ((da * da + db * db) + (dc * dc + dd * dd));
            *(f32x2v*)(lns + ((size_t)(u.pm * BM + row) * 8 + u.pn) * 2) = (f32x2v){mt, m2};
        }
        xcd_barrier(bar);
        if (lane < 32) {
            const f32x4* sp = (const f32x4*)(lns + (size_t)(u.pm * BM + row) * 16); float mt[8], m2[8];
#pragma unroll
            for (int t = 0; t < 4; ++t) { const f32x4 w = sp[t]; mt[2 * t] = w[0]; m2[2 * t] = w[1]; mt[2 * t + 1] = w[2]; m2[2 * t + 1] = w[3]; }
            float ms = 0.f;
#pragma unroll
            for (int t = 0; t < 8; ++t) ms += mt[t];
            const float mean = ms * 0.125f; float q = 0.f;
#pragma unroll
            for (int t = 0; t < 8; ++t) { const float dm = mt[t] - mean; q += m2[t] + 256.0f * dm * dm; }
            S[row] = (f32x2v){mean, 1.0f / sqrtf(q * (1.0f / DM) + LN_EPS)};
        }
        asm volatile("s_waitcnt lgkmcnt(0)" ::: "memory"); __builtin_amdgcn_s_barrier(); asm volatile("" ::: "memory");
        f32x4 gv[2][2], bv[2][2];
#pragma unroll
        for (int bj = 0; bj < 2; ++bj)
#pragma unroll
            for (int n = 0; n < 2; ++n) { gv[bj][n] = *(const f32x4*)(lng + col0 + bj * HALF + n * 16); bv[bj][n] = *(const f32x4*)(lnb + col0 + bj * HALF + n * 16); }
#pragma unroll
        for (int ai = 0; ai < 2; ++ai)
#pragma unroll
            for (int m = 0; m < 4; ++m) { const int r = ai * HALF + wr * 64 + m * 16 + fr; const f32x2v sr = S[r]; const size_t off = (size_t)(u.pm * BM + r) * DM + col0;
#pragma unroll
                for (int bj = 0; bj < 2; ++bj)
#pragma unroll
                    for (int n = 0; n < 2; ++n) { const f32x4 o = (acc[ai][bj][m][n] - sr.x) * sr.y * gv[bj][n] + bv[bj][n]; __builtin_nontemporal_store(o, (f32x4*)(out + off + bj * HALF + n * 16)); } }
    }
};
}


namespace moba {
constexpr int D = 128, PITCH = W, NW = 8, QBLK = 32, KVBLK = 64, QB = NW * QBLK;
constexpr int SHM_V = KVBLK * D * 2, SHM_K = KVBLK * D * 2;
constexpr int LDS_NEED = 2 * SHM_V + 2 * SHM_K + NW * 64 * 4;
constexpr float SCALE = 0.08838834764831845f, THR = 8.f;
typedef short s16x4 __attribute__((ext_vector_type(4)));
typedef float f32x16 __attribute__((ext_vector_type(16)));
typedef unsigned u32x4 __attribute__((ext_vector_type(4)));
#define KSWZ(row, colB) ((row) * 256 + ((colB) ^ (((row) & 7) << 4)))
#define SBAR() __builtin_amdgcn_sched_barrier(0)
__device__ __forceinline__ int v_st(int k, int c) { const int kk = (k & ~0xC) | ((k & 4) << 1) | ((k & 8) >> 1); return ((kk >> 3) * 4 + (c >> 5)) * 512 + ((kk & 7) * 32 + (c & 31)) * 2; }
__device__ __forceinline__ int v_rd_base(int lane) { return ((lane & 3) << 3) | (((lane >> 2) & 3) << 6) | (((lane >> 4) & 1) << 5) | (((lane >> 5) & 1) << 8); }
constexpr int v_rd_off(int d0, int ks, int half) { return d0 * 512 + ks * 4096 + half * 2048; }
__device__ __forceinline__ int crow(int r, int hi) { return (r & 3) + 8 * (r >> 2) + 4 * hi; }
__device__ __forceinline__ bf16x8 pack8(f32x4 a, f32x4 b) { u32x4 w = {cvt_pk_bf16(a[0], a[1]), cvt_pk_bf16(a[2], a[3]), cvt_pk_bf16(b[0], b[1]), cvt_pk_bf16(b[2], b[3])}; return *reinterpret_cast<bf16x8*>(&w); }
__device__ __forceinline__ bf16x8 load8(const bf16* p) { return *reinterpret_cast<const bf16x8*>(p); }
__device__ __forceinline__ void mask_causal(f32x16& p0, f32x16& p1, int dq) {
    const float NEG = -__builtin_inff();
#pragma unroll
    for (int r = 0; r < 16; ++r) { const int c = (r & 3) + 8 * (r >> 2); if (dq - c < 0) p0[r] = NEG; if (dq - c - 32 < 0) p1[r] = NEG; }
}
__device__ __forceinline__ void mask_row(f32x16& p0, f32x16& p1, bool keep) {
    const float NEG = -__builtin_inff();
#pragma unroll
    for (int r = 0; r < 16; ++r) { p0[r] = keep ? p0[r] : NEG; p1[r] = keep ? p1[r] : NEG; }
}
__device__ __forceinline__ void partialSM(f32x16& p0, f32x16& p1, float& m_reg, float& mn, float& alpha) {
    float pmax = p0[0]; for (int r = 1; r < 16; ++r) pmax = fmaxf(pmax, p0[r]); for (int r = 0; r < 16; ++r) pmax = fmaxf(pmax, p1[r]);
    { auto rr = __builtin_amdgcn_permlane32_swap(__float_as_uint(pmax), __float_as_uint(pmax), false, false);
      pmax = fmaxf(__uint_as_float(rr[0]), __uint_as_float(rr[1])); }
    constexpr float C2 = 1.4426950408889634f * SCALE;
    if (__builtin_expect(__all((pmax - m_reg) * SCALE <= THR), 1)) { mn = m_reg; alpha = 1.f; }
    else { mn = fmaxf(m_reg, pmax); alpha = __builtin_amdgcn_exp2f((m_reg - mn) * C2); m_reg = mn; }
    const float mnL = -mn * C2;
    for (int r = 0; r < 16; ++r) p0[r] = fmaf(p0[r], C2, mnL); for (int r = 0; r < 16; ++r) p1[r] = fmaf(p1[r], C2, mnL);
    for (int r = 0; r < 16; ++r) p0[r] = __builtin_amdgcn_exp2f(p0[r]);
}
__device__ __forceinline__ void finishSM(f32x16& p0, f32x16& p1, float alpha, float& l_reg, bf16x8& pa0, bf16x8& pa1, bf16x8& pa2, bf16x8& pa3) {
    for (int r = 0; r < 16; ++r) p1[r] = __builtin_amdgcn_exp2f(p1[r]);
    float ps = 0; for (int r = 0; r < 16; ++r) ps += p0[r]; for (int r = 0; r < 16; ++r) ps += p1[r];
    { auto rr = __builtin_amdgcn_permlane32_swap(__float_as_uint(ps), __float_as_uint(ps), false, false);
      ps = __uint_as_float(rr[0]) + __uint_as_float(rr[1]); }
    l_reg = l_reg * alpha + ps;
#define PK4(P, B_, OUT) do { unsigned a0 = cvt_pk_bf16(P[B_+0], P[B_+1]), a1 = cvt_pk_bf16(P[B_+2], P[B_+3]);                          \
        unsigned b0 = cvt_pk_bf16(P[B_+4], P[B_+5]), b1 = cvt_pk_bf16(P[B_+6], P[B_+7]);                                             \
        auto r0 = __builtin_amdgcn_permlane32_swap(a0, b0, false, false); auto r1 = __builtin_amdgcn_permlane32_swap(a1, b1, false, false); \
        u32x4 w = {r0[0], r1[0], r0[1], r1[1]}; OUT = *reinterpret_cast<bf16x8*>(&w); } while (0)
    PK4(p0, 0, pa0); PK4(p0, 8, pa1); PK4(p1, 0, pa2); PK4(p1, 8, pa3);
#undef PK4
}
template <int KB>
__device__ __forceinline__ void qkt(f32x16& p0, f32x16& p1, const char* K_lds, int r32, int hi, const bf16x8* qr) {
    p0 = f32x16{}; p1 = f32x16{};
    const char* kb[4];
#pragma unroll
    for (int dd = 0; dd < 4; ++dd) kb[dd] = K_lds + KB * SHM_K + KSWZ(r32, (dd * 16 + hi * 8) * 2);
#pragma unroll
    for (int d0 = 0; d0 < 8; ++d0) { const char* a = kb[d0 & 3] + (d0 >> 2) * 128;
        bf16x8 b0 = *reinterpret_cast<const bf16x8*>(a);
        bf16x8 b1 = *reinterpret_cast<const bf16x8*>(a + 32 * 256);
        p0 = __builtin_amdgcn_mfma_f32_32x32x16_bf16(b0, qr[d0], p0, 0, 0, 0);
        p1 = __builtin_amdgcn_mfma_f32_32x32x16_bf16(b1, qr[d0], p1, 0, 0, 0); }
}
#define MOBA_TRRD(dst, off) asm volatile("ds_read_b64_tr_b16 %0, %1 offset:%2" : "=&v"(dst) : "v"(vb0), "i"(off) : "memory")
#define MOBA_PV_D0(d0) do { s16x4 l0, l1, l2, l3, h0, h1, h2, h3; constexpr int b_ = VB * SHM_V + v_rd_off(d0, 0, 0);     \
        MOBA_TRRD(l0, b_); MOBA_TRRD(h0, b_ + 2048); MOBA_TRRD(l1, b_ + 4096); MOBA_TRRD(h1, b_ + 6144); MOBA_TRRD(l2, b_ + 8192); MOBA_TRRD(h2, b_ + 10240); MOBA_TRRD(l3, b_ + 12288); MOBA_TRRD(h3, b_ + 14336); \
        asm volatile("s_waitcnt lgkmcnt(0)" ::: "memory"); SBAR();                 \
        o[d0] = __builtin_amdgcn_mfma_f32_32x32x16_bf16(pa0, (bf16x8){l0[0], l0[1], l0[2], l0[3], h0[0], h0[1], h0[2], h0[3]}, o[d0], 0, 0, 0);   \
        o[d0] = __builtin_amdgcn_mfma_f32_32x32x16_bf16(pa1, (bf16x8){l1[0], l1[1], l1[2], l1[3], h1[0], h1[1], h1[2], h1[3]}, o[d0], 0, 0, 0);   \
        o[d0] = __builtin_amdgcn_mfma_f32_32x32x16_bf16(pa2, (bf16x8){l2[0], l2[1], l2[2], l2[3], h2[0], h2[1], h2[2], h2[3]}, o[d0], 0, 0, 0);   \
        o[d0] = __builtin_amdgcn_mfma_f32_32x32x16_bf16(pa3, (bf16x8){l3[0], l3[1], l3[2], l3[3], h3[0], h3[1], h3[2], h3[3]}, o[d0], 0, 0, 0); } while (0)
template <int VB>
__device__ __forceinline__ void pv_tile(f32x16* o, int vb0, bf16x8 pa0, bf16x8 pa1, bf16x8 pa2, bf16x8 pa3) {
    MOBA_PV_D0(0); MOBA_PV_D0(1); MOBA_PV_D0(2); MOBA_PV_D0(3);
}

#define VMW() asm volatile("s_waitcnt vmcnt(0)" ::: "memory")
#if defined(TS_PHASE) && TS_PHASE >= 90 && TS_PHASE <= 95
__device__ unsigned long long g_gacc[4];
#define GT0() const unsigned long long gt0_ = __builtin_amdgcn_s_memtime()
#define GT1() const unsigned long long gt1_ = __builtin_amdgcn_s_memtime()
#define GT2() do { const unsigned long long gt2_ = __builtin_amdgcn_s_memtime(); if (blockIdx.x == 0 && tid == 0) { g_gacc[0] += gt1_ - gt0_; g_gacc[1] += gt2_ - gt1_; g_gacc[2] += 1; } } while (0)
#else
#define GT0() do {} while (0)
#define GT1() do {} while (0)
#define GT2() do {} while (0)
#endif
constexpr int SCR = 133120;
constexpr int SCR_WAVE = SCR, SCR_ROWTAB = SCR + 2048, SCR_CURSOR = SCR + 3072, SCR_U0 = SCR + 3076, SCR_P = SCR + 3136, SCR_N = SCR + 4224, SCR_DUMP = SCR + 5376  ;
__device__ __forceinline__ bf16* po_slot(unsigned char* ws, int s) { return (bf16*)(ws + (s == 3 ? WS_PO : WS_POS + (size_t)s * (ACT_STRIDE * 2))); }

struct KVRegs { bf16x8 sk[4][2], sv[4][2]; };
__device__ __forceinline__ void kv_issue(KVRegs& R, const bf16* Kb, const bf16* Vb, int tid) {
    const int sr = tid >> 4, sc = (tid & 15) * 8;
#pragma unroll
    for (int t = 0; t < 4; ++t) { R.sk[t][0] = load8(Kb + (size_t)(t * 64 + sr) * PITCH + sc); R.sk[t][1] = load8(Kb + (size_t)(t * 64 + 32 + sr) * PITCH + sc);
                                  R.sv[t][0] = load8(Vb + (size_t)(t * 64 + sr) * PITCH + sc); R.sv[t][1] = load8(Vb + (size_t)(t * 64 + 32 + sr) * PITCH + sc); }
}
__device__ __forceinline__ void kv_write(const KVRegs& R, char* V_lds, char* K_lds, int tid) {
    const int sr = tid >> 4, sc = (tid & 15) * 8, kws = KSWZ(sr, sc * 2), vst0 = v_st(sr, sc), vst1 = v_st(32 + sr, sc);
#pragma unroll
    for (int t = 0; t < 4; ++t) { *(bf16x8*)(K_lds + t * SHM_K + kws) = R.sk[t][0]; *(bf16x8*)(K_lds + t * SHM_K + kws + 32 * 256) = R.sk[t][1];
                                  *(bf16x8*)(V_lds + t * SHM_V + vst0) = R.sv[t][0]; *(bf16x8*)(V_lds + t * SHM_V + vst1) = R.sv[t][1]; }
}

template <bool OWN, class LastQ>
__device__ __forceinline__ void attn_tiles(const bf16x8* qr, const char* K_lds, int vb0, int NT, int qlo, int qm, int r32, int hi, float* al_l, f32x16* o, float& m_reg, float& l_reg, LastQ&& last_q) {
#define RESC(a) do { if (__any((a) < 1.f)) { if (hi == 0) al_l[r32] = (a); asm volatile("s_waitcnt lgkmcnt(0)" ::: "memory");              \
                     for (int d_ = 0; d_ < 4; ++d_) for (int r = 0; r < 16; ++r) o[d_][r] *= al_l[crow(r, hi)]; } } while (0)
#define GMASK(P0_, P1_, t) do { if (OWN && (t) * KVBLK + KVBLK - 1 > qlo) mask_causal(P0_, P1_, qm - (t) * KVBLK); } while (0)
    f32x16 pA0, pA1, pB0, pB1; float mnA, mnB, alA, alB; bf16x8 pa0, pa1, pa2, pa3;
    qkt<0>(pA0, pA1, K_lds, r32, hi, qr); if (NT == 1) { SBAR(); last_q(); SBAR(); }
    GMASK(pA0, pA1, 0); partialSM(pA0, pA1, m_reg, mnA, alA);
    if (NT > 1) { SBAR(); qkt<1>(pB0, pB1, K_lds, r32, hi, qr); if (NT == 2) { SBAR(); last_q(); SBAR(); } }
    finishSM(pA0, pA1, alA, l_reg, pa0, pa1, pa2, pa3); SBAR(); pv_tile<0>(o, vb0, pa0, pa1, pa2, pa3);
    if (NT > 1) {
        GMASK(pB0, pB1, 1); partialSM(pB0, pB1, m_reg, mnB, alB); RESC(alB);
        if (NT > 2) { SBAR(); qkt<2>(pA0, pA1, K_lds, r32, hi, qr); if (NT == 3) { SBAR(); last_q(); SBAR(); } }
        finishSM(pB0, pB1, alB, l_reg, pa0, pa1, pa2, pa3); SBAR(); pv_tile<1>(o, vb0, pa0, pa1, pa2, pa3);
        if (NT > 2) {
            GMASK(pA0, pA1, 2); partialSM(pA0, pA1, m_reg, mnA, alA); RESC(alA);
            if (NT > 3) { SBAR(); qkt<3>(pB0, pB1, K_lds, r32, hi, qr); SBAR(); last_q(); SBAR(); }
            finishSM(pA0, pA1, alA, l_reg, pa0, pa1, pa2, pa3); SBAR(); pv_tile<2>(o, vb0, pa0, pa1, pa2, pa3);
            if (NT > 3) { GMASK(pB0, pB1, 3); partialSM(pB0, pB1, m_reg, mnB, alB); RESC(alB);
                finishSM(pB0, pB1, alB, l_reg, pa0, pa1, pa2, pa3); SBAR(); pv_tile<3>(o, vb0, pa0, pa1, pa2, pa3); } } }
#undef RESC
#undef GMASK
}
constexpr int STG = 147456;
__device__ __forceinline__ void attn_store(unsigned char* ws, size_t rb, int h, int ent, const f32x16* o, float m_reg, float l_reg, float* li_l, int* rowtab, char* stg, int r32, int hi) {
    if (hi == 0) { li_l[r32] = l_reg; rowtab[r32] = ent;
        if (ent >= 0) *(f32x2v*)((float*)(ws + WS_ML4) + ((size_t)(ent >> 12) * M + rb + (ent & 4095)) * (2 * AH) + h * 2) = (f32x2v){m_reg, l_reg}; }
    asm volatile("s_waitcnt lgkmcnt(0)" ::: "memory");
    float rl[16];
#pragma unroll
    for (int r = 0; r < 16; ++r) rl[r] = li_l[crow(r, hi)];
    const int lane = r32 + 32 * hi, r16 = (lane >> 2) & 15, ch = lane & 3;
    const int e0 = rowtab[r16], e1 = rowtab[16 + r16];
#pragma unroll
    for (int r = 0; r < 16; ++r) rl[r] = rl[r] > 0.f ? __builtin_amdgcn_rcpf(rl[r]) : 0.f;
    const bool odd = (r32 & 1) != 0;
    char* wr = stg + (odd ? 1024 : 0) + (r32 & ~1) * 2;
    const char* rd = stg + r16 * 64 + ch * 16;
#pragma unroll
    for (int hf = 0; hf < 2; ++hf) { const int e = hf ? e1 : e0;
        bf16* dst = po_slot(ws, (e >= 0 ? e : 0) >> 12) + (rb + (size_t)((e >= 0 ? e : 0) & 4095)) * W + h * AD + ch * 8;
#pragma unroll
        for (int pp = 0; pp < 2; ++pp) {
#pragma unroll
            for (int r8 = 0; r8 < 8; ++r8) { const int r = hf * 8 + r8; const float va = o[2 * pp][r] * rl[r], vb = o[2 * pp + 1][r] * rl[r];
                const float x = odd ? va : vb;
                const float y = __builtin_bit_cast(float, __builtin_amdgcn_update_dpp(0, __builtin_bit_cast(int, x), 0xB1  , 0xF, 0xF, true));
                const unsigned pk = cvt_pk_bf16(odd ? y : va, odd ? vb : y);
                *(unsigned*)(wr + (crow(r, hi) - 16 * hf) * 64) = pk; }
            const v4u q0 = *(const v4u*)rd, q1 = *(const v4u*)(rd + 1024);
            if (e >= 0) { __builtin_nontemporal_store(q0, (v4u*)(dst + (2 * pp) * 32)); __builtin_nontemporal_store(q1, (v4u*)(dst + (2 * pp + 1) * 32)); } } }
}

constexpr int KM_ROW = 272;
constexpr int SCR_CW = SCR_P, SCR_PRE = SCR_N, SCR_BASE = SCR_N + 512;
template <class Arrive> __device__ __forceinline__ void select_own(unsigned char* ws, char* lds, gu32* cnt, int bh, int j, Arrive&& arrive) {
    const int tid = opaque_tid(), wid = __builtin_amdgcn_readfirstlane(tid >> 6), lane = tid & 63, r32 = lane & 31, hi = lane >> 5;
    const int b = bh >> 3, h = bh & 7; const size_t rb = (size_t)b * SEQ;
    const bf16* act = (const bf16*)(ws + WS_ACT);
    const bf16* Q = act + A_QA * ACT_STRIDE + (rb + (size_t)j * MBLK) * W + h * AD;
    const float* KM = (const float*)(ws + WS_KMEAN) + (size_t)(b * NBLK) * W + h * AD;
    char* V_lds = lds; char* K_lds = lds + 4 * SHM_V; char* KMH = lds; char* KML = lds + 16 * KM_ROW;
    const f32x4 km0 = *(const f32x4*)(KM + (size_t)(tid >> 5) * W + (tid & 31) * 4), km1 = *(const f32x4*)(KM + KM_SLOT + (size_t)(tid >> 5) * W + (tid & 31) * 4);
    bf16x8 qr[8];
#pragma unroll
    for (int d0 = 0; d0 < 8; ++d0) qr[d0] = load8(Q + (size_t)(wid * QBLK + r32) * PITCH + d0 * 16 + hi * 8);
    KVRegs R; kv_issue(R, act + A_KA * ACT_STRIDE + (rb + (size_t)j * MBLK) * W + h * AD, act + A_VA * ACT_STRIDE + (rb + (size_t)j * MBLK) * W + h * AD, tid);
    { const f32x4 a = km0 + km1; const unsigned h01 = cvt_pk_bf16(a[0], a[1]), h23 = cvt_pk_bf16(a[2], a[3]);
      const unsigned l01 = cvt_pk_bf16(a[0] - bflo(h01), a[1] - bfhi(h01)), l23 = cvt_pk_bf16(a[2] - bflo(h23), a[3] - bfhi(h23));
      const int o_ = (tid >> 5) * KM_ROW + (tid & 31) * 8; *(v2u*)(KMH + o_) = (v2u){h01, h23}; *(v2u*)(KML + o_) = (v2u){l01, l23}; }
    __syncthreads();
    unsigned sel = 0u;
    if (j > 0) {
        f32x16 sc_ = f32x16{};
        const char* ka = KMH + (r32 & 15) * KM_ROW + hi * 16;
#pragma unroll
        for (int d0 = 0; d0 < 8; ++d0) { const bf16x8 ah = *(const bf16x8*)(ka + d0 * 32), al = *(const bf16x8*)(ka + 16 * KM_ROW + d0 * 32);
            sc_ = __builtin_amdgcn_mfma_f32_32x32x16_bf16(ah, qr[d0], sc_, 0, 0, 0); sc_ = __builtin_amdgcn_mfma_f32_32x32x16_bf16(al, qr[d0], sc_, 0, 0, 0); }
        float v[16];
#pragma unroll
        for (int n = 0; n < 16; ++n) { const int idx = (n & 3) + 4 * (n >> 3); const float own = sc_[idx], oth = __shfl_xor(own, 32); v[n] = (hi == ((n >> 2) & 1)) ? own : oth; }
#pragma unroll
        for (int k = 0; k < 3; ++k) { float best = -__builtin_inff(); int bi = -1;
#pragma unroll
            for (int n = 0; n < 15; ++n) { const bool ok = n < j && !((sel >> n) & 1u) && (bi < 0 || v[n] > best); if (ok) { best = v[n]; bi = n; } }
            if (bi >= 0) sel |= 1u << bi; }
    }
    const int rowb = j * MBLK + wid * QBLK + r32;
    if (hi == 0) { const int ns = __builtin_popcount(sel); float* ml = (float*)(ws + WS_ML4) + (rb + rowb) * (2 * AH) + h * 2;
#pragma unroll
        for (int s = 0; s < 3; ++s) if (s >= ns) *(f32x2v*)(ml + (size_t)s * M * (2 * AH)) = (f32x2v){-1e30f, 0.f}; }
    int* cw = (int*)(lds + SCR_CW); int* pre = (int*)(lds + SCR_PRE);
#pragma unroll
    for (int k = 0; k < 15; ++k) { const unsigned long long mk = __ballot(hi == 0 && ((sel >> k) & 1u)); if (lane == 0) cw[wid * 16 + k] = __builtin_popcountll(mk); }
    TSP(30);
    __syncthreads();
    VMW(); kv_write(R, V_lds, K_lds, tid);
    if (tid < 16) { int run = 0;
#pragma unroll
        for (int w = 0; w < NW; ++w) { pre[w * 16 + tid] = run; run += cw[w * 16 + tid]; }
        if (tid < j) cnt[(bh * NBLK + tid) * NBLK + j] = (unsigned)run; }
    __syncthreads();
    TSP(31);
    unsigned* lists = (unsigned*)(ws + WS_LIST) + (size_t)(bh * NBLK) * LCAP + j * MBLK;
#pragma unroll
    for (int k = 0; k < 15; ++k) { const bool s = hi == 0 && k < j && ((sel >> k) & 1u); const unsigned long long mk = __ballot(s);
        if (s) lists[(size_t)k * LCAP + pre[wid * 16 + k] + __builtin_popcountll(mk & ((1ull << lane) - 1ull))] = (unsigned)rowb | ((unsigned)__builtin_popcount(sel & ((1u << k) - 1u)) << 12); }
    arrive();
    TSP(32);
    { float* wsc = (float*)(lds + SCR_WAVE) + wid * 64; int* rowtab = (int*)(lds + SCR_ROWTAB) + wid * 32;
      const int vb0 = (int)(uintptr_t)V_lds + v_rd_base(lane), qlo = wid * QBLK, qm = qlo + r32 - 4 * hi, NT = ((qlo + QBLK - 1) >> 6) + 1;
      float m_reg = -1e30f, l_reg = 0; f32x16 o[4] = {};
      attn_tiles<true>(qr, K_lds, vb0, NT, qlo, qm, r32, hi, wsc + 32, o, m_reg, l_reg, [] {});
      attn_store(ws, rb, h, rowb | (3 << 12), o, m_reg, l_reg, wsc, rowtab, lds + STG + wid * 2048, r32, hi); }
    TSP(33);
}

__device__ __forceinline__ void gather_unit(unsigned char* ws, char* lds, const gu32* cnt, int bh, int k, int n, int gb0, int gb1) {
    const int tid = opaque_tid(), wid = __builtin_amdgcn_readfirstlane(tid >> 6), lane = tid & 63, r32 = lane & 31, hi = lane >> 5;
    const int b = bh >> 3, h = bh & 7; const size_t rb = (size_t)b * SEQ;
    const bf16* act = (const bf16*)(ws + WS_ACT);
    const bf16* Qb = act + A_QA * ACT_STRIDE + rb * W + h * AD;
    const unsigned* list = (const unsigned*)(ws + WS_LIST) + (size_t)(bh * NBLK + k) * LCAP;
    char* V_lds = lds; char* K_lds = lds + 4 * SHM_V;
    float* wsc = (float*)(lds + SCR_WAVE) + wid * 64; int* rowtab = (int*)(lds + SCR_ROWTAB) + wid * 32; int* cursor = (int*)(lds + SCR_CURSOR); int* seg = (int*)(lds + SCR_DUMP);
    { KVRegs R; kv_issue(R, act + A_KA * ACT_STRIDE + (rb + (size_t)k * MBLK) * W + h * AD, act + A_VA * ACT_STRIDE + (rb + (size_t)k * MBLK) * W + h * AD, tid);
      int sc_[16];
      if (tid == 0) {
#pragma unroll
          for (int j = 0; j < 16; ++j) sc_[j] = j > k ? (int)__hip_atomic_load(cnt + (bh * NBLK + k) * NBLK + j, RLX_AGENT) : 0; }
      __syncthreads();
      if (tid == 0) { *cursor = 0; int run = 0;
#pragma unroll
          for (int j = 0; j < 16; ++j) { seg[j] = run; run += sc_[j]; }
          seg[16] = run; }
      VMW(); kv_write(R, V_lds, K_lds, tid); }
    __syncthreads();
    const int vb0 = (int)(uintptr_t)V_lds + v_rd_base(lane), n_items = gb1 - gb0;
#define GRAB(dst) do { int g_ = 0; if (lane == 0) g_ = __hip_atomic_fetch_add(cursor, 1, __ATOMIC_RELAXED, __HIP_MEMORY_SCOPE_WORKGROUP); dst = __builtin_amdgcn_readfirstlane(g_); } while (0)
#define ENTRY(dst, it_) do { int ix_ = (gb0 + (it_)) * 32 + r32; if (ix_ >= n) ix_ = (gb0 + (it_)) * 32; int sg_ = 0; \
        _Pragma("unroll") for (int j_ = 1; j_ < 16; ++j_) sg_ += seg[j_] <= ix_ ? 1 : 0;                  \
        dst = list[sg_ * MBLK + ix_ - seg[sg_]]; } while (0)
    int it; GRAB(it);
    if (it >= n_items) return;
    unsigned e; ENTRY(e, it);
    bf16x8 qr[8];
#pragma unroll
    for (int d0 = 0; d0 < 8; ++d0) qr[d0] = load8(Qb + (size_t)(e & 4095u) * PITCH + d0 * 16 + hi * 8);
    for (;;) {
        int it2; GRAB(it2);
        const bool more = it2 < n_items; unsigned e2 = 0u; if (more) ENTRY(e2, it2);
        const int ent = ((gb0 + it) * 32 + r32 < n) ? (int)e : -1;
        float m_reg = -1e30f, l_reg = 0; f32x16 o[4] = {};
        GT0();
        attn_tiles<false>(qr, K_lds, vb0, 4, 0, 0, r32, hi, wsc + 32, o, m_reg, l_reg, [&] { if (more) {
#pragma unroll
            for (int d0 = 0; d0 < 8; ++d0) qr[d0] = load8(Qb + (size_t)(e2 & 4095u) * PITCH + d0 * 16 + hi * 8); } });
        GT1();
        attn_store(ws, rb, h, ent, o, m_reg, l_reg, wsc, rowtab, lds + STG + wid * 2048, r32, hi);
        GT2();
        if (!more) break;
        it = it2; e = e2;
    }
#undef GRAB
#undef ENTRY
}
#undef VMW
}


namespace mix {
#if defined(TS_PHASE) && TS_PHASE >= 110 && TS_PHASE <= 119
__device__ unsigned long long g_mt[8];
#define MT(i) do { if (blockIdx.x == 0 && tid == 0) g_mt[i] = __builtin_amdgcn_s_memtime(); } while (0)
#else
#define MT(i) do {} while (0)
#endif
using moba::f32x16; using moba::s16x4; using moba::u32x4; using moba::crow; using moba::v_st; using moba::v_rd_base; using moba::SHM_V;
__device__ __forceinline__ void slab_put(char* slab, float v, int row, int col, int r32) { const float vn = __builtin_bit_cast(float, __builtin_amdgcn_update_dpp(0, __builtin_bit_cast(int, v), 0xB1  , 0xF, 0xF, true)); if ((r32 & 1) == 0) *(unsigned*)(slab + row * 256 + col * 2) = cvt_pk_bf16(v, vn); }
__device__ __forceinline__ void slab_put2(char* slab, float va, float vb, int row, int da, int db, int r32) { const bool odd = (r32 & 1) != 0; const float x = odd ? va : vb;
    const float y = __builtin_bit_cast(float, __builtin_amdgcn_update_dpp(0, __builtin_bit_cast(int, x), 0xB1, 0xF, 0xF, true));
    *(unsigned*)(slab + row * 256 + ((odd ? db : da) * 32 + (r32 & ~1)) * 2) = cvt_pk_bf16(odd ? y : va, odd ? vb : y); }
template <bool TWO> __device__ __forceinline__ void slab_mul_store(const char* slab, const bf16* A, const bf16* B, bf16* Y, size_t e0  , int lane) {
    asm volatile("s_waitcnt lgkmcnt(0)" ::: "memory");
#pragma unroll
    for (int h = 0; h < 2; ++h) { v4u a[4], b[4];
#pragma unroll
        for (int i = 0; i < 4; ++i) { const size_t e = e0 + (size_t)((h * 4 + i) * 4 + (lane >> 4)) * W + (lane & 15) * 8; a[i] = *(const v4u*)(A + e); if (TWO) b[i] = *(const v4u*)(B + e); }
#pragma unroll
        for (int i = 0; i < 4; ++i) { const int row = (h * 4 + i) * 4 + (lane >> 4); const v4u sv = *(const v4u*)(slab + row * 256 + (lane & 15) * 16); v4u o;
#pragma unroll
            for (int j = 0; j < 4; ++j) { float lo = bflo(sv[j]) * bflo(a[i][j]), hi = bfhi(sv[j]) * bfhi(a[i][j]); if (TWO) { lo *= bflo(b[i][j]); hi *= bfhi(b[i][j]); } o[j] = cvt_pk_bf16(lo, hi); }
            *(v4u*)(Y + e0 + (size_t)row * W + (lane & 15) * 8) = o; } }
}
template <bool TWO> __device__ __forceinline__ void slab_loads(const bf16* A, const bf16* B, size_t e0, int lane, v4u (&a)[8], v4u (&b)[8]) {
#pragma unroll
    for (int i = 0; i < 8; ++i) { const size_t e = e0 + (size_t)(i * 4 + (lane >> 4)) * W + (lane & 15) * 8; a[i] = __builtin_nontemporal_load((const v4u*)(A + e)); if (TWO) b[i] = __builtin_nontemporal_load((const v4u*)(B + e)); }
}
template <bool TWO> __device__ __forceinline__ void slab_finish(const char* slab, const v4u (&a)[8], const v4u (&b)[8], bf16* Y, size_t e0, int lane) {
    asm volatile("s_waitcnt lgkmcnt(0)" ::: "memory");
#pragma unroll
    for (int i = 0; i < 8; ++i) { const int row = i * 4 + (lane >> 4); const v4u sv = *(const v4u*)(slab + row * 256 + (lane & 15) * 16); v4u o;
#pragma unroll
        for (int j = 0; j < 4; ++j) { float lo = bflo(sv[j]) * bflo(a[i][j]), hi = bfhi(sv[j]) * bfhi(a[i][j]); if (TWO) { lo *= bflo(b[i][j]); hi *= bfhi(b[i][j]); } o[j] = cvt_pk_bf16(lo, hi); }
        *(v4u*)(Y + e0 + (size_t)row * W + (lane & 15) * 8) = o; }
}
__device__ __forceinline__ void sgu_unit(char* lds, unsigned char* ws, const float* b_s, const float* lng, const float* lnb, int b, int c, int gp) {
    const int tid = opaque_tid(), wid = __builtin_amdgcn_readfirstlane(tid >> 6), lane = tid & 63, r32 = lane & 31, hi = lane >> 5, hw = wid >> 2, tb = wid & 3, g = 2 * gp + hw;
    const size_t row0 = (size_t)b * SEQ + (size_t)c * SC;
    const bf16* act = (const bf16*)(ws + WS_ACT); const bf16* UG = act + A_UG * ACT_STRIDE; const bf16* VG = act + A_VG * ACT_STRIDE; const bf16* ZG = act + A_ZG * ACT_STRIDE; bf16* YG = (bf16*)(ws + WS_Y) + ACT_STRIDE;
    const float* vst = (const float*)(ws + WS_VSTATS); const bf16* wsb = (const bf16*)(ws + WS_WSB); const float* c2 = (const float*)(ws + WS_C2);
    char* V_lds = lds + hw * 2 * SHM_V; f32x2v* stab = (f32x2v*)(lds + 132096);
    const int ht = tid & 255; v4u raw[8];
#pragma unroll
    for (int i = 0; i < 8; ++i) { const int idx = ht + 256 * i, s_ = idx >> 4, col = (idx & 15) * 8; raw[i] = *(const v4u*)(VG + (row0 + s_) * W + g * SGD + col); }
    const bf16* wrow = wsb + ((size_t)g * SC + tb * 32 + r32) * SC + hi * 8;
    bf16x8 wa[8];
#pragma unroll
    for (int k = 0; k < 4; ++k) wa[k] = *(const bf16x8*)(wrow + 16 * k);
    if (tb >= 2) {
#pragma unroll
        for (int k = 4; k < 8; ++k) wa[k] = *(const bf16x8*)(wrow + 16 * k); }
    float gm[4], bt[4], cc[16], bb[16];
#pragma unroll
    for (int d0 = 0; d0 < 4; ++d0) { gm[d0] = lng[g * SGD + d0 * 32 + r32]; bt[d0] = lnb[g * SGD + d0 * 32 + r32]; }
#pragma unroll
    for (int r = 0; r < 16; ++r) { cc[r] = 0.f; bb[r] = 0.f; }
    f32x2v* cbt = (f32x2v*)(lds + 133120) + wid * 32;
    const f32x2v cb_mine = (f32x2v){c2[g * SC + tb * 32 + r32], b_s[g * SC + tb * 32 + r32]};
    if (tid < SC) { const f32x4* sp = (const f32x4*)(vst + (row0 + tid) * 32); float s = 0.f, q = 0.f;
#pragma unroll
        for (int j = 0; j < 8; ++j) { const f32x4 w = sp[j]; s += w[0] + w[2]; q += w[1] + w[3]; }
        const float mean = s * (1.0f / W), var = q * (1.0f / W) - mean * mean; stab[tid] = (f32x2v){mean, 1.0f / sqrtf(var + LN_EPS)}; }
    if (hi == 0) cbt[r32] = cb_mine;
    __syncthreads();
#pragma unroll
    for (int r = 0; r < 16; ++r) { const f32x2v cb = cbt[crow(r, hi)]; cc[r] = cb.x; bb[r] = cb.y; }
#pragma unroll
    for (int i = 0; i < 8; ++i) { const int idx = ht + 256 * i, s_ = idx >> 4, col = (idx & 15) * 8; const f32x2v st = stab[s_]; v4u o;
#pragma unroll
        for (int j = 0; j < 4; ++j) o[j] = cvt_pk_bf16((bflo(raw[i][j]) - st.x) * st.y, (bfhi(raw[i][j]) - st.x) * st.y);
        *(v4u*)(V_lds + (s_ >> 6) * SHM_V + v_st(s_ & 63, col)) = o; }
    __syncthreads();
    f32x16 o[4] = {};
    const int vb0 = (int)(uintptr_t)V_lds + v_rd_base(lane);
    v4u ua[8], za[8]; const size_t e0s = (row0 + tb * 32) * W + g * SGD; slab_loads<true>(UG, ZG, e0s, lane, ua, za);
    moba::pv_tile<0>(o, vb0, wa[0], wa[1], wa[2], wa[3]);
    if (tb >= 2) moba::pv_tile<1>(o, vb0, wa[4], wa[5], wa[6], wa[7]);
    char* slab = lds + 4 * SHM_V + wid * 8192;
#pragma unroll
    for (int r = 0; r < 16; ++r) { const int tl = crow(r, hi);
#pragma unroll
        for (int d0 = 0; d0 < 4; d0 += 2) slab_put2(slab, gm[d0] * o[d0][r] + bt[d0] * cc[r] + bb[r], gm[d0 + 1] * o[d0 + 1][r] + bt[d0 + 1] * cc[r] + bb[r], tl, d0, d0 + 1, r32); }
    slab_finish<true>(slab, ua, za, YG, e0s, lane);
    __syncthreads();
}
__device__ __forceinline__ void mem_unit(char* lds, unsigned char* ws, int b, int h, int qb, int dh) {
    const int tid = opaque_tid(), wid = __builtin_amdgcn_readfirstlane(tid >> 6), lane = tid & 63, r32 = lane & 31, hi = lane >> 5;
    const bf16* act = (const bf16*)(ws + WS_ACT); const bf16* QC = act + A_QC * ACT_STRIDE; const bf16* ZC = act + A_ZC * ACT_STRIDE; bf16* YC = (bf16*)(ws + WS_Y) + 2 * ACT_STRIDE;
    const bf16* MK = (const bf16*)(ws + WS_MEMK) + (size_t)b * NMEM * W + h * MD; const bf16* MV = (const bf16*)(ws + WS_MEMV) + (size_t)b * NMEM * W + h * MD + dh * 128;
    const size_t qrow = (size_t)b * SEQ + (size_t)qb * 256 + wid * 32 + r32;
    MT(0);
    v4u kst[16];
#pragma unroll
    for (int i = 0; i < 16; ++i) { const int idx = tid + 512 * i, key = idx >> 5, ch = idx & 31; kst[i] = *(const v4u*)(MK + (size_t)key * W + ch * 8); }
    bf16x8 qr[16];
#pragma unroll
    for (int d0 = 0; d0 < 16; ++d0) qr[d0] = *(const bf16x8*)(QC + qrow * W + h * MD + d0 * 16 + hi * 8);
#pragma unroll
    for (int i = 0; i < 16; ++i) { const int idx = tid + 512 * i, key = idx >> 5, ch = idx & 31; *(v4u*)(lds + key * 512 + ((ch ^ (key & 7)) << 4)) = kst[i]; }
    __syncthreads();
    MT(1);
    v4u vraw[8];
#pragma unroll
    for (int i = 0; i < 8; ++i) { const int idx = tid + 512 * i, key = idx >> 4, col = (idx & 15) * 8; vraw[i] = *(const v4u*)(MV + (size_t)key * W + col); }
    f32x16 p[8];
#pragma unroll
    for (int kg = 0; kg < 8; ++kg) { p[kg] = f32x16{};
        const char* kb = lds + (kg * 32 + r32) * 512;
#pragma unroll
        for (int d0 = 0; d0 < 16; ++d0) { const bf16x8 kf = *(const bf16x8*)(kb + (((2 * d0 + hi) ^ (r32 & 7)) << 4)); p[kg] = __builtin_amdgcn_mfma_f32_32x32x16_bf16(kf, qr[d0], p[kg], 0, 0, 0); } }
    MT(2);
    constexpr float C2 = 1.4426950408889634f * 0.0625f;
    float mx = p[0][0];
#pragma unroll
    for (int kg = 0; kg < 8; ++kg)
#pragma unroll
        for (int r = 0; r < 16; ++r) mx = fmaxf(mx, p[kg][r]);
    { auto rr = __builtin_amdgcn_permlane32_swap(__float_as_uint(mx), __float_as_uint(mx), false, false); mx = fmaxf(__uint_as_float(rr[0]), __uint_as_float(rr[1])); }
    const float mnl = -mx * C2; float ls = 0.f;
#pragma unroll
    for (int kg = 0; kg < 8; ++kg)
#pragma unroll
        for (int r = 0; r < 16; ++r) { p[kg][r] = __builtin_amdgcn_exp2f(fmaf(p[kg][r], C2, mnl)); ls += p[kg][r]; }
    { auto rr = __builtin_amdgcn_permlane32_swap(__float_as_uint(ls), __float_as_uint(ls), false, false); ls = __uint_as_float(rr[0]) + __uint_as_float(rr[1]); }
    bf16x8 pa[4][4];
#define MIX_PK4(P, B_, OUT) do { unsigned a0 = cvt_pk_bf16(P[B_+0], P[B_+1]), a1 = cvt_pk_bf16(P[B_+2], P[B_+3]);                          \
        unsigned b0 = cvt_pk_bf16(P[B_+4], P[B_+5]), b1 = cvt_pk_bf16(P[B_+6], P[B_+7]);                                             \
        auto r0 = __builtin_amdgcn_permlane32_swap(a0, b0, false, false); auto r1 = __builtin_amdgcn_permlane32_swap(a1, b1, false, false); \
        u32x4 w = {r0[0], r1[0], r0[1], r1[1]}; OUT = *reinterpret_cast<bf16x8*>(&w); } while (0)
#pragma unroll
    for (int t = 0; t < 4; ++t) { MIX_PK4(p[2 * t], 0, pa[t][0]); MIX_PK4(p[2 * t], 8, pa[t][1]); MIX_PK4(p[2 * t + 1], 0, pa[t][2]); MIX_PK4(p[2 * t + 1], 8, pa[t][3]); }
#undef MIX_PK4
    MT(3);
    __syncthreads();
#pragma unroll
    for (int i = 0; i < 8; ++i) { const int idx = tid + 512 * i, key = idx >> 4, col = (idx & 15) * 8; *(v4u*)(lds + (key >> 6) * SHM_V + v_st(key & 63, col)) = vraw[i]; }
    __syncthreads();
    MT(4);
    f32x16 o[4] = {};
    const int vb0 = (int)(uintptr_t)lds + v_rd_base(lane);
    v4u zc[8], zdummy[8]; const size_t e0m = ((size_t)b * SEQ + (size_t)qb * 256 + wid * 32) * W + h * MD + dh * 128; slab_loads<false>(ZC, nullptr, e0m, lane, zc, zdummy);
    moba::pv_tile<0>(o, vb0, pa[0][0], pa[0][1], pa[0][2], pa[0][3]); moba::pv_tile<1>(o, vb0, pa[1][0], pa[1][1], pa[1][2], pa[1][3]);
    moba::pv_tile<2>(o, vb0, pa[2][0], pa[2][1], pa[2][2], pa[2][3]); moba::pv_tile<3>(o, vb0, pa[3][0], pa[3][1], pa[3][2], pa[3][3]);
    MT(5);
    const float rl = __builtin_amdgcn_rcpf(ls);
    char* slab = lds + 4 * SHM_V + wid * 8192;
    float rliv[16];
#pragma unroll
    for (int r = 0; r < 16; ++r) rliv[r] = __shfl(rl, crow(r, hi));
#pragma unroll
    for (int r = 0; r < 16; ++r) { const int orow = crow(r, hi);
#pragma unroll
        for (int d0 = 0; d0 < 4; d0 += 2) slab_put2(slab, o[d0][r] * rliv[r], o[d0 + 1][r] * rliv[r], orow, d0, d0 + 1, r32); }
    MT(6);
    slab_finish<false>(slab, zc, zdummy, YC, e0m, lane);
    __syncthreads();
    MT(7);
}
}


constexpr int NWAVES = 8;
constexpr int RING_BYTES = 131072;
constexpr int LDSCTL_OFF = RING_BYTES, MISC_OFF = LDSCTL_OFF + 320;
constexpr int LDS_BYTES = 163840;
constexpr int CW_TMO = 0, CW_CODE = 1, CW_LCNT = 16384  , CW_BAR = 4096;
constexpr int N_PHASES = 6;

struct Frame {
    LAS unsigned char* lds;
    volatile LAS unsigned* MISC;
    gu32* ctl;
    int vcu, G;
    const float *x, *mem, *w_in, *w_mk, *w_mv, *w_s, *b_s, *lnvg, *lnvb, *wba, *wbg, *wbm, *w_out, *ln_g, *ln_b; float* out;
    unsigned char* ws;
};

__device__ __forceinline__ float wave_sum(float v) {
#pragma unroll
    for (int o = 1; o < 64; o <<= 1) v += __shfl_xor(v, o);
    return v;
}
template <bool DEEP = false> __device__ __forceinline__ void p0_transpose_item(const float* Wm, int K, int N, bf16* WT, int row_off, LAS float* scr, int item, int lane) {
    const int nblk = N / 32, kb = item / nblk, nb = item % nblk, k0 = 64 * kb, n0 = 32 * nb;
    if (DEEP) { float t[32];
#pragma unroll
        for (int i = 0; i < 32; ++i) t[i] = __builtin_nontemporal_load(Wm + (size_t)(k0 + 2 * i + (lane >> 5)) * N + n0 + (lane & 31));
#pragma unroll
        for (int i = 0; i < 32; ++i) scr[(2 * i + (lane >> 5)) * 33 + (lane & 31)] = t[i]; }
    else {
#pragma unroll 8
    for (int i = 0; i < 32; ++i) { const int kk = 2 * i + (lane >> 5); scr[kk * 33 + (lane & 31)] = Wm[(size_t)(k0 + kk) * N + n0 + (lane & 31)]; } }
    LDS_WAIT(); asm volatile("" ::: "memory");
    const int c = lane & 7;
#pragma unroll
    for (int j = 0; j < 4; ++j) { const int n = (lane >> 3) + 8 * j; const LAS float* s = scr + (8 * c) * 33 + n;
        v4u o; o.x = pk2(s[0 * 33], s[1 * 33]); o.y = pk2(s[2 * 33], s[3 * 33]); o.z = pk2(s[4 * 33], s[5 * 33]); o.w = pk2(s[6 * 33], s[7 * 33]);
        *(GAS v4u*)(WT + (size_t)(row_off + n0 + n) * K + k0 + 8 * c) = o; }
    LDS_WAIT(); asm volatile("" ::: "memory");
}
__device__ __forceinline__ void p0_transpose_item_q8(const float* Wm, int K, int N, int col_off, int ncols, float sc, unsigned char* WT, LAS float* scr, int item, int lane) {
    const int nblk = ncols / 32, kb = item / nblk, nb = item % nblk, k0 = 64 * kb, n0 = 32 * nb;
    { f32x4 t[8];
#pragma unroll
      for (int i = 0; i < 8; ++i) t[i] = __builtin_nontemporal_load((const f32x4*)(Wm + (size_t)(k0 + 8 * i + (lane >> 3)) * N + col_off + n0 + 4 * (lane & 7)));
#pragma unroll
      for (int i = 0; i < 8; ++i)
#pragma unroll
          for (int j = 0; j < 4; ++j) scr[(8 * i + (lane >> 3)) * 33 + 4 * (lane & 7) + j] = t[i][j]; }
    LDS_WAIT(); asm volatile("" ::: "memory");
    const int n = lane >> 1, kh = (lane & 1) * 32; const LAS float* s = scr + kh * 33 + n; v4u o[2];
#pragma unroll
    for (int q = 0; q < 8; ++q) o[q >> 2][q & 3] = pk4_i8(s[(4 * q) * 33], s[(4 * q + 1) * 33], s[(4 * q + 2) * 33], s[(4 * q + 3) * 33], sc);
    GAS v4u* dst = (GAS v4u*)(WT + (size_t)(n0 + n) * K + k0 + kh); dst[0] = o[0]; dst[1] = o[1];
    LDS_WAIT(); asm volatile("" ::: "memory");
}
__device__ __forceinline__ void p0_prologue(Frame& F) {
    const int tid_ = opaque_tid(), lane = tid_ & 63, wave = __builtin_amdgcn_readfirstlane(tid_ >> 6);
    LAS float* scr = (LAS float*)(F.lds + wave * 16384);
    const int gw = F.vcu * NWAVES + wave, NGW = F.G * NWAVES;
    constexpr int I_GQ = (DM / 64) * (NPROJ / 32), I_MK = (DM / 64) * (W / 32);
    constexpr int NITEMS = I_GQ + 2 * I_MK;
    for (int it = gw; it < NITEMS; it += NGW) {
        int r = it;
        if (r < I_GQ) { const int nb = r % (NPROJ / 32); const bool beta = (nb >= 64 && nb < 96) || (nb >= 128 && nb < 192);
            p0_transpose_item_q8(F.w_in, DM, NPROJ, 0, NPROJ, beta ? QWB : QW, F.ws + WS_WQ, scr, r, lane); continue; } r -= I_GQ;
        if (r < I_MK) { p0_transpose_item_q8(F.w_mk, DM, W, 0, W, QW, F.ws + WS_WQ + (size_t)NPROJ * DM, scr, r, lane); continue; } r -= I_MK;
        p0_transpose_item_q8(F.w_mv, DM, W, 0, W, QWB, F.ws + WS_WQ + (size_t)(NPROJ + W) * DM, scr, r, lane);
    }
    { GAS v2u* xq = (GAS v2u*)(F.ws + WS_XQ); const GAS f32x4* xs = (const GAS f32x4*)F.x;
      for (int i = gw; i < (M * DM) / 512; i += NGW) { const size_t ch = (size_t)i * 64 + lane; const f32x4 a = __builtin_nontemporal_load(xs + 2 * ch), b = __builtin_nontemporal_load(xs + 2 * ch + 1);
          xq[ch] = (v2u){pk4_i8(a[0], a[1], a[2], a[3], QX), pk4_i8(b[0], b[1], b[2], b[3], QX)}; }
      GAS v2u* mq = (GAS v2u*)(F.ws + WS_MQ); const GAS f32x4* ms = (const GAS f32x4*)F.mem;
      for (int i = gw; i < (MM * DM) / 512; i += NGW) { const size_t ch = (size_t)i * 64 + lane; const f32x4 a = ms[2 * ch], b = ms[2 * ch + 1];
          mq[ch] = (v2u){pk4_i8(a[0], a[1], a[2], a[3], QX), pk4_i8(b[0], b[1], b[2], b[3], QX)}; } }
    { bf16* wsb = (bf16*)(F.ws + WS_WSB); float* c2 = (float*)(F.ws + WS_C2);
      for (int row = gw; row < SG * SC; row += NGW) { const int t = row % SC; float s = 0.f;
#pragma unroll
          for (int h = 0; h < 2; ++h) { const int sidx = lane + 64 * h; const float w = sidx <= t ? F.w_s[(size_t)row * SC + sidx] : 0.f; const unsigned short wb = (unsigned short)f2bf(w); wsb[(size_t)row * SC + sidx] = wb; s += bf2f(wb); }
          s = wave_sum(s); if (lane == 0) c2[row] = s; } }
}

__device__ __forceinline__ void p0_late(Frame& F, int me, int nw) {
    const int tid_ = opaque_tid(), lane = tid_ & 63, wave = __builtin_amdgcn_readfirstlane(tid_ >> 6);
    LAS float* scr = (LAS float*)(F.lds + wave * 16384);
    bf16* WBR = (bf16*)(F.ws + WS_WBR);
    constexpr int I_BR = (W / 64) * (DM / 32), I_OUT = (DM / 64) * (DM / 32);
    for (int it = me * NWAVES + wave; it < 3 * I_BR + I_OUT; it += nw * NWAVES) {
        int r = it;
        if (r < I_BR) { p0_transpose_item<true>(F.wba, W, DM, WBR, 0, scr, r, lane); continue; } r -= I_BR;
        if (r < I_BR) { p0_transpose_item<true>(F.wbg, W, DM, WBR, DM, scr, r, lane); continue; } r -= I_BR;
        if (r < I_BR) { p0_transpose_item<true>(F.wbm, W, DM, WBR, 2 * DM, scr, r, lane); continue; } r -= I_BR;
        p0_transpose_item_q8(F.w_out, DM, DM, 0, DM, QWB, F.ws + WS_WOUT, scr, r, lane);
    }
}
constexpr int CW_COMB = 2, COMB_ROWS = 16;
__device__ __forceinline__ void p3_combine(Frame& F) {
    const int tid_ = opaque_tid(), lane = tid_ & 63, wave = __builtin_amdgcn_readfirstlane(tid_ >> 6);
    const float* ml4 = (const float*)(F.ws + WS_ML4);
    const bf16* za = (const bf16*)(F.ws + WS_ACT) + A_ZA * ACT_STRIDE; bf16* ya = (bf16*)(F.ws + WS_Y);
    constexpr float C2 = 1.4426950408889634f * moba::SCALE;
    volatile LAS int* slot = (volatile LAS int*)(F.lds + moba::SCR_U0);
    if (tid_ == 0) *slot = (int)__hip_atomic_fetch_add(F.ctl + CW_COMB, 1u, RLX_AGENT);
    __syncthreads();
    int c = __builtin_amdgcn_readfirstlane(*slot);
    while (c < M / COMB_ROWS) {
        int nxt = 0; if (tid_ == 0) nxt = (int)__hip_atomic_fetch_add(F.ctl + CW_COMB, 1u, RLX_AGENT);
        const int row = c * COMB_ROWS + wave * 2;
        f32x2v ml[4][4]; v4u p[4][4], z[4]; size_t e[4];
#pragma unroll
        for (int q = 0; q < 4; ++q) { const int r_ = row + (q >> 1), col = (q & 1) * 512 + lane * 8, head = col >> 7; e[q] = (size_t)r_ * W + col;
#pragma unroll
            for (int s = 0; s < 4; ++s) { ml[q][s] = *(const f32x2v*)(ml4 + ((size_t)s * M + r_) * (2 * AH) + head * 2); p[q][s] = __builtin_nontemporal_load((const v4u*)(moba::po_slot(F.ws, s) + e[q])); }
            z[q] = __builtin_nontemporal_load((const v4u*)(za + e[q])); }
#pragma unroll
        for (int q = 0; q < 4; ++q) {
            const float mx = fmaxf(fmaxf(ml[q][0].x, ml[q][1].x), fmaxf(ml[q][2].x, ml[q][3].x)); float w[4], ws_ = 0.f;
#pragma unroll
            for (int s = 0; s < 4; ++s) { w[s] = ml[q][s].y * __builtin_amdgcn_exp2f((ml[q][s].x - mx) * C2); ws_ += w[s]; }
            const float inv = 1.0f / ws_; v4u o;
#pragma unroll
            for (int j = 0; j < 4; ++j) { float lo = 0.f, hi = 0.f;
#pragma unroll
                for (int s = 0; s < 4; ++s) { const unsigned pw = ml[q][s].y > 0.f ? p[q][s][j] : 0u; const float f = w[s] * inv; lo += f * bflo(pw); hi += f * bfhi(pw); }
                o[j] = cvt_pk_bf16(lo * bflo(z[q][j]), hi * bfhi(z[q][j])); }
            *(v4u*)(ya + e[q]) = o; }
        __syncthreads();
        if (tid_ == 0) *slot = nxt;
        __syncthreads();
        c = __builtin_amdgcn_readfirstlane(*slot);
    }
}

struct Args { const float* in[15]; float* out; unsigned char* ws; int ph_lo, ph_hi, li, pad; };
__global__ void __launch_bounds__(NWAVES * 64, 2) mk_fwd(Args args) {
    extern __shared__ __attribute__((aligned(16))) unsigned char lds[];
    Frame F;
    F.lds = (LAS unsigned char*)lds;
    F.MISC = (volatile LAS unsigned*)(F.lds + MISC_OFF);
    F.G = gridDim.x; { const int bx = blockIdx.x; F.vcu = (F.G % 8 == 0) ? (bx % 8) * (F.G / 8) + bx / 8 : bx; }
    F.ws = args.ws; F.ctl = (gu32*)(args.ws + WS_CTL);
    F.x = args.in[0]; F.mem = args.in[1]; F.w_in = args.in[2]; F.w_mk = args.in[3]; F.w_mv = args.in[4]; F.w_s = args.in[5]; F.b_s = args.in[6]; F.lnvg = args.in[7]; F.lnvb = args.in[8];
    F.wba = args.in[9]; F.wbg = args.in[10]; F.wbm = args.in[11]; F.w_out = args.in[12]; F.ln_g = args.in[13]; F.ln_b = args.in[14]; F.out = args.out;
    for (int u = threadIdx.x; u < (LDS_BYTES - LDSCTL_OFF) / 4; u += NWAVES * 64) ((LAS unsigned*)(F.lds + LDSCTL_OFF))[u] = 0u;
    __syncthreads();
    XcdBarrier bar = xcd_barrier_post((unsigned*)(F.ctl + CW_BAR) + args.li * XCD_BAR_WORDS, F.MISC + 8);
    const int lo = args.ph_lo, hi = args.ph_hi;
#ifdef TS_PHASE
    unsigned long long ts_[8], tc_[8]; int nts_ = 0; tc_[nts_] = __builtin_amdgcn_s_memtime(); ts_[nts_++] = __builtin_amdgcn_s_memrealtime();
#define STAMP() do { tc_[nts_] = __builtin_amdgcn_s_memtime(); ts_[nts_++] = __builtin_amdgcn_s_memrealtime(); } while (0)
#else
#define STAMP() do {} while (0)
#endif
#define IN(k) (lo <= (k) && (k) < hi)
#define BOTH(k) (IN(k) && IN((k) + 1))
    unsigned char* ws = args.ws;
    if (IN(0)) { p0_prologue(F); if (BOTH(0)) xcd_barrier(bar); } STAMP();
    if (IN(1)) {
        pg8::Gemm gq{(const bf16*)(ws + WS_XQ), (const bf16*)(ws + WS_WQ), DM}; pg8::GateOrder Sq{F.G, (int)blockIdx.x}; pg8::EpiGate Eq{(bf16*)(ws + WS_GATES), (bf16*)(ws + WS_ACT), (bf16*)(ws + WS_MEMK), (float*)(ws + WS_KMEAN), (float*)(ws + WS_VSTATS)};
        pg8::gemm_phase<pg8::EpiGate, pg8::GateOrder, true, true, true>(F.lds, gq, Sq, Eq);
        { const int first_idle = (1920 + 16) - 7 * F.G; if (F.G == 256 && (int)blockIdx.x >= first_idle) p0_late(F, (int)blockIdx.x - first_idle, F.G - first_idle); else if (F.G != 256) p0_late(F, (int)blockIdx.x, F.G); }
        if (BOTH(1)) xcd_barrier(bar);
    } STAMP();
    if (IN(2)) {
        if (F.G == 256) { const int v = F.vcu; gu32* lcnt = F.ctl + CW_LCNT;
            moba::select_own(ws, (char*)lds, lcnt, v >> 4, v & 15, [&] { xcd_barrier_arrive(bar); });
            xcd_barrier_wait(bar);
#if defined(TS_PHASE) && TS_PHASE == 12
            STAMP();
#endif
            constexpr int UC0 = 32;
            int* P = (int*)((char*)lds + moba::SCR_P); int* Nn = (int*)((char*)lds + moba::SCR_N); int* u0p = (int*)((char*)lds + moba::SCR_U0);
            const int tid = opaque_tid();
            if (tid < 64) { int c[4], n4[4], s = 0;
#pragma unroll
                for (int i = 0; i < 4; ++i) { const int u_ = tid * 4 + i, k_ = u_ & 15; int s_ = 0;
#pragma unroll
                    for (int j_ = 1; j_ < 16; ++j_) { const int c_ = (int)__hip_atomic_load(lcnt + u_ * 16 + j_, RLX_AGENT); s_ += j_ > k_ ? c_ : 0; }
                    n4[i] = s_; const int nb_ = (n4[i] + 31) >> 5; c[i] = n4[i] > 0 ? UC0 + 4 * nb_ : 0; s += c[i]; }
                int inc = s;
#pragma unroll
                for (int o = 1; o < 64; o <<= 1) { const int t = __shfl_up(inc, o); if (tid >= o) inc += t; }
                int ex = inc - s;
#pragma unroll
                for (int i = 0; i < 4; ++i) { P[tid * 4 + i] = ex; Nn[tid * 4 + i] = n4[i]; ex += c[i]; }
                if (tid == 63) P[256] = ex; }
            __syncthreads();
            const int C = __builtin_amdgcn_readfirstlane(P[256]), lo = (int)(((long long)C * v) >> 8), hi = (int)(((long long)C * (v + 1)) >> 8);
            int* u1p = (int*)((char*)lds + moba::SCR_CURSOR);
            if (tid == 0) *u1p = 256;
            __syncthreads();
            if (tid < 256 && P[tid] <= lo && lo < P[tid + 1]) *u0p = tid;
            if (tid < 256 && P[tid] <= hi && hi < P[tid + 1]) *u1p = tid;
            __syncthreads();
#if defined(TS_PHASE) && TS_PHASE == 13
            STAMP();
#endif
            const int ua = __builtin_amdgcn_readfirstlane(*u0p), ub = __builtin_amdgcn_readfirstlane(*u1p);
            auto cut = [&](int x, int u) -> int {
                const int pu = __builtin_amdgcn_readfirstlane(P[u]), nb = (__builtin_amdgcn_readfirstlane(Nn[u]) + 31) >> 5;
                int i = (x - pu - UC0 + 3) >> 2; i = i < 0 ? 0 : (i > nb ? nb : i);
                const int r = i & 7; i = r < 4 ? i - r : i - r + 8; return i > nb ? nb : i; };
            const int ia = cut(lo, ua), ib = ub < 256 ? cut(hi, ub) : 0;
            __syncthreads();
            for (int u = ua; u < 256 && u <= ub; ++u) {
                const int n = __builtin_amdgcn_readfirstlane(Nn[u]), nb = (n + 31) >> 5;
                const int i0 = u == ua ? ia : 0, i1 = u == ub ? ib : nb;
                if (i0 < i1) moba::gather_unit(ws, (char*)lds, lcnt, u >> 4, u & 15, n, i0, i1); }
#if defined(TS_PHASE) && TS_PHASE == 14
            STAMP();
#endif
#if defined(TS_PHASE) && (TS_PHASE == 61 || TS_PHASE == 62 || TS_PHASE == 63)
            if (threadIdx.x == 0) ((unsigned long long*)(ws + WS_CTL + 8192))[v] = __builtin_amdgcn_s_memrealtime();
#endif
        }
        if (BOTH(2)) xcd_barrier_arrive(bar);
    } STAMP();
    if (IN(3)) {
        if (F.G == 256) { const int v = F.vcu;
            mix::mem_unit((char*)lds, ws, v >> 7, (v >> 5) & 3, (v >> 1) & 15, v & 1);
#if defined(TS_PHASE) && TS_PHASE == 10
            STAMP();
#endif
            mix::sgu_unit((char*)lds, ws, F.b_s, F.lnvg, F.lnvb, v >> 7, (v >> 2) & 31, v & 3); }
#if defined(TS_PHASE) && TS_PHASE == 11
        STAMP();
#endif
        if (BOTH(2)) xcd_barrier_wait(bar);
#if defined(TS_PHASE) && (TS_PHASE >= 64 && TS_PHASE <= 69)
        if (threadIdx.x == 0 && (TS_PHASE == 64 || TS_PHASE == 65)) ((unsigned long long*)(ws + WS_CTL + 8192))[F.vcu] = __builtin_amdgcn_s_memrealtime();
#endif
        p3_combine(F);
#if defined(TS_PHASE) && (TS_PHASE >= 64 && TS_PHASE <= 69)
        if (threadIdx.x == 0 && (TS_PHASE == 66 || TS_PHASE == 67)) ((unsigned long long*)(ws + WS_CTL + 8192))[F.vcu] = __builtin_amdgcn_s_memrealtime();
#endif
        if (BOTH(3)) xcd_barrier(bar);
    } STAMP();
    const int tile = F.vcu;
    if (IN(4)) {
        pg8::Gemm g{(const bf16*)(ws + WS_Y), (const bf16*)(ws + WS_WBR), W}; pg8::BranchOrder S{tile >> 3, tile & 7};
        pg8::EpiBranch E{(const bf16*)(ws + WS_GATES), (bf16*)(ws + WS_MERGED)};
        if (F.G == 256) {
            pg8::gemm_phase<pg8::EpiBranch, pg8::BranchOrder, true, true>(F.lds, g, S, E); }
        if (BOTH(4)) xcd_barrier(bar);
    } STAMP();
    if (IN(5)) {
        pg8::Gemm g{(const bf16*)(ws + WS_MERGED), (const bf16*)(ws + WS_WOUT), DM}; pg8::OneOrder S{tile >> 3, tile & 7};
        pg8::EpiOutLN E{F.x, F.out, F.ln_g, F.ln_b, (float*)(ws + WS_LNS), bar};
        if (F.G == 256) pg8::gemm_phase<pg8::EpiOutLN, pg8::OneOrder, false, true, true>(F.lds, g, S, E);
    } STAMP();
#ifdef TS_PHASE
#if TS_PHASE >= 110 && TS_PHASE <= 119
    if (blockIdx.x == 0 && threadIdx.x == 0) { const int i_ = TS_PHASE - 110; F.out[0] += (float)(mix::g_mt[i_ + 1] - mix::g_mt[i_]) * 1e-3f * 0.01f; }
#elif TS_PHASE >= 90 && TS_PHASE <= 95
    if (blockIdx.x == 0 && threadIdx.x == 0) { const float n_ = (float)moba::g_gacc[2]; const float val = TS_PHASE == 90 ? (float)moba::g_gacc[0] / n_ * 1e-3f : TS_PHASE == 91 ? (float)moba::g_gacc[1] / n_ * 1e-3f : n_; F.out[0] += val * 0.01f; }
#elif TS_PHASE >= 64 && TS_PHASE <= 67
    if (blockIdx.x == 0 && threadIdx.x == 0) { const unsigned long long* ft = (const unsigned long long*)(ws + WS_CTL + 8192); unsigned long long mx = 0, mn = ~0ull;
        for (int i = 0; i < 256; ++i) { const unsigned long long t_ = __hip_atomic_load(ft + i, RLX_AGENT); if (t_ > mx) mx = t_; if (t_ < mn) mn = t_; }
        const float val = (TS_PHASE & 1) ? (float)(mn - ts_[2]) * 0.01f : (float)(mx - ts_[2]) * 0.01f; F.out[0] += val * 0.001f; }
#elif TS_PHASE == 81 || TS_PHASE == 84
    if (blockIdx.x == 0 && threadIdx.x == 0) { const int k_ = TS_PHASE - 80; const float us = (float)(ts_[k_ + 1] - ts_[k_]) * 0.01f - (TS_PHASE == 81 ? 200.f : 60.f); F.out[0] += us * 0.01f; }
#elif TS_PHASE == 61 || TS_PHASE == 62 || TS_PHASE == 63
    if (blockIdx.x == 0 && threadIdx.x == 0) { const unsigned long long* ft = (const unsigned long long*)(ws + WS_CTL + 8192); unsigned long long mx = 0, mn = ~0ull; int am = 0;
        for (int i = 0; i < 256; ++i) { const unsigned long long t_ = __hip_atomic_load(ft + i, RLX_AGENT); if (t_ > mx) { mx = t_; am = i; } if (t_ < mn) mn = t_; }
        const float val = TS_PHASE == 61 ? (float)(mx - ts_[2]) * 0.01f : TS_PHASE == 62 ? (float)am : (float)(mn - ts_[2]) * 0.01f; F.out[0] += val * 0.01f; }
#elif TS_PHASE >= 70 && TS_PHASE < 80
    if (blockIdx.x == 0 && threadIdx.x == 0) { const int k_ = TS_PHASE - 70; const float r_ = (float)(tc_[k_ + 1] - tc_[k_]) / (float)(ts_[k_ + 1] - ts_[k_]); F.out[0] += r_ * 0.01f; }
#elif TS_PHASE >= 30 && TS_PHASE < 60
    if (blockIdx.x == 0 && threadIdx.x == 0) { const float us = (float)(g_tsp - ts_[2]) * 0.01f; F.out[0] += us * 0.01f; }
#elif TS_PHASE >= 100
    if (blockIdx.x == 0 && threadIdx.x == 0) { const float us = (float)__hip_atomic_load(&pg8::g_epi_ticks, RLX_AGENT) * 0.01f; F.out[0] += us * 0.01f; }
#else
    if (blockIdx.x == 0 && threadIdx.x == 0) { const int k_ = (TS_PHASE >= 12 && TS_PHASE <= 14) ? 2 : TS_PHASE >= 10 ? 3 : TS_PHASE; const float us = TS_PHASE == 20 ? (float)(ts_[nts_ - 1] - ts_[0]) * 0.001f : (float)(ts_[k_ + 1] - ts_[k_]) * 0.01f; F.out[0] += us * 0.01f; }
#endif
#endif
#undef IN
#undef BOTH
}


extern "C" void kernel_launch(void* const* d_in, const int* in_sizes, int n_in, void* d_out, int out_size, void* d_ws, size_t ws_size, hipStream_t stream) {
    static int grid = 0;
    if (grid == 0) {
        if (n_in != 15 || in_sizes[0] != M * DM || in_sizes[2] != DM * NPROJ || out_size != M * DM || ws_size < WS_END) { fprintf(stderr, "kernel_launch: unexpected shapes (n_in %d, ws %zu); nothing launched\n", n_in, ws_size); grid = -1; return; }
        int dev = 0, cus = 0, per_cu = 0;
        if (hipGetDevice(&dev) != hipSuccess || hipDeviceGetAttribute(&cus, hipDeviceAttributeMultiprocessorCount, dev) != hipSuccess) { grid = -1; return; }
        if (hipFuncSetAttribute((const void*)mk_fwd, hipFuncAttributeMaxDynamicSharedMemorySize, LDS_BYTES) != hipSuccess) { fprintf(stderr, "kernel_launch: hipFuncSetAttribute failed\n"); grid = -1; return; }
        if (hipOccupancyMaxActiveBlocksPerMultiprocessor(&per_cu, (const void*)mk_fwd, NWAVES * 64, LDS_BYTES) != hipSuccess || per_cu < 1) fprintf(stderr, "kernel_launch: occupancy query reports %d workgroups per CU\n", per_cu);
        (void)hipGetLastError();
        grid = cus;
        if (grid != 256) fprintf(stderr, "kernel_launch: %d CUs; the one-tile-per-workgroup phases need 256\n", grid);
    }
    if (grid < 0) return;
    (void)hipMemsetAsync((char*)d_ws + WS_CTL, 0, 65536, stream);
    Args a{};
    for (int i = 0; i < 15; ++i) a.in[i] = (const float*)d_in[i];
    a.out = (float*)d_out; a.ws = (unsigned char*)d_ws;
    a.ph_lo = 0; a.ph_hi = N_PHASES; a.li = 0;
    hipLaunchKernelGGL(mk_fwd, dim3(grid), dim3(NWAVES * 64), LDS_BYTES, stream, a);
    const hipError_t le = hipPeekAtLastError();
    if (le != hipSuccess) fprintf(stderr, "kernel_launch: launch failed: %s\n", hipGetErrorName(le));
}
```
